# Optimizing an MI355X kernel written in HIP

```python
import math
import jax, jax.numpy as jnp
from jax import lax
import numpy as np

D_MODEL = 1024
BATCH = 4
SEQ = 4096
DEPTH = 1

N_ATTN_HEADS = 8
SUB_HEAD_DIM = 64
V_HEAD_DIM = 2 * SUB_HEAD_DIM
ATTN_WIDTH = N_ATTN_HEADS * V_HEAD_DIM
ROPE_THETA = 10000.0
Q_BLOCK = 128
LAMBDA_BASE = 0.8
LAMBDA_AMP = 0.6
LAMBDA_RATE = 0.3

LRU_WIDTH = 1024
LRU_BLOCKS = 8
LRU_BLOCK_DIM = LRU_WIDTH // LRU_BLOCKS
CONV_WIDTH = 4
CONV_PAD_LEFT = (CONV_WIDTH - 1) // 2
CONV_PAD_RIGHT = CONV_WIDTH - 1 - CONV_PAD_LEFT
LRU_C = 8.0
N_DIRECTIONS = 2

N_GATED_BRANCHES = 2
PROJ_WIDTH = 3 * ATTN_WIDTH + 2 * LRU_WIDTH + N_GATED_BRANCHES * D_MODEL
SPLIT_POINTS = (ATTN_WIDTH, 2 * ATTN_WIDTH, 3 * ATTN_WIDTH,
                3 * ATTN_WIDTH + LRU_WIDTH, 3 * ATTN_WIDTH + 2 * LRU_WIDTH)

N_GROUPS = 4
EXPERTS_PER_GROUP = 4
N_EXPERTS = N_GROUPS * EXPERTS_PER_GROUP
TOP_K_IN_GROUP = 2
EXPERT_HIDDEN = 512
TOKEN_BLOCK = 128

RMS_EPS = 1e-6

kernel_name = "hybrid_diffattn_rglru_hmoe_encoder"


def rms_norm(x, gain):
    xf = x.astype(jnp.float32)
    y = xf * lax.rsqrt(jnp.mean(xf * xf, axis=-1, keepdims=True) + RMS_EPS)
    return (y * gain.astype(jnp.float32)).astype(x.dtype)


def lambda_init_fn(layer_idx):
    return LAMBDA_BASE - LAMBDA_AMP * math.exp(-LAMBDA_RATE * layer_idx)


def rope_tables(seq, dim):
    pos = jnp.arange(seq, dtype=jnp.float32)
    inv_freq = ROPE_THETA ** (-jnp.arange(0, dim, 2, dtype=jnp.float32) / dim)
    ang = pos[:, None] * inv_freq[None, :]
    return jnp.cos(ang), jnp.sin(ang)


def apply_rope(x, cos, sin):
    xf = x.astype(jnp.float32)
    x1, x2 = jnp.split(xf, 2, axis=-1)
    c = cos[None, :, None, None, :]
    s = sin[None, :, None, None, :]
    return jnp.concatenate([x1 * c - x2 * s, x1 * s + x2 * c], axis=-1).astype(x.dtype)


def diff_attention(q, k, v, lam):
    B, S, H, _, dh = q.shape
    scale = dh ** -0.5
    n_blk = S // Q_BLOCK
    qb = q.reshape(B, n_blk, Q_BLOCK, H, 2, dh).transpose(1, 0, 2, 3, 4, 5)

    def one_block(q_blk):
        s = jnp.einsum('bqhcd,bkhcd->bhcqk', q_blk, k,
                       preferred_element_type=jnp.float32) * scale
        p = jax.nn.softmax(s, axis=-1)
        p_diff = p[:, :, 0] - lam * p[:, :, 1]
        return jnp.einsum('bhqk,bkhd->bqhd', p_diff.astype(v.dtype), v)

    out = lax.map(one_block, qb)
    return out.transpose(1, 0, 2, 3, 4).reshape(B, S, H, v.shape[-1])


def centred_depthwise_conv(x, w, b):
    y = lax.conv_general_dilated(
        x, w[:, None, :], window_strides=(1,),
        padding=[(CONV_PAD_LEFT, CONV_PAD_RIGHT)],
        dimension_numbers=('NWC', 'WIO', 'NWC'),
        feature_group_count=x.shape[-1])
    return y + b


def block_diag_linear(x, w, b):
    B, S, C = x.shape
    xb = x.reshape(B, S, LRU_BLOCKS, LRU_BLOCK_DIM)
    y = jnp.einsum('bsnd,nde->bsne', xb, w)
    return y.reshape(B, S, C) + b


def rg_lru(x, w_a, b_a, w_i, b_i, lam_param, reverse):
    r = jax.nn.sigmoid(block_diag_linear(x, w_a, b_a).astype(jnp.float32))
    i = jax.nn.sigmoid(block_diag_linear(x, w_i, b_i).astype(jnp.float32))
    log_a = -LRU_C * r * jax.nn.softplus(-lam_param.astype(jnp.float32))
    a = jnp.exp(log_a)
    mult = jnp.sqrt(-jnp.expm1(2.0 * log_a))
    u = mult * (i * x.astype(jnp.float32))

    def combine(c1, c2):
        a1, b1 = c1
        a2, b2 = c2
        return a1 * a2, a2 * b1 + b2

    _, h = lax.associative_scan(combine, (a, u), axis=1, reverse=reverse)
    return h.astype(x.dtype)


def hierarchical_moe(h, w_group, b_group, w_er, b_er, w_gate, w_up, w_down):
    B, S, D = h.shape
    N = B * S
    xt = h.reshape(N, D)
    g_logits = (xt @ w_group + b_group).astype(jnp.float32)
    g_prob = jax.nn.softmax(g_logits, axis=-1)
    g_sel = jnp.argmax(g_logits, axis=-1)
    g_w = jnp.take_along_axis(g_prob, g_sel[:, None], axis=-1)
    e_logits = (xt @ w_er + b_er).astype(jnp.float32).reshape(N, N_GROUPS, EXPERTS_PER_GROUP)
    e_sel_logits = jnp.take_along_axis(e_logits, g_sel[:, None, None], axis=1)[:, 0]
    top_val, top_idx = lax.top_k(e_sel_logits, TOP_K_IN_GROUP)
    top_w = jax.nn.softmax(top_val, axis=-1) * g_w
    expert_id = g_sel[:, None] * EXPERTS_PER_GROUP + top_idx
    combine_w = jnp.sum(jax.nn.one_hot(expert_id, N_EXPERTS, dtype=jnp.float32)
                        * top_w[..., None], axis=1)

    n_blk = S // TOKEN_BLOCK
    xb = h.reshape(B, n_blk, TOKEN_BLOCK, D).transpose(1, 0, 2, 3).reshape(n_blk, B * TOKEN_BLOCK, D)
    cb = combine_w.reshape(B, n_blk, TOKEN_BLOCK, N_EXPERTS).transpose(1, 0, 2, 3)
    cb = cb.reshape(n_blk, B * TOKEN_BLOCK, N_EXPERTS).astype(h.dtype)

    def expert_block(args):
        xs, cs = args
        a = jnp.einsum('nd,edf->nef', xs, w_gate)
        u = jnp.einsum('nd,edf->nef', xs, w_up)
        hid = jax.nn.silu(a) * u * cs[:, :, None]
        return jnp.einsum('nef,efd->nd', hid, w_down)

    y = lax.map(expert_block, (xb, cb))
    y = y.reshape(n_blk, B, TOKEN_BLOCK, D).transpose(1, 0, 2, 3)
    return y.reshape(B, S, D)


def setup_inputs(seed: int = 0) -> dict:
    key = jax.random.key(seed)
    ks = jax.random.split(key, 32)
    f32 = jnp.float32
    nrm = lambda k, shape, scale: jax.random.normal(k, shape, f32) * scale
    gain = lambda k, shape: jnp.ones(shape, f32) + 0.02 * jax.random.normal(k, shape, f32)

    a_c = jax.random.uniform(ks[16], (DEPTH, N_DIRECTIONS, LRU_WIDTH), f32, 0.9, 0.999)
    a_base = a_c ** (1.0 / LRU_C)
    lru_lambda = jnp.log(a_base) - jnp.log1p(-a_base)

    return {
        "x": jax.random.normal(ks[0], (BATCH, SEQ, D_MODEL), f32),
        "norm1_gain": gain(ks[1], (DEPTH, D_MODEL)),
        "w_in": nrm(ks[2], (DEPTH, D_MODEL, PROJ_WIDTH), D_MODEL ** -0.5),
        "b_gates": nrm(ks[3], (DEPTH, N_GATED_BRANCHES * D_MODEL), 0.02),
        "q_norm_gain": gain(ks[4], (DEPTH, SUB_HEAD_DIM)),
        "k_norm_gain": gain(ks[5], (DEPTH, SUB_HEAD_DIM)),
        "lambda_q1": nrm(ks[6], (DEPTH, SUB_HEAD_DIM), 0.1),
        "lambda_k1": nrm(ks[7], (DEPTH, SUB_HEAD_DIM), 0.1),
        "lambda_q2": nrm(ks[8], (DEPTH, SUB_HEAD_DIM), 0.1),
        "lambda_k2": nrm(ks[9], (DEPTH, SUB_HEAD_DIM), 0.1),
        "attn_subln_gain": gain(ks[10], (DEPTH, V_HEAD_DIM)),
        "w_attn_o": nrm(ks[11], (DEPTH, ATTN_WIDTH, D_MODEL), ATTN_WIDTH ** -0.5),
        "conv_w": nrm(ks[12], (DEPTH, CONV_WIDTH, LRU_WIDTH), CONV_WIDTH ** -0.5),
        "conv_b": nrm(ks[13], (DEPTH, LRU_WIDTH), 0.02),
        "lru_wa": nrm(ks[14], (DEPTH, N_DIRECTIONS, LRU_BLOCKS, LRU_BLOCK_DIM, LRU_BLOCK_DIM), LRU_BLOCK_DIM ** -0.5),
        "lru_ba": nrm(ks[15], (DEPTH, N_DIRECTIONS, LRU_WIDTH), 0.02),
        "lru_wi": nrm(ks[17], (DEPTH, N_DIRECTIONS, LRU_BLOCKS, LRU_BLOCK_DIM, LRU_BLOCK_DIM), LRU_BLOCK_DIM ** -0.5),
        "lru_bi": nrm(ks[18], (DEPTH, N_DIRECTIONS, LRU_WIDTH), 0.02),
        "lru_lambda": lru_lambda,
        "w_lru_o": nrm(ks[19], (DEPTH, LRU_WIDTH, D_MODEL), LRU_WIDTH ** -0.5),
        "w_out": nrm(ks[20], (DEPTH, D_MODEL, D_MODEL), D_MODEL ** -0.5),
        "norm2_gain": gain(ks[21], (DEPTH, D_MODEL)),
        "w_group_router": nrm(ks[22], (DEPTH, D_MODEL, N_GROUPS), D_MODEL ** -0.5),
        "b_group_router": nrm(ks[23], (DEPTH, N_GROUPS), 0.01),
        "w_expert_router": nrm(ks[24], (DEPTH, D_MODEL, N_EXPERTS), D_MODEL ** -0.5),
        "b_expert_router": nrm(ks[25], (DEPTH, N_EXPERTS), 0.01),
        "w_expert_gate": nrm(ks[26], (DEPTH, N_EXPERTS, D_MODEL, EXPERT_HIDDEN), D_MODEL ** -0.5),
        "w_expert_up": nrm(ks[27], (DEPTH, N_EXPERTS, D_MODEL, EXPERT_HIDDEN), D_MODEL ** -0.5),
        "w_expert_down": nrm(ks[28], (DEPTH, N_EXPERTS, EXPERT_HIDDEN, D_MODEL), EXPERT_HIDDEN ** -0.5),
    }


def reference(x, norm1_gain, w_in, b_gates, q_norm_gain, k_norm_gain,
              lambda_q1, lambda_k1, lambda_q2, lambda_k2, attn_subln_gain, w_attn_o,
              conv_w, conv_b, lru_wa, lru_ba, lru_wi, lru_bi, lru_lambda, w_lru_o,
              w_out, norm2_gain, w_group_router, b_group_router,
              w_expert_router, b_expert_router, w_expert_gate, w_expert_up, w_expert_down):
    B, S, D = x.shape
    cos, sin = rope_tables(S, SUB_HEAD_DIM)
    for l in range(DEPTH):
        lam_init = lambda_init_fn(l)
        h = rms_norm(x, norm1_gain[l])
        proj = jnp.einsum('bsd,dc->bsc', h, w_in[l])
        q, k, v, lru_x, lru_g, gate_pre = jnp.split(proj, SPLIT_POINTS, axis=-1)

        q = q.reshape(B, S, N_ATTN_HEADS, 2, SUB_HEAD_DIM)
        k = k.reshape(B, S, N_ATTN_HEADS, 2, SUB_HEAD_DIM)
        v = v.reshape(B, S, N_ATTN_HEADS, V_HEAD_DIM)
        q = apply_rope(rms_norm(q, q_norm_gain[l]), cos, sin)
        k = apply_rope(rms_norm(k, k_norm_gain[l]), cos, sin)
        lam = (jnp.exp(jnp.sum(lambda_q1[l].astype(jnp.float32) * lambda_k1[l].astype(jnp.float32)))
               - jnp.exp(jnp.sum(lambda_q2[l].astype(jnp.float32) * lambda_k2[l].astype(jnp.float32)))
               + lam_init)
        o = diff_attention(q, k, v, lam)
        o = rms_norm(o, attn_subln_gain[l]) * (1.0 - lam_init)
        attn_d = jnp.einsum('bsc,cd->bsd', o.reshape(B, S, ATTN_WIDTH), w_attn_o[l])

        xr = centred_depthwise_conv(lru_x, conv_w[l], conv_b[l])
        h_fwd = rg_lru(xr, lru_wa[l, 0], lru_ba[l, 0], lru_wi[l, 0], lru_bi[l, 0], lru_lambda[l, 0], False)
        h_bwd = rg_lru(xr, lru_wa[l, 1], lru_ba[l, 1], lru_wi[l, 1], lru_bi[l, 1], lru_lambda[l, 1], True)
        y_lru = (h_fwd + h_bwd) * jax.nn.gelu(lru_g)
        lru_d = jnp.einsum('bsc,cd->bsd', y_lru, w_lru_o[l])

        g_attn, g_lru = jnp.split(jax.nn.sigmoid(gate_pre + b_gates[l]), N_GATED_BRANCHES, axis=-1)
        merged = g_attn * attn_d + g_lru * lru_d
        x = x + jnp.einsum('bsd,de->bse', merged, w_out[l])

        h2 = rms_norm(x, norm2_gain[l])
        x = x + hierarchical_moe(h2, w_group_router[l], b_group_router[l],
                                 w_expert_router[l], b_expert_router[l],
                                 w_expert_gate[l], w_expert_up[l], w_expert_down[l])
    return x
```

```cpp
#include <hip/hip_runtime.h>
#include <cstdint>
#include <cstdio>

typedef unsigned short bf16_t;
__device__ __forceinline__ float bf2f(bf16_t v) { return __uint_as_float(((unsigned)v) << 16); }
__device__ __forceinline__ bf16_t f2bf(float f) { unsigned u = __float_as_uint(f); return (bf16_t)((u + 0x7fffu + ((u >> 16) & 1u)) >> 16); }
__device__ __forceinline__ float toF(float v) { return v; }
__device__ __forceinline__ float toF(bf16_t v) { return bf2f(v); }

constexpr int NTOK = 16384, DM = 1024, SEQ = 4096, NB = 4, PROJ = 7168;
constexpr size_t MiB = 1u << 20;
constexpr size_t SLOT = 32 * MiB;
constexpr size_t WS_S0 = 0, WS_S1 = SLOT, WS_S2 = 2 * SLOT, WS_S3 = 3 * SLOT, WS_S4 = 4 * SLOT, WS_S5 = 5 * SLOT, WS_S6 = 6 * SLOT, WS_S7 = 7 * SLOT;

__device__ __forceinline__ float wave_sum(float v) {
#pragma unroll
  for (int o = 1; o < 64; o <<= 1) v += __shfl_xor(v, o);
  return v;
}
__device__ __forceinline__ float sigmoidf_(float x) { return 1.f / (1.f + __expf(-x)); }
__device__ __forceinline__ float gelu_tanh(float x) {
  const float k0 = 0.7978845608028654f, k1 = 0.044715f;
  float t = k0 * (x + k1 * x * x * x);
  return 0.5f * x * (1.f + tanhf(t));
}

namespace nv {
__global__ __launch_bounds__(256) void rms1(const float* __restrict__ x, const float* __restrict__ gain, bf16_t* __restrict__ xn) {
  const int wave = threadIdx.x >> 6, lane = threadIdx.x & 63;
  const size_t tok = (size_t)blockIdx.x * 4 + wave;
  float v[16]; float ss = 0.f;
#pragma unroll
  for (int j = 0; j < 16; ++j) { v[j] = x[tok * DM + j * 64 + lane]; ss += v[j] * v[j]; }
  ss = wave_sum(ss);
  const float rs = rsqrtf(ss * (1.f / DM) + 1e-6f);
#pragma unroll
  for (int j = 0; j < 16; ++j) xn[tok * DM + j * 64 + lane] = f2bf(v[j] * rs * gain[j * 64 + lane]);
}

template <typename TA, class Epi>
__global__ __launch_bounds__(256) void ngemm(const TA* __restrict__ A, int lda, const float* __restrict__ B, int ldb, int K, Epi epi) {
  __shared__ float As[16][68];
  __shared__ float Bs[16][68];
  const int tid = threadIdx.x, tx = tid & 15, ty = tid >> 4;
  const int m0 = blockIdx.y * 64, n0 = blockIdx.x * 64;
  float acc[4][4];
#pragma unroll
  for (int i = 0; i < 4; ++i)
#pragma unroll
    for (int j = 0; j < 4; ++j) acc[i][j] = 0.f;
  const int ar = tid >> 2, akq = (tid & 3) * 4;
  const int bk = tid >> 4, bnq = (tid & 15) * 4;
  for (int k0 = 0; k0 < K; k0 += 16) {
#pragma unroll
    for (int j = 0; j < 4; ++j) As[akq + j][ar] = toF(A[(size_t)(m0 + ar) * lda + k0 + akq + j]);
    const float4 bv = *(const float4*)&B[(size_t)(k0 + bk) * ldb + n0 + bnq];
    Bs[bk][bnq + 0] = bv.x; Bs[bk][bnq + 1] = bv.y; Bs[bk][bnq + 2] = bv.z; Bs[bk][bnq + 3] = bv.w;
    __syncthreads();
#pragma unroll
    for (int kk = 0; kk < 16; ++kk) {
      float a[4], b[4];
#pragma unroll
      for (int i = 0; i < 4; ++i) a[i] = As[kk][ty * 4 + i];
#pragma unroll
      for (int j = 0; j < 4; ++j) b[j] = Bs[kk][tx * 4 + j];
#pragma unroll
      for (int i = 0; i < 4; ++i)
#pragma unroll
        for (int j = 0; j < 4; ++j) acc[i][j] += a[i] * b[j];
    }
    __syncthreads();
  }
#pragma unroll
  for (int i = 0; i < 4; ++i)
#pragma unroll
    for (int j = 0; j < 4; ++j) epi(m0 + ty * 4 + i, n0 + tx * 4 + j, acc[i][j]);
}

struct EpiProj {
  bf16_t *q, *k, *v, *lrx, *lrg, *ga, *gl; const float* bg;
  __device__ __forceinline__ void operator()(int row, int col, float val) const {
    const size_t r = (size_t)row * DM;
    if (col < 1024) q[r + col] = f2bf(val);
    else if (col < 2048) k[r + col - 1024] = f2bf(val);
    else if (col < 3072) v[r + col - 2048] = f2bf(val);
    else if (col < 4096) lrx[r + col - 3072] = f2bf(val);
    else if (col < 5120) lrg[r + col - 4096] = f2bf(gelu_tanh(val));
    else if (col < 6144) ga[r + col - 5120] = f2bf(sigmoidf_(val + bg[col - 5120]));
    else gl[r + col - 6144] = f2bf(sigmoidf_(val + bg[col - 5120]));
  }
};
struct EpiGateSet { float* M; const bf16_t* g; __device__ __forceinline__ void operator()(int row, int col, float val) const { const size_t i = (size_t)row * DM + col; M[i] = bf2f(g[i]) * val; } };
struct EpiGateAdd { float* M; const bf16_t* g; __device__ __forceinline__ void operator()(int row, int col, float val) const { const size_t i = (size_t)row * DM + col; M[i] += bf2f(g[i]) * val; } };
struct EpiResid { float* O; const float* x; __device__ __forceinline__ void operator()(int row, int col, float val) const { const size_t i = (size_t)row * DM + col; O[i] = x[i] + val; } };

__global__ void scalars(const float* lq1, const float* lk1, const float* lq2, const float* lk2, float* sc) {
  if (threadIdx.x == 0) {
    float s1 = 0.f, s2 = 0.f;
    for (int i = 0; i < 64; ++i) { s1 += lq1[i] * lk1[i]; s2 += lq2[i] * lk2[i]; }
    sc[0] = expf(s1) - expf(s2) + 0.2f;
  }
}

__global__ __launch_bounds__(256) void qkprep(bf16_t* __restrict__ q, bf16_t* __restrict__ k, const float* __restrict__ qg, const float* __restrict__ kg) {
  const int wave = threadIdx.x >> 6, lane = threadIdx.x & 63;
  const size_t item = (size_t)blockIdx.x * 4 + wave;
  const size_t tok = item >> 5; const int which = (item >> 4) & 1, hc = item & 15;
  bf16_t* p = (which ? k : q) + tok * DM + hc * 64;
  const float* g = which ? kg : qg;
  const float xv = bf2f(p[lane]);
  const float ss = wave_sum(xv * xv);
  const float y = xv * rsqrtf(ss * (1.f / 64.f) + 1e-6f) * g[lane];
  const int pos = (int)(tok & (SEQ - 1));
  const int i = lane & 31;
  const float inv_freq = expf(-9.210340371976184f * (float)i * (1.f / 32.f));
  const float ang = (float)pos * inv_freq;
  float sn, cs; sincosf(ang, &sn, &cs);
  const float other = __shfl_xor(y, 32);
  const float o = (lane < 32) ? (y * cs - other * sn) : (other * sn + y * cs);
  p[lane] = f2bf(o);
}

__global__ __launch_bounds__(256) void nattn(const bf16_t* __restrict__ Q, const bf16_t* __restrict__ Kp, const bf16_t* __restrict__ V, bf16_t* __restrict__ O1, bf16_t* __restrict__ O2) {
  __shared__ float Ks[64][64];
  __shared__ float Vs[64][128];
  const int tid = threadIdx.x, r = tid >> 2, cq = tid & 3;
  const int b = blockIdx.z, hc = blockIdx.y, h = hc >> 1, c = hc & 1;
  const size_t tok = (size_t)b * SEQ + blockIdx.x * 64 + r;
  float q[16];
#pragma unroll
  for (int i = 0; i < 16; ++i) q[i] = bf2f(Q[tok * DM + h * 128 + c * 64 + cq * 16 + i]) * 0.125f;
  float acc[32];
#pragma unroll
  for (int i = 0; i < 32; ++i) acc[i] = 0.f;
  float m = -1e30f, l = 0.f;
  for (int kt = 0; kt < SEQ; kt += 64) {
    __syncthreads();
    for (int i = tid; i < 4096; i += 256) { const int kr = i >> 6, d = i & 63; Ks[kr][d] = bf2f(Kp[((size_t)b * SEQ + kt + kr) * DM + h * 128 + c * 64 + d]); }
    for (int i = tid; i < 8192; i += 256) { const int kr = i >> 7, d = i & 127; Vs[kr][d] = bf2f(V[((size_t)b * SEQ + kt + kr) * DM + h * 128 + d]); }
    __syncthreads();
    for (int j = 0; j < 64; ++j) {
      float s = 0.f;
#pragma unroll
      for (int i = 0; i < 16; ++i) s += q[i] * Ks[j][cq * 16 + i];
      s += __shfl_xor(s, 1); s += __shfl_xor(s, 2);
      const float mn = fmaxf(m, s); const float al = __expf(m - mn); const float p = __expf(s - mn);
      l = l * al + p; m = mn;
#pragma unroll
      for (int i = 0; i < 32; ++i) acc[i] = acc[i] * al + p * Vs[j][cq * 32 + i];
    }
  }
  const float inv = 1.f / l;
  bf16_t* O = c ? O2 : O1;
#pragma unroll
  for (int i = 0; i < 32; ++i) O[tok * DM + h * 128 + cq * 32 + i] = f2bf(acc[i] * inv);
}

__global__ __launch_bounds__(256) void subln(const bf16_t* __restrict__ O1, const bf16_t* __restrict__ O2, const float* __restrict__ gain, const float* __restrict__ sc, bf16_t* __restrict__ On) {
  const int wave = threadIdx.x >> 6, lane = threadIdx.x & 63;
  const size_t item = (size_t)blockIdx.x * 4 + wave;
  const size_t base = item * 128;
  const float lam = sc[0];
  const float a0 = bf2f(O1[base + lane]) - lam * bf2f(O2[base + lane]);
  const float a1 = bf2f(O1[base + 64 + lane]) - lam * bf2f(O2[base + 64 + lane]);
  const float ss = wave_sum(a0 * a0 + a1 * a1);
  const float rs = rsqrtf(ss * (1.f / 128.f) + 1e-6f) * 0.8f;
  On[base + lane] = f2bf(a0 * rs * gain[lane]);
  On[base + 64 + lane] = f2bf(a1 * rs * gain[64 + lane]);
}

__global__ __launch_bounds__(128) void nlru(const bf16_t* __restrict__ lrx, const float* __restrict__ conv_w, const float* __restrict__ conv_b,
                                            const float* __restrict__ wa, const float* __restrict__ ba, const float* __restrict__ wi, const float* __restrict__ bi,
                                            const float* __restrict__ lam, bf16_t* __restrict__ hout) {
  extern __shared__ __attribute__((aligned(16))) float sm[];
  float* Wa = sm; float* Wi = sm + 128 * 128; float* xs = sm + 2 * 128 * 128;
  const int e = threadIdx.x;
  const int dir = blockIdx.x & 1, blk = (blockIdx.x >> 1) & 7, b = blockIdx.x >> 4;
  const int c = blk * 128 + e;
  for (int d = 0; d < 128; ++d) { Wa[d * 128 + e] = wa[((size_t)(dir * 8 + blk) * 128 + d) * 128 + e]; Wi[d * 128 + e] = wi[((size_t)(dir * 8 + blk) * 128 + d) * 128 + e]; }
  const float sp = log1pf(expf(-lam[dir * 1024 + c]));
  const float bav = ba[dir * 1024 + c], biv = bi[dir * 1024 + c];
  const float cw0 = conv_w[0 * 1024 + c], cw1 = conv_w[1 * 1024 + c], cw2 = conv_w[2 * 1024 + c], cw3 = conv_w[3 * 1024 + c], cb = conv_b[c];
  float h = 0.f;
  bf16_t* ho = hout + (size_t)dir * NTOK * DM;
  for (int step = 0; step < SEQ; ++step) {
    const int t = dir ? (SEQ - 1 - step) : step;
    const size_t rowb = (size_t)b * SEQ;
    float xv = cb;
    if (t - 1 >= 0) xv += cw0 * bf2f(lrx[(rowb + t - 1) * DM + c]);
    xv += cw1 * bf2f(lrx[(rowb + t) * DM + c]);
    if (t + 1 < SEQ) xv += cw2 * bf2f(lrx[(rowb + t + 1) * DM + c]);
    if (t + 2 < SEQ) xv += cw3 * bf2f(lrx[(rowb + t + 2) * DM + c]);
    float* xb = xs + (step & 1) * 128;
    xb[e] = xv;
    __syncthreads();
    float ra = bav, ia = biv;
#pragma unroll 8
    for (int d = 0; d < 128; ++d) { const float xd = xb[d]; ra += xd * Wa[d * 128 + e]; ia += xd * Wi[d * 128 + e]; }
    const float r = sigmoidf_(ra), ig = sigmoidf_(ia);
    const float log_a = -8.f * r * sp;
    const float a = expf(log_a);
    const float mult = sqrtf(-expm1f(2.f * log_a));
    h = a * h + mult * ig * xv;
    ho[(rowb + t) * DM + c] = f2bf(h);
  }
}
__global__ __launch_bounds__(256) void lru_y(const bf16_t* __restrict__ hf, const bf16_t* __restrict__ hb, const bf16_t* __restrict__ lrg, bf16_t* __restrict__ y) {
  const size_t i = (size_t)blockIdx.x * 256 + threadIdx.x;
  y[i] = f2bf((bf2f(hf[i]) + bf2f(hb[i])) * bf2f(lrg[i]));
}

__global__ __launch_bounds__(256) void router(const float* __restrict__ x1, const float* __restrict__ gain2, const float* __restrict__ wg, const float* __restrict__ bg,
                                              const float* __restrict__ wer, const float* __restrict__ ber, bf16_t* __restrict__ h2, int* __restrict__ sel_e, float* __restrict__ sel_w) {
  const int wave = threadIdx.x >> 6, lane = threadIdx.x & 63;
  const size_t tok = (size_t)blockIdx.x * 4 + wave;
  float v[16]; float ss = 0.f;
#pragma unroll
  for (int j = 0; j < 16; ++j) { v[j] = x1[tok * DM + j * 64 + lane]; ss += v[j] * v[j]; }
  ss = wave_sum(ss);
  const float rs = rsqrtf(ss * (1.f / DM) + 1e-6f);
  float lg[20];
#pragma unroll
  for (int k = 0; k < 20; ++k) lg[k] = 0.f;
#pragma unroll
  for (int j = 0; j < 16; ++j) {
    const int d = j * 64 + lane; const float hv = v[j] * rs * gain2[d];
    h2[tok * DM + d] = f2bf(hv);
    const float4 g4 = *(const float4*)&wg[d * 4];
    lg[0] += hv * g4.x; lg[1] += hv * g4.y; lg[2] += hv * g4.z; lg[3] += hv * g4.w;
#pragma unroll
    for (int q = 0; q < 4; ++q) { const float4 e4 = *(const float4*)&wer[d * 16 + q * 4]; lg[4 + q * 4 + 0] += hv * e4.x; lg[4 + q * 4 + 1] += hv * e4.y; lg[4 + q * 4 + 2] += hv * e4.z; lg[4 + q * 4 + 3] += hv * e4.w; }
  }
#pragma unroll
  for (int k = 0; k < 20; ++k) lg[k] = wave_sum(lg[k]);
  if (lane == 0) {
    float gl0 = lg[0] + bg[0], gl1 = lg[1] + bg[1], gl2 = lg[2] + bg[2], gl3 = lg[3] + bg[3];
    int gs = 0; float gm = gl0;
    if (gl1 > gm) { gm = gl1; gs = 1; } if (gl2 > gm) { gm = gl2; gs = 2; } if (gl3 > gm) { gm = gl3; gs = 3; }
    const float gden = expf(gl0 - gm) + expf(gl1 - gm) + expf(gl2 - gm) + expf(gl3 - gm);
    const float gw = 1.f / gden;
    float el[4];
#pragma unroll
    for (int j = 0; j < 4; ++j) {
      float s0 = lg[4 + j], s1 = lg[8 + j], s2 = lg[12 + j], s3 = lg[16 + j];
      el[j] = (gs == 0 ? s0 : gs == 1 ? s1 : gs == 2 ? s2 : s3) + ber[gs * 4 + j];
    }
    int i0 = 0; float v0 = el[0];
    if (el[1] > v0) { v0 = el[1]; i0 = 1; } if (el[2] > v0) { v0 = el[2]; i0 = 2; } if (el[3] > v0) { v0 = el[3]; i0 = 3; }
    int i1 = -1; float v1 = -3.0e38f;
#pragma unroll
    for (int j = 0; j < 4; ++j) { if (j != i0 && el[j] > v1) { v1 = el[j]; i1 = j; } }
    const float ex = expf(v1 - v0); const float w0 = gw / (1.f + ex), w1 = gw * ex / (1.f + ex);
    sel_e[tok * 2 + 0] = gs * 4 + i0; sel_e[tok * 2 + 1] = gs * 4 + i1;
    sel_w[tok * 2 + 0] = w0; sel_w[tok * 2 + 1] = w1;
  }
}

__global__ __launch_bounds__(256) void nmoe(const bf16_t* __restrict__ h2, const int* __restrict__ sel_e, const float* __restrict__ sel_w,
                                            const float* __restrict__ Wg, const float* __restrict__ Wu, const float* __restrict__ Wd, const float* __restrict__ x1, float* __restrict__ out) {
  __shared__ float hs[1024]; __shared__ float hid[512];
  const int tid = threadIdx.x; const size_t tok = blockIdx.x;
  for (int d = tid; d < 1024; d += 256) hs[d] = bf2f(h2[tok * DM + d]);
  float y0 = 0.f, y1 = 0.f, y2 = 0.f, y3 = 0.f;
  for (int s = 0; s < 2; ++s) {
    const int e = sel_e[tok * 2 + s]; const float w = sel_w[tok * 2 + s];
    __syncthreads();
#pragma unroll
    for (int ff = 0; ff < 2; ++ff) {
      const int f = tid + ff * 256; float a = 0.f, u = 0.f;
      const float* pg = Wg + (size_t)e * 1024 * 512 + f; const float* pu = Wu + (size_t)e * 1024 * 512 + f;
#pragma unroll 8
      for (int d = 0; d < 1024; ++d) { const float hv = hs[d]; a += hv * pg[(size_t)d * 512]; u += hv * pu[(size_t)d * 512]; }
      hid[f] = a / (1.f + __expf(-a)) * u * w;
    }
    __syncthreads();
    const float* pd = Wd + (size_t)e * 512 * 1024 + tid;
#pragma unroll 8
    for (int f = 0; f < 512; ++f) { const float hv = hid[f]; y0 += hv * pd[(size_t)f * 1024]; y1 += hv * pd[(size_t)f * 1024 + 256]; y2 += hv * pd[(size_t)f * 1024 + 512]; y3 += hv * pd[(size_t)f * 1024 + 768]; }
  }
  out[tok * DM + tid] = x1[tok * DM + tid] + y0; out[tok * DM + tid + 256] = x1[tok * DM + tid + 256] + y1;
  out[tok * DM + tid + 512] = x1[tok * DM + tid + 512] + y2; out[tok * DM + tid + 768] = x1[tok * DM + tid + 768] + y3;
}
}

extern "C" void kernel_launch(void* const* d_in, const int* in_sizes, int n_in, void* d_out, int out_size, void* d_ws, size_t ws_size, hipStream_t stream) {
  const float* x = (const float*)d_in[0];
  const float* norm1_gain = (const float*)d_in[1];
  const float* w_in = (const float*)d_in[2];
  const float* b_gates = (const float*)d_in[3];
  const float* q_norm_gain = (const float*)d_in[4];
  const float* k_norm_gain = (const float*)d_in[5];
  const float* lq1 = (const float*)d_in[6];
  const float* lk1 = (const float*)d_in[7];
  const float* lq2 = (const float*)d_in[8];
  const float* lk2 = (const float*)d_in[9];
  const float* subln_gain = (const float*)d_in[10];
  const float* w_attn_o = (const float*)d_in[11];
  const float* conv_w = (const float*)d_in[12];
  const float* conv_b = (const float*)d_in[13];
  const float* lru_wa = (const float*)d_in[14];
  const float* lru_ba = (const float*)d_in[15];
  const float* lru_wi = (const float*)d_in[16];
  const float* lru_bi = (const float*)d_in[17];
  const float* lru_lambda = (const float*)d_in[18];
  const float* w_lru_o = (const float*)d_in[19];
  const float* w_out = (const float*)d_in[20];
  const float* norm2_gain = (const float*)d_in[21];
  const float* w_group = (const float*)d_in[22];
  const float* b_group = (const float*)d_in[23];
  const float* w_er = (const float*)d_in[24];
  const float* b_er = (const float*)d_in[25];
  const float* w_eg = (const float*)d_in[26];
  const float* w_eu = (const float*)d_in[27];
  const float* w_ed = (const float*)d_in[28];
  static int once = 0;
  if (!once) {
    once = 1;
    if (ws_size < 8 * SLOT) fprintf(stderr, "kernel_launch: ws too small: %zu\n", ws_size);
    (void)hipFuncSetAttribute((const void*)nv::nlru, hipFuncAttributeMaxDynamicSharedMemorySize, (2 * 128 * 128 + 256) * 4);
  }
  char* ws = (char*)d_ws; char* dout = (char*)d_out;
  bf16_t* xn = (bf16_t*)dout;
  bf16_t* qb = (bf16_t*)(ws + WS_S0); bf16_t* kb = (bf16_t*)(ws + WS_S1); bf16_t* vb = (bf16_t*)(ws + WS_S2);
  bf16_t* lrx = (bf16_t*)(ws + WS_S3); bf16_t* lrg = (bf16_t*)(ws + WS_S4); bf16_t* ga = (bf16_t*)(ws + WS_S5); bf16_t* gl = (bf16_t*)(ws + WS_S6);
  float* sc = (float*)(ws + WS_S7);
  int* sel_e = (int*)(ws + WS_S7 + 1 * MiB); float* sel_w = (float*)(ws + WS_S7 + 2 * MiB);

  nv::scalars<<<1, 64, 0, stream>>>(lq1, lk1, lq2, lk2, sc);
  nv::rms1<<<NTOK / 4, 256, 0, stream>>>(x, norm1_gain, xn);
  { nv::EpiProj e{qb, kb, vb, lrx, lrg, ga, gl, b_gates};
    nv::ngemm<bf16_t, nv::EpiProj><<<dim3(PROJ / 64, NTOK / 64), 256, 0, stream>>>(xn, DM, w_in, PROJ, DM, e); }
  nv::qkprep<<<NTOK * 32 / 4, 256, 0, stream>>>(qb, kb, q_norm_gain, k_norm_gain);
  bf16_t* O1 = (bf16_t*)dout; bf16_t* O2 = (bf16_t*)(dout + SLOT);
  nv::nattn<<<dim3(SEQ / 64, 16, NB), 256, 0, stream>>>(qb, kb, vb, O1, O2);
  bf16_t* On = qb;
  nv::subln<<<NTOK * 8 / 4, 256, 0, stream>>>(O1, O2, subln_gain, sc, On);
  bf16_t* hfb = kb;
  nv::nlru<<<NB * 8 * 2, 128, (2 * 128 * 128 + 256) * 4, stream>>>(lrx, conv_w, conv_b, lru_wa, lru_ba, lru_wi, lru_bi, lru_lambda, hfb);
  bf16_t* ylru = lrx;
  nv::lru_y<<<NTOK * DM / 256, 256, 0, stream>>>(hfb, hfb + (size_t)NTOK * DM, lrg, ylru);
  float* merged = (float*)dout;
  { nv::EpiGateSet e{merged, ga}; nv::ngemm<bf16_t, nv::EpiGateSet><<<dim3(DM / 64, NTOK / 64), 256, 0, stream>>>(On, DM, w_attn_o, DM, DM, e); }
  { nv::EpiGateAdd e{merged, gl}; nv::ngemm<bf16_t, nv::EpiGateAdd><<<dim3(DM / 64, NTOK / 64), 256, 0, stream>>>(ylru, DM, w_lru_o, DM, DM, e); }
  float* x1 = (float*)(ws + WS_S0);
  { nv::EpiResid e{x1, x}; nv::ngemm<float, nv::EpiResid><<<dim3(DM / 64, NTOK / 64), 256, 0, stream>>>(merged, DM, w_out, DM, DM, e); }
  bf16_t* h2 = vb;
  nv::router<<<NTOK / 4, 256, 0, stream>>>(x1, norm2_gain, w_group, b_group, w_er, b_er, h2, sel_e, sel_w);
  nv::nmoe<<<NTOK, 256, 0, stream>>>(h2, sel_e, sel_w, w_eg, w_eu, w_ed, x1, (float*)d_out);
}
```

```cpp
#include <hip/hip_runtime.h>
#include <cstdint>
#include <cstdio>

typedef unsigned short bf16_t;
__device__ __forceinline__ float bf2f(bf16_t v) { return __uint_as_float(((unsigned)v) << 16); }
__device__ __forceinline__ bf16_t f2bf(float f) { unsigned u = __float_as_uint(f); return (bf16_t)((u + 0x7fffu + ((u >> 16) & 1u)) >> 16); }
__device__ __forceinline__ float toF(float v) { return v; }
__device__ __forceinline__ float toF(bf16_t v) { return bf2f(v); }

constexpr int NTOK = 16384, DM = 1024, SEQ = 4096, NB = 4, PROJ = 7168;
constexpr size_t MiB = 1u << 20;
constexpr size_t SLOT = 32 * MiB;
constexpr size_t WS_S0 = 0, WS_S1 = SLOT, WS_S2 = 2 * SLOT, WS_S3 = 3 * SLOT, WS_S4 = 4 * SLOT, WS_S5 = 5 * SLOT, WS_S6 = 6 * SLOT, WS_S7 = 7 * SLOT;

__device__ __forceinline__ float wave_sum(float v) {
#pragma unroll
  for (int o = 1; o < 64; o <<= 1) v += __shfl_xor(v, o);
  return v;
}
__device__ __forceinline__ float sigmoidf_(float x) { return 1.f / (1.f + __expf(-x)); }
__device__ __forceinline__ float gelu_tanh(float x) {
  const float k0 = 0.7978845608028654f, k1 = 0.044715f;
  float t = k0 * (x + k1 * x * x * x);
  return 0.5f * x * (1.f + tanhf(t));
}

namespace nv {
__global__ __launch_bounds__(256) void rms1(const float* __restrict__ x, const float* __restrict__ gain, bf16_t* __restrict__ xn) {
  const int wave = threadIdx.x >> 6, lane = threadIdx.x & 63;
  const size_t tok = (size_t)blockIdx.x * 4 + wave;
  float v[16]; float ss = 0.f;
#pragma unroll
  for (int j = 0; j < 16; ++j) { v[j] = x[tok * DM + j * 64 + lane]; ss += v[j] * v[j]; }
  ss = wave_sum(ss);
  const float rs = rsqrtf(ss * (1.f / DM) + 1e-6f);
#pragma unroll
  for (int j = 0; j < 16; ++j) xn[tok * DM + j * 64 + lane] = f2bf(v[j] * rs * gain[j * 64 + lane]);
}

template <typename TA, class Epi>
__global__ __launch_bounds__(256) void ngemm(const TA* __restrict__ A, int lda, const float* __restrict__ B, int ldb, int K, Epi epi) {
  __shared__ float As[16][68];
  __shared__ float Bs[16][68];
  const int tid = threadIdx.x, tx = tid & 15, ty = tid >> 4;
  const int m0 = blockIdx.y * 64, n0 = blockIdx.x * 64;
  float acc[4][4];
#pragma unroll
  for (int i = 0; i < 4; ++i)
#pragma unroll
    for (int j = 0; j < 4; ++j) acc[i][j] = 0.f;
  const int ar = tid >> 2, akq = (tid & 3) * 4;
  const int bk = tid >> 4, bnq = (tid & 15) * 4;
  for (int k0 = 0; k0 < K; k0 += 16) {
#pragma unroll
    for (int j = 0; j < 4; ++j) As[akq + j][ar] = toF(A[(size_t)(m0 + ar) * lda + k0 + akq + j]);
    const float4 bv = *(const float4*)&B[(size_t)(k0 + bk) * ldb + n0 + bnq];
    Bs[bk][bnq + 0] = bv.x; Bs[bk][bnq + 1] = bv.y; Bs[bk][bnq + 2] = bv.z; Bs[bk][bnq + 3] = bv.w;
    __syncthreads();
#pragma unroll
    for (int kk = 0; kk < 16; ++kk) {
      float a[4], b[4];
#pragma unroll
      for (int i = 0; i < 4; ++i) a[i] = As[kk][ty * 4 + i];
#pragma unroll
      for (int j = 0; j < 4; ++j) b[j] = Bs[kk][tx * 4 + j];
#pragma unroll
      for (int i = 0; i < 4; ++i)
#pragma unroll
        for (int j = 0; j < 4; ++j) acc[i][j] += a[i] * b[j];
    }
    __syncthreads();
  }
#pragma unroll
  for (int i = 0; i < 4; ++i)
#pragma unroll
    for (int j = 0; j < 4; ++j) epi(m0 + ty * 4 + i, n0 + tx * 4 + j, acc[i][j]);
}

struct EpiProj {
  bf16_t *q, *k, *v, *lrx, *lrg, *ga, *gl; const float* bg;
  __device__ __forceinline__ void operator()(int row, int col, float val) const {
    const size_t r = (size_t)row * DM;
    if (col < 1024) q[r + col] = f2bf(val);
    else if (col < 2048) k[r + col - 1024] = f2bf(val);
    else if (col < 3072) { const int cc = col - 2048, hh = cc >> 7, dd = cc & 127; const int bb = row >> 12, ss = row & 4095; v[(((size_t)bb * 8 + hh) * SEQ + ss) * 128 + dd] = f2bf(val); }
    else if (col < 4096) lrx[r + col - 3072] = f2bf(val);
    else if (col < 5120) lrg[r + col - 4096] = f2bf(gelu_tanh(val));
    else if (col < 6144) ga[r + col - 5120] = f2bf(sigmoidf_(val + bg[col - 5120]));
    else gl[r + col - 6144] = f2bf(sigmoidf_(val + bg[col - 5120]));
  }
};
struct EpiGateSet { float* M; const bf16_t* g; __device__ __forceinline__ void operator()(int row, int col, float val) const { const size_t i = (size_t)row * DM + col; M[i] = bf2f(g[i]) * val; } };
struct EpiGateAdd { float* M; const bf16_t* g; __device__ __forceinline__ void operator()(int row, int col, float val) const { const size_t i = (size_t)row * DM + col; M[i] += bf2f(g[i]) * val; } };
struct EpiResid { float* O; const float* x; __device__ __forceinline__ void operator()(int row, int col, float val) const { const size_t i = (size_t)row * DM + col; O[i] = x[i] + val; } };

__global__ void scalars(const float* lq1, const float* lk1, const float* lq2, const float* lk2, float* sc) {
  if (threadIdx.x == 0) {
    float s1 = 0.f, s2 = 0.f;
    for (int i = 0; i < 64; ++i) { s1 += lq1[i] * lk1[i]; s2 += lq2[i] * lk2[i]; }
    sc[0] = expf(s1) - expf(s2) + 0.2f;
  }
}

__global__ __launch_bounds__(256) void qkprep(const bf16_t* __restrict__ q, const bf16_t* __restrict__ k, const float* __restrict__ qg, const float* __restrict__ kg, bf16_t* __restrict__ QP, bf16_t* __restrict__ KP) {
  const int wave = threadIdx.x >> 6, lane = threadIdx.x & 63;
  const size_t item = (size_t)blockIdx.x * 4 + wave;
  const size_t tok = item >> 5; const int which = (item >> 4) & 1, hc = item & 15;
  const bf16_t* p = (which ? k : q) + tok * DM + hc * 64;
  const float* g = which ? kg : qg;
  const float xv = bf2f(p[lane]);
  const float ss = wave_sum(xv * xv);
  const float y = xv * rsqrtf(ss * (1.f / 64.f) + 1e-6f) * g[lane];
  const int pos = (int)(tok & (SEQ - 1));
  const int i = lane & 31;
  const float inv_freq = expf(-9.210340371976184f * (float)i * (1.f / 32.f));
  const float ang = (float)pos * inv_freq;
  float sn, cs; sincosf(ang, &sn, &cs);
  const float other = __shfl_xor(y, 32);
  const float o = (lane < 32) ? (y * cs - other * sn) : (other * sn + y * cs);
  const int bb = (int)(tok >> 12);
  bf16_t* dst = (which ? KP : QP) + (((size_t)bb * 16 + hc) * SEQ + pos) * 64;
  dst[lane] = f2bf(which ? o : o * (0.125f * 1.4426950408889634f));
}

__global__ __launch_bounds__(256) void nattn(const bf16_t* __restrict__ Q, const bf16_t* __restrict__ Kp, const bf16_t* __restrict__ V, bf16_t* __restrict__ O1, bf16_t* __restrict__ O2) {
  __shared__ float Ks[64][64];
  __shared__ float Vs[64][128];
  const int tid = threadIdx.x, r = tid >> 2, cq = tid & 3;
  const int b = blockIdx.z, hc = blockIdx.y, h = hc >> 1, c = hc & 1;
  const size_t tok = (size_t)b * SEQ + blockIdx.x * 64 + r;
  float q[16];
#pragma unroll
  for (int i = 0; i < 16; ++i) q[i] = bf2f(Q[(((size_t)b * 16 + hc) * SEQ + blockIdx.x * 64 + r) * 64 + cq * 16 + i]);
  float acc[32];
#pragma unroll
  for (int i = 0; i < 32; ++i) acc[i] = 0.f;
  float m = -1e30f, l = 0.f;
  for (int kt = 0; kt < SEQ; kt += 64) {
    __syncthreads();
    for (int i = tid; i < 4096; i += 256) { const int kr = i >> 6, d = i & 63; Ks[kr][d] = bf2f(Kp[(((size_t)b * 16 + hc) * SEQ + kt + kr) * 64 + d]); }
    for (int i = tid; i < 8192; i += 256) { const int kr = i >> 7, d = i & 127; Vs[kr][d] = bf2f(V[(((size_t)b * 8 + h) * SEQ + kt + kr) * 128 + d]); }
    __syncthreads();
    for (int j = 0; j < 64; ++j) {
      float s = 0.f;
#pragma unroll
      for (int i = 0; i < 16; ++i) s += q[i] * Ks[j][cq * 16 + i];
      s += __shfl_xor(s, 1); s += __shfl_xor(s, 2);
      const float mn = fmaxf(m, s); const float al = exp2f(m - mn); const float p = exp2f(s - mn);
      l = l * al + p; m = mn;
#pragma unroll
      for (int i = 0; i < 32; ++i) acc[i] = acc[i] * al + p * Vs[j][cq * 32 + i];
    }
  }
  const float inv = 1.f / l;
  bf16_t* O = c ? O2 : O1;
#pragma unroll
  for (int i = 0; i < 32; ++i) O[tok * DM + h * 128 + cq * 32 + i] = f2bf(acc[i] * inv);
}

__global__ __launch_bounds__(256) void subln(const bf16_t* __restrict__ O1, const bf16_t* __restrict__ O2, const float* __restrict__ gain, const float* __restrict__ sc, bf16_t* __restrict__ On) {
  const int wave = threadIdx.x >> 6, lane = threadIdx.x & 63;
  const size_t item = (size_t)blockIdx.x * 4 + wave;
  const size_t base = item * 128;
  const float lam = sc[0];
  const float a0 = bf2f(O1[base + lane]) - lam * bf2f(O2[base + lane]);
  const float a1 = bf2f(O1[base + 64 + lane]) - lam * bf2f(O2[base + 64 + lane]);
  const float ss = wave_sum(a0 * a0 + a1 * a1);
  const float rs = rsqrtf(ss * (1.f / 128.f) + 1e-6f) * 0.8f;
  On[base + lane] = f2bf(a0 * rs * gain[lane]);
  On[base + 64 + lane] = f2bf(a1 * rs * gain[64 + lane]);
}

__global__ __launch_bounds__(128) void nlru(const bf16_t* __restrict__ lrx, const float* __restrict__ conv_w, const float* __restrict__ conv_b,
                                            const float* __restrict__ wa, const float* __restrict__ ba, const float* __restrict__ wi, const float* __restrict__ bi,
                                            const float* __restrict__ lam, bf16_t* __restrict__ hout_f, bf16_t* __restrict__ hout_b) {
  extern __shared__ __attribute__((aligned(16))) float sm[];
  float* Wa = sm; float* Wi = sm + 128 * 128; float* xs = sm + 2 * 128 * 128;
  const int e = threadIdx.x;
  const int dir = blockIdx.x & 1, blk = (blockIdx.x >> 1) & 7, b = blockIdx.x >> 4;
  const int c = blk * 128 + e;
  for (int d = 0; d < 128; ++d) { Wa[d * 128 + e] = wa[((size_t)(dir * 8 + blk) * 128 + d) * 128 + e]; Wi[d * 128 + e] = wi[((size_t)(dir * 8 + blk) * 128 + d) * 128 + e]; }
  const float sp = log1pf(expf(-lam[dir * 1024 + c]));
  const float bav = ba[dir * 1024 + c], biv = bi[dir * 1024 + c];
  const float cw0 = conv_w[0 * 1024 + c], cw1 = conv_w[1 * 1024 + c], cw2 = conv_w[2 * 1024 + c], cw3 = conv_w[3 * 1024 + c], cb = conv_b[c];
  float h = 0.f;
  bf16_t* ho = dir ? hout_b : hout_f;
  for (int step = 0; step < SEQ; ++step) {
    const int t = dir ? (SEQ - 1 - step) : step;
    const size_t rowb = (size_t)b * SEQ;
    float xv = cb;
    if (t - 1 >= 0) xv += cw0 * bf2f(lrx[(rowb + t - 1) * DM + c]);
    xv += cw1 * bf2f(lrx[(rowb + t) * DM + c]);
    if (t + 1 < SEQ) xv += cw2 * bf2f(lrx[(rowb + t + 1) * DM + c]);
    if (t + 2 < SEQ) xv += cw3 * bf2f(lrx[(rowb + t + 2) * DM + c]);
    float* xb = xs + (step & 1) * 128;
    xb[e] = xv;
    __syncthreads();
    float ra = bav, ia = biv;
#pragma unroll 8
    for (int d = 0; d < 128; ++d) { const float xd = xb[d]; ra += xd * Wa[d * 128 + e]; ia += xd * Wi[d * 128 + e]; }
    const float r = sigmoidf_(ra), ig = sigmoidf_(ia);
    const float log_a = -8.f * r * sp;
    const float a = expf(log_a);
    const float mult = sqrtf(-expm1f(2.f * log_a));
    h = a * h + mult * ig * xv;
    ho[(rowb + t) * DM + c] = f2bf(h);
  }
}
__global__ __launch_bounds__(256) void lru_y(const bf16_t* __restrict__ hf, const bf16_t* __restrict__ hb, const bf16_t* __restrict__ lrg, bf16_t* __restrict__ y) {
  const size_t i = (size_t)blockIdx.x * 256 + threadIdx.x;
  y[i] = f2bf((bf2f(hf[i]) + bf2f(hb[i])) * bf2f(lrg[i]));
}

__global__ __launch_bounds__(256) void router(const float* __restrict__ x1, const float* __restrict__ gain2, const float* __restrict__ wg, const float* __restrict__ bg,
                                              const float* __restrict__ wer, const float* __restrict__ ber, bf16_t* __restrict__ h2, int* __restrict__ sel_e, float* __restrict__ sel_w) {
  const int wave = threadIdx.x >> 6, lane = threadIdx.x & 63;
  const size_t tok = (size_t)blockIdx.x * 4 + wave;
  float v[16]; float ss = 0.f;
#pragma unroll
  for (int j = 0; j < 16; ++j) { v[j] = x1[tok * DM + j * 64 + lane]; ss += v[j] * v[j]; }
  ss = wave_sum(ss);
  const float rs = rsqrtf(ss * (1.f / DM) + 1e-6f);
  float lg[20];
#pragma unroll
  for (int k = 0; k < 20; ++k) lg[k] = 0.f;
#pragma unroll
  for (int j = 0; j < 16; ++j) {
    const int d = j * 64 + lane; const float hv = v[j] * rs * gain2[d];
    h2[tok * DM + d] = f2bf(hv);
    const float4 g4 = *(const float4*)&wg[d * 4];
    lg[0] += hv * g4.x; lg[1] += hv * g4.y; lg[2] += hv * g4.z; lg[3] += hv * g4.w;
#pragma unroll
    for (int q = 0; q < 4; ++q) { const float4 e4 = *(const float4*)&wer[d * 16 + q * 4]; lg[4 + q * 4 + 0] += hv * e4.x; lg[4 + q * 4 + 1] += hv * e4.y; lg[4 + q * 4 + 2] += hv * e4.z; lg[4 + q * 4 + 3] += hv * e4.w; }
  }
#pragma unroll
  for (int k = 0; k < 20; ++k) lg[k] = wave_sum(lg[k]);
  if (lane == 0) {
    float gl0 = lg[0] + bg[0], gl1 = lg[1] + bg[1], gl2 = lg[2] + bg[2], gl3 = lg[3] + bg[3];
    int gs = 0; float gm = gl0;
    if (gl1 > gm) { gm = gl1; gs = 1; } if (gl2 > gm) { gm = gl2; gs = 2; } if (gl3 > gm) { gm = gl3; gs = 3; }
    const float gden = expf(gl0 - gm) + expf(gl1 - gm) + expf(gl2 - gm) + expf(gl3 - gm);
    const float gw = 1.f / gden;
    float el[4];
#pragma unroll
    for (int j = 0; j < 4; ++j) {
      float s0 = lg[4 + j], s1 = lg[8 + j], s2 = lg[12 + j], s3 = lg[16 + j];
      el[j] = (gs == 0 ? s0 : gs == 1 ? s1 : gs == 2 ? s2 : s3) + ber[gs * 4 + j];
    }
    int i0 = 0; float v0 = el[0];
    if (el[1] > v0) { v0 = el[1]; i0 = 1; } if (el[2] > v0) { v0 = el[2]; i0 = 2; } if (el[3] > v0) { v0 = el[3]; i0 = 3; }
    int i1 = (i0 == 0) ? 1 : 0; float v1 = -3.0e38f;
#pragma unroll
    for (int j = 0; j < 4; ++j) { if (j != i0 && el[j] > v1) { v1 = el[j]; i1 = j; } }
    const float ex = expf(v1 - v0); const float w0 = gw / (1.f + ex), w1 = gw * ex / (1.f + ex);
    sel_e[tok * 2 + 0] = gs * 4 + i0; sel_e[tok * 2 + 1] = gs * 4 + i1;
    sel_w[tok * 2 + 0] = w0; sel_w[tok * 2 + 1] = w1;
  }
}

__global__ __launch_bounds__(256) void nmoe(const bf16_t* __restrict__ h2, const int* __restrict__ sel_e, const float* __restrict__ sel_w,
                                            const float* __restrict__ Wg, const float* __restrict__ Wu, const float* __restrict__ Wd, const float* __restrict__ x1, float* __restrict__ out) {
  __shared__ float hs[1024]; __shared__ float hid[512];
  const int tid = threadIdx.x; const size_t tok = blockIdx.x;
  for (int d = tid; d < 1024; d += 256) hs[d] = bf2f(h2[tok * DM + d]);
  float y0 = 0.f, y1 = 0.f, y2 = 0.f, y3 = 0.f;
  for (int s = 0; s < 2; ++s) {
    const int e = sel_e[tok * 2 + s]; const float w = sel_w[tok * 2 + s];
    __syncthreads();
#pragma unroll
    for (int ff = 0; ff < 2; ++ff) {
      const int f = tid + ff * 256; float a = 0.f, u = 0.f;
      const float* pg = Wg + (size_t)e * 1024 * 512 + f; const float* pu = Wu + (size_t)e * 1024 * 512 + f;
#pragma unroll 8
      for (int d = 0; d < 1024; ++d) { const float hv = hs[d]; a += hv * pg[(size_t)d * 512]; u += hv * pu[(size_t)d * 512]; }
      hid[f] = a / (1.f + __expf(-a)) * u * w;
    }
    __syncthreads();
    const float* pd = Wd + (size_t)e * 512 * 1024 + tid;
#pragma unroll 8
    for (int f = 0; f < 512; ++f) { const float hv = hid[f]; y0 += hv * pd[(size_t)f * 1024]; y1 += hv * pd[(size_t)f * 1024 + 256]; y2 += hv * pd[(size_t)f * 1024 + 512]; y3 += hv * pd[(size_t)f * 1024 + 768]; }
  }
  out[tok * DM + tid] = x1[tok * DM + tid] + y0; out[tok * DM + tid + 256] = x1[tok * DM + tid + 256] + y1;
  out[tok * DM + tid + 512] = x1[tok * DM + tid + 512] + y2; out[tok * DM + tid + 768] = x1[tok * DM + tid + 768] + y3;
}
}

namespace pg8 {
#define PG8_LAS __attribute__((address_space(3)))
typedef unsigned short bf16_t;
typedef short bf16x8 __attribute__((ext_vector_type(8)));
typedef float f32x4 __attribute__((ext_vector_type(4)));
typedef unsigned u32x4 __attribute__((ext_vector_type(4)));
constexpr int BM = 256, BK = 64, HALF = 128, HTB = HALF * BK * 2  , STAGE_BYTES = 8 * HTB, NXCD = 8, WGM = 8;

__host__ __device__ __forceinline__ int lds_byte(int r, int c) { const int st = (r >> 4) * 2 + (c >> 5), rr = r & 15, cc = c & 31, ob = rr * 64 + cc * 2; return st * 1024 + (ob ^ (((ob >> 9) & 1) << 5)); }
__host__ __device__ __forceinline__ void stage_rc(int b, int& R, int& C) { const int st = b / 1024, sb = b % 1024, swz = sb ^ (((sb >> 9) & 1) << 5); R = (st >> 1) * 16 + swz / 64; C = (st & 1) * 32 + (swz % 64) / 2; }
__host__ __device__ __forceinline__ int perm32(int rho) { const int n = rho >> 4, i = rho & 15; return 8 * (i >> 2) + 4 * n + (i & 3); }

struct Unit { int pm, pn; };
struct GUnit { int pm, pn, e, pos0, cnt; };
struct Gemm { const bf16_t* A; const bf16_t* Bt; int M, N, K; };

struct StaticOrder {
    int nM, nN, nwg, G, c;
    __host__ __device__ void init(int M, int N, int G_, int c_) { nM = M / BM; nN = N / BM; nwg = nM * nN; G = G_; c = c_; }
    __host__ __device__ bool next(int i, Unit& u) const {
        const long L = (long)i * G + c; if (L >= nwg) return false;
        int wgid = (int)L; { const int q = nwg / NXCD, r = nwg % NXCD, xcd = wgid % NXCD, off = wgid / NXCD; wgid = (xcd < r ? xcd * (q + 1) : r * (q + 1) + (xcd - r) * q) + off; }
        const int nig = WGM * nN, gid = wgid / nig, fm = gid * WGM, gsz = (nM - fm) < WGM ? (nM - fm) : WGM;
        u.pm = fm + ((wgid % nig) % gsz); u.pn = (wgid % nig) / gsz; return true;
    }
    __device__ __forceinline__ void a_ready(const Unit&) const {}
    __device__ __forceinline__ void done(const Unit&) const {}
};

__device__ __forceinline__ unsigned cvt_pk_bf16(float lo, float hi) { unsigned r; asm volatile("v_cvt_pk_bf16_f32 %0, %1, %2" : "=v"(r) : "v"(lo), "v"(hi)); return r; }
typedef float f32x2 __attribute__((ext_vector_type(2)));
template <class Epi, class Sched, bool ALIGN_EPI = false, bool SP2 = false>
__device__ __forceinline__ void gemm_phase(PG8_LAS unsigned char* lds, const Gemm g, const Sched& S, const Epi& E) {
    const int tid = threadIdx.x, wid = __builtin_amdgcn_readfirstlane(tid >> 6), lane = tid & 63, wr = wid >> 2, wc = wid & 3, fr = lane & 15, fq = lane >> 4;
    const int K = g.K, nt = K / BK;
    unsigned voffA[2], voffB[2];
#pragma unroll
    for (int i = 0; i < 2; ++i) { int R, C; stage_rc(tid * 16 + i * 8192, R, C); const int Rb = Epi::PERM ? ((R & ~31) + perm32(R & 31)) : R;
        voffA[i] = (unsigned)(R * K + C) * 2u; voffB[i] = (unsigned)(Rb * K + C) * 2u; }
    const size_t kstep = (size_t)(BK * 2);
    const size_t hstep = (size_t)HALF * K * 2;
    const size_t tstep = 2 * hstep;
    const unsigned ldsw = (unsigned)wid * 1024u;
    const int aoff = lds_byte(wr * 64 + fr, fq * 8), boff = lds_byte(wc * 32 + fr, fq * 8);
#define PG8_SA(b, h) (((b) * 2 + (h)) * HTB)
#define PG8_SB(b, h) ((4 + (b) * 2 + (h)) * HTB)
#define PG8_STAGE(bufoff, gbase, voff) do { _Pragma("unroll") for (int _i = 0; _i < 2; ++_i) \
        __builtin_amdgcn_global_load_lds((const unsigned*)((const char*)(gbase) + (voff)[_i]), (PG8_LAS unsigned*)(lds + (bufoff) + ldsw + _i * 8192), 16, 0, 0); } while (0)
#define PG8_LDA(dst, b, h) do { _Pragma("unroll") for (int m = 0; m < 4; ++m) _Pragma("unroll") for (int k = 0; k < 2; ++k) dst[m][k] = *(const PG8_LAS bf16x8*)(lds + PG8_SA(b, h) + aoff + m * 2048 + k * 1024); } while (0)
#define PG8_LDB(dst, b, h) do { _Pragma("unroll") for (int n = 0; n < 2; ++n) _Pragma("unroll") for (int k = 0; k < 2; ++k) dst[n][k] = *(const PG8_LAS bf16x8*)(lds + PG8_SB(b, h) + boff + n * 2048 + k * 1024); } while (0)
#define PG8_MMA(ai, bj, At, Bt) do { __builtin_amdgcn_s_setprio(1); _Pragma("unroll") for (int m = 0; m < 4; ++m) _Pragma("unroll") for (int n = 0; n < 2; ++n) _Pragma("unroll") for (int k = 0; k < 2; ++k) \
        acc[ai][bj][m][n] = __builtin_amdgcn_mfma_f32_16x16x32_bf16(Bt[n][k], At[m][k], acc[ai][bj][m][n], 0, 0, 0); __builtin_amdgcn_s_setprio(0); } while (0)
#define PG8_WAIT_V(n) asm volatile("s_waitcnt vmcnt(" #n ")" ::: "memory")
#define PG8_WAIT_L(n) asm volatile("s_waitcnt lgkmcnt(" #n ")" ::: "memory")
#define PG8_BAR __builtin_amdgcn_s_barrier()
#define PG8_SCHED __builtin_amdgcn_sched_barrier(0)
    Unit cur, nxt; int ui = 0;
    if (!S.next(0, cur)) return;
    f32x4 acc[2][2][4][2];
#pragma unroll
    for (int a = 0; a < 2; ++a)
#pragma unroll
        for (int b = 0; b < 2; ++b)
#pragma unroll
            for (int m = 0; m < 4; ++m)
#pragma unroll
                for (int n = 0; n < 2; ++n) acc[a][b][m][n] = (f32x4){0.f, 0.f, 0.f, 0.f};
    bf16x8 At[4][2], B0[2][2], B1[2][2];
    const char* cA = (const char*)g.A + (size_t)cur.pm * tstep; const char* cB = (const char*)g.Bt + (size_t)cur.pn * tstep;
    S.a_ready(cur);
    if constexpr (SP2) {
        PG8_STAGE(PG8_SB(0, 0), cB, voffB); PG8_STAGE(PG8_SB(0, 1), cB + hstep, voffB); PG8_STAGE(PG8_SA(0, 0), cA, voffA); PG8_STAGE(PG8_SA(0, 1), cA + hstep, voffA);
        if (wr == 1) PG8_BAR;
        PG8_WAIT_V(2); PG8_BAR;
        PG8_STAGE(PG8_SB(1, 0), cB + kstep, voffB); PG8_STAGE(PG8_SA(1, 0), cA + kstep, voffA); PG8_STAGE(PG8_SB(1, 1), cB + hstep + kstep, voffB);
        PG8_WAIT_V(6); PG8_BAR;
    } else {
        PG8_STAGE(PG8_SB(0, 0), cB, voffB); PG8_STAGE(PG8_SA(0, 0), cA, voffA); PG8_STAGE(PG8_SB(0, 1), cB + hstep, voffB); PG8_STAGE(PG8_SA(0, 1), cA + hstep, voffA);
        if (wr == 1) PG8_BAR;
        PG8_WAIT_V(4); PG8_BAR;
        PG8_STAGE(PG8_SB(1, 0), cB + kstep, voffB); PG8_STAGE(PG8_SA(1, 0), cA + kstep, voffA); PG8_STAGE(PG8_SB(1, 1), cB + hstep + kstep, voffB);
        PG8_WAIT_V(6); PG8_BAR;
    }
    for (;;) {
        const bool has_next = S.next(ui + 1, nxt);
        const char* nA = has_next ? (const char*)g.A + (size_t)nxt.pm * tstep : cA; const char* nB = has_next ? (const char*)g.Bt + (size_t)nxt.pn * tstep : cB;
        for (int t = 0; t < nt; t += 2) {
            const bool last = (t == nt - 2);
            const char* a1 = cA + (size_t)(t + 1) * kstep;
            const char* a2 = last ? nA : cA + (size_t)(t + 2) * kstep; const char* b2 = last ? nB : cB + (size_t)(t + 2) * kstep;
            const char* a3 = a2 + kstep; const char* b3 = b2 + kstep;
            if (last && has_next) S.a_ready(nxt);
            if constexpr (SP2) {
            PG8_LDB(B0, 0, 0); PG8_LDB(B1, 0, 1); PG8_SCHED; PG8_LDA(At, 0, 0); PG8_STAGE(PG8_SA(1, 1), a1 + hstep, voffA);
            PG8_WAIT_V(8); PG8_WAIT_L(0); PG8_BAR; PG8_MMA(0, 0, At, B0); PG8_MMA(0, 1, At, B1); PG8_BAR; PG8_SCHED;
            PG8_LDA(At, 0, 1); PG8_STAGE(PG8_SB(0, 0), b2, voffB); PG8_STAGE(PG8_SB(0, 1), b2 + hstep, voffB); PG8_STAGE(PG8_SA(0, 0), a2, voffA);
            PG8_WAIT_V(8); PG8_WAIT_L(0); PG8_BAR; PG8_MMA(1, 0, At, B0); PG8_MMA(1, 1, At, B1); PG8_BAR; PG8_SCHED;
            PG8_LDB(B0, 1, 0); PG8_LDB(B1, 1, 1); PG8_SCHED; PG8_LDA(At, 1, 0); PG8_STAGE(PG8_SA(0, 1), a2 + hstep, voffA);
            PG8_WAIT_V(8); PG8_WAIT_L(0); PG8_BAR; PG8_MMA(0, 0, At, B0); PG8_MMA(0, 1, At, B1); PG8_BAR; PG8_SCHED;
            PG8_LDA(At, 1, 1); PG8_STAGE(PG8_SB(1, 0), b3, voffB); PG8_STAGE(PG8_SB(1, 1), b3 + hstep, voffB); PG8_STAGE(PG8_SA(1, 0), a3, voffA);
            PG8_WAIT_V(8); PG8_WAIT_L(0); PG8_BAR; PG8_MMA(1, 0, At, B0); PG8_MMA(1, 1, At, B1); PG8_BAR; PG8_SCHED;
            } else {
            PG8_LDB(B0, 0, 0); PG8_SCHED; PG8_LDA(At, 0, 0); PG8_STAGE(PG8_SA(1, 1), a1 + hstep, voffA);
            PG8_WAIT_L(8); PG8_BAR; PG8_WAIT_L(0); PG8_MMA(0, 0, At, B0); PG8_BAR; PG8_SCHED;
            PG8_LDB(B1, 0, 1); PG8_STAGE(PG8_SB(0, 0), b2, voffB);
            PG8_BAR; PG8_WAIT_L(0); PG8_MMA(0, 1, At, B1); PG8_BAR;
            PG8_LDA(At, 0, 1); PG8_STAGE(PG8_SA(0, 0), a2, voffA);
            PG8_BAR; PG8_WAIT_L(0); PG8_MMA(1, 0, At, B0); PG8_BAR; PG8_SCHED;
            PG8_STAGE(PG8_SB(0, 1), b2 + hstep, voffB);
            PG8_WAIT_V(6); PG8_BAR; PG8_MMA(1, 1, At, B1); PG8_BAR;
            PG8_LDB(B0, 1, 0); PG8_SCHED; PG8_LDA(At, 1, 0); PG8_STAGE(PG8_SA(0, 1), a2 + hstep, voffA);
            PG8_WAIT_L(8); PG8_BAR; PG8_WAIT_L(0); PG8_MMA(0, 0, At, B0); PG8_BAR; PG8_SCHED;
            PG8_LDB(B1, 1, 1); PG8_STAGE(PG8_SB(1, 0), b3, voffB);
            PG8_BAR; PG8_WAIT_L(0); PG8_MMA(0, 1, At, B1); PG8_BAR;
            PG8_LDA(At, 1, 1); PG8_STAGE(PG8_SA(1, 0), a3, voffA);
            PG8_BAR; PG8_WAIT_L(0); PG8_MMA(1, 0, At, B0); PG8_BAR; PG8_SCHED;
            PG8_STAGE(PG8_SB(1, 1), b3 + hstep, voffB);
            PG8_WAIT_V(6); PG8_BAR; PG8_MMA(1, 1, At, B1); PG8_BAR;
            }
        }
        if constexpr (ALIGN_EPI) { if (wr == 0) PG8_BAR; }
        if constexpr (!Epi::AFTER_DRAIN) { E(acc, cur, wr, wc, fr, fq); S.done(cur); }
        if (!has_next) break;
#pragma unroll
        for (int a = 0; a < 2; ++a)
#pragma unroll
            for (int b = 0; b < 2; ++b)
#pragma unroll
                for (int m = 0; m < 4; ++m)
#pragma unroll
                    for (int n = 0; n < 2; ++n) acc[a][b][m][n] = (f32x4){0.f, 0.f, 0.f, 0.f};
        cur = nxt; cA = nA; cB = nB; ++ui;
        if constexpr (ALIGN_EPI) { if (wr == 1) PG8_BAR; }
    }
    PG8_WAIT_V(0);
    if constexpr (!ALIGN_EPI) { if (wr == 0) PG8_BAR; }
    PG8_BAR;
    if constexpr (Epi::AFTER_DRAIN) { E.fused(acc, cur, wr, wc, fr, fq, lds, wid, lane); S.done(cur); }
#undef PG8_SA
#undef PG8_SB
#undef PG8_STAGE
#undef PG8_LDA
#undef PG8_LDB
#undef PG8_MMA
#undef PG8_WAIT_V
#undef PG8_WAIT_L
#undef PG8_BAR
#undef PG8_SCHED
}
}
namespace pg8 {
template <class Epi, class Sched, int MODE, bool ALIGN_EPI = true>
__device__ __forceinline__ void gemm_grouped(PG8_LAS unsigned char* lds, const Gemm g, const Sched& S, const Epi& E) {
    constexpr bool SP2 = true;
    const int tid = threadIdx.x, wid = __builtin_amdgcn_readfirstlane(tid >> 6), lane = tid & 63, wr = wid >> 2, wc = wid & 3, fr = lane & 15, fq = lane >> 4;
    const int K = g.K, nt = K / BK;
    unsigned voffA[2], voffB[2];
#pragma unroll
    for (int i = 0; i < 2; ++i) { int R, C; stage_rc(tid * 16 + i * 8192, R, C); const int Rb = Epi::PERM ? ((R & ~31) + perm32(R & 31)) : R;
        voffA[i] = (unsigned)(R * K + C) * 2u; voffB[i] = (unsigned)(Rb * K + C) * 2u; }
    const size_t kstep = (size_t)(BK * 2);
    const size_t hstep = (size_t)HALF * K * 2;
    const size_t tstep = 2 * hstep;
    const unsigned ldsw = (unsigned)wid * 1024u;
    const int aoff = lds_byte(wr * 64 + fr, fq * 8), boff = lds_byte(wc * 32 + fr, fq * 8);
#define PG8_SA(b, h) (((b) * 2 + (h)) * HTB)
#define PG8_SB(b, h) ((4 + (b) * 2 + (h)) * HTB)
#define PG8_STAGE(bufoff, gbase, voff) do { _Pragma("unroll") for (int _i = 0; _i < 2; ++_i) \
        __builtin_amdgcn_global_load_lds((const unsigned*)((const char*)(gbase) + (voff)[_i]), (PG8_LAS unsigned*)(lds + (bufoff) + ldsw + _i * 8192), 16, 0, 0); } while (0)
#define PG8_STAGE_A(bufoff, kptr, h, nx) do { if (MODE == 0) { unsigned _v[2]; _v[0] = (nx) ? nvA[h][0] : cvA[h][0]; _v[1] = (nx) ? nvA[h][1] : cvA[h][1]; PG8_STAGE(bufoff, kptr, _v); } else { PG8_STAGE(bufoff, (kptr) + (h) * hstep, voffA); } } while (0)
#define PG8_LDA(dst, b, h) do { _Pragma("unroll") for (int m = 0; m < 4; ++m) _Pragma("unroll") for (int k = 0; k < 2; ++k) dst[m][k] = *(const PG8_LAS bf16x8*)(lds + PG8_SA(b, h) + aoff + m * 2048 + k * 1024); } while (0)
#define PG8_LDB(dst, b, h) do { _Pragma("unroll") for (int n = 0; n < 2; ++n) _Pragma("unroll") for (int k = 0; k < 2; ++k) dst[n][k] = *(const PG8_LAS bf16x8*)(lds + PG8_SB(b, h) + boff + n * 2048 + k * 1024); } while (0)
#define PG8_MMA(ai, bj, At, Bt) do { __builtin_amdgcn_s_setprio(1); _Pragma("unroll") for (int m = 0; m < 4; ++m) _Pragma("unroll") for (int n = 0; n < 2; ++n) _Pragma("unroll") for (int k = 0; k < 2; ++k) \
        acc[ai][bj][m][n] = __builtin_amdgcn_mfma_f32_16x16x32_bf16(Bt[n][k], At[m][k], acc[ai][bj][m][n], 0, 0, 0); __builtin_amdgcn_s_setprio(0); } while (0)
#define PG8_WAIT_V(n) asm volatile("s_waitcnt vmcnt(" #n ")" ::: "memory")
#define PG8_WAIT_L(n) asm volatile("s_waitcnt lgkmcnt(" #n ")" ::: "memory")
#define PG8_BAR __builtin_amdgcn_s_barrier()
#define PG8_SCHED __builtin_amdgcn_sched_barrier(0)
    GUnit cur, nxt; int ui = 0;
    if (!S.next(0, cur)) return;
    unsigned cvA[2][2], nvA[2][2];
    if (MODE == 0) S.rows(cur, voffA, cvA);
    f32x4 acc[2][2][4][2];
#pragma unroll
    for (int a = 0; a < 2; ++a)
#pragma unroll
        for (int b = 0; b < 2; ++b)
#pragma unroll
            for (int m = 0; m < 4; ++m)
#pragma unroll
                for (int n = 0; n < 2; ++n) acc[a][b][m][n] = (f32x4){0.f, 0.f, 0.f, 0.f};
    bf16x8 At[4][2], B0[2][2], B1[2][2];
    const size_t estep = (size_t)g.N * K * 2;
    const char* cA = (const char*)g.A + (MODE == 0 ? (size_t)0 : (size_t)cur.pm * tstep); const char* cB = (const char*)g.Bt + (size_t)cur.e * estep + (size_t)cur.pn * tstep;
    S.a_ready(cur);
    if constexpr (SP2) {
        PG8_STAGE(PG8_SB(0, 0), cB, voffB); PG8_STAGE(PG8_SB(0, 1), cB + hstep, voffB); PG8_STAGE_A(PG8_SA(0, 0), cA, 0, false); PG8_STAGE_A(PG8_SA(0, 1), cA, 1, false);
        if (wr == 1) PG8_BAR;
        PG8_WAIT_V(2); PG8_BAR;
        PG8_STAGE(PG8_SB(1, 0), cB + kstep, voffB); PG8_STAGE_A(PG8_SA(1, 0), cA + kstep, 0, false); PG8_STAGE(PG8_SB(1, 1), cB + hstep + kstep, voffB);
        PG8_WAIT_V(6); PG8_BAR;
    } else {
        PG8_STAGE(PG8_SB(0, 0), cB, voffB); PG8_STAGE(PG8_SA(0, 0), cA, voffA); PG8_STAGE(PG8_SB(0, 1), cB + hstep, voffB); PG8_STAGE(PG8_SA(0, 1), cA + hstep, voffA);
        if (wr == 1) PG8_BAR;
        PG8_WAIT_V(4); PG8_BAR;
        PG8_STAGE(PG8_SB(1, 0), cB + kstep, voffB); PG8_STAGE_A(PG8_SA(1, 0), cA + kstep, 0, false); PG8_STAGE(PG8_SB(1, 1), cB + hstep + kstep, voffB);
        PG8_WAIT_V(6); PG8_BAR;
    }
    for (;;) {
        const bool has_next = S.next(ui + 1, nxt);
        const char* nA = (MODE == 0) ? cA : (has_next ? (const char*)g.A + (size_t)nxt.pm * tstep : cA); const char* nB = has_next ? (const char*)g.Bt + (size_t)nxt.e * estep + (size_t)nxt.pn * tstep : cB;
        if (MODE == 0) { if (has_next) S.rows(nxt, voffA, nvA); else { nvA[0][0] = cvA[0][0]; nvA[0][1] = cvA[0][1]; nvA[1][0] = cvA[1][0]; nvA[1][1] = cvA[1][1]; } }
        for (int t = 0; t < nt; t += 2) {
            const bool last = (t == nt - 2);
            const char* a1 = cA + (size_t)(t + 1) * kstep;
            const char* a2 = last ? nA : cA + (size_t)(t + 2) * kstep; const char* b2 = last ? nB : cB + (size_t)(t + 2) * kstep;
            const char* a3 = a2 + kstep; const char* b3 = b2 + kstep;
            if (last && has_next) S.a_ready(nxt);
            if constexpr (SP2) {
            PG8_LDB(B0, 0, 0); PG8_LDB(B1, 0, 1); PG8_SCHED; PG8_LDA(At, 0, 0); PG8_STAGE_A(PG8_SA(1, 1), a1, 1, false);
            PG8_WAIT_V(8); PG8_WAIT_L(0); PG8_BAR; PG8_MMA(0, 0, At, B0); PG8_MMA(0, 1, At, B1); PG8_BAR; PG8_SCHED;
            PG8_LDA(At, 0, 1); PG8_STAGE(PG8_SB(0, 0), b2, voffB); PG8_STAGE(PG8_SB(0, 1), b2 + hstep, voffB); PG8_STAGE_A(PG8_SA(0, 0), a2, 0, last);
            PG8_WAIT_V(8); PG8_WAIT_L(0); PG8_BAR; PG8_MMA(1, 0, At, B0); PG8_MMA(1, 1, At, B1); PG8_BAR; PG8_SCHED;
            PG8_LDB(B0, 1, 0); PG8_LDB(B1, 1, 1); PG8_SCHED; PG8_LDA(At, 1, 0); PG8_STAGE_A(PG8_SA(0, 1), a2, 1, last);
            PG8_WAIT_V(8); PG8_WAIT_L(0); PG8_BAR; PG8_MMA(0, 0, At, B0); PG8_MMA(0, 1, At, B1); PG8_BAR; PG8_SCHED;
            PG8_LDA(At, 1, 1); PG8_STAGE(PG8_SB(1, 0), b3, voffB); PG8_STAGE(PG8_SB(1, 1), b3 + hstep, voffB); PG8_STAGE_A(PG8_SA(1, 0), a3, 0, last);
            PG8_WAIT_V(8); PG8_WAIT_L(0); PG8_BAR; PG8_MMA(1, 0, At, B0); PG8_MMA(1, 1, At, B1); PG8_BAR; PG8_SCHED;
            } else {
            PG8_LDB(B0, 0, 0); PG8_SCHED; PG8_LDA(At, 0, 0); PG8_STAGE_A(PG8_SA(1, 1), a1, 1, false);
            PG8_WAIT_L(8); PG8_BAR; PG8_WAIT_L(0); PG8_MMA(0, 0, At, B0); PG8_BAR; PG8_SCHED;
            PG8_LDB(B1, 0, 1); PG8_STAGE(PG8_SB(0, 0), b2, voffB);
            PG8_BAR; PG8_WAIT_L(0); PG8_MMA(0, 1, At, B1); PG8_BAR;
            PG8_LDA(At, 0, 1); PG8_STAGE_A(PG8_SA(0, 0), a2, 0, last);
            PG8_BAR; PG8_WAIT_L(0); PG8_MMA(1, 0, At, B0); PG8_BAR; PG8_SCHED;
            PG8_STAGE(PG8_SB(0, 1), b2 + hstep, voffB);
            PG8_WAIT_V(6); PG8_BAR; PG8_MMA(1, 1, At, B1); PG8_BAR;
            PG8_LDB(B0, 1, 0); PG8_SCHED; PG8_LDA(At, 1, 0); PG8_STAGE_A(PG8_SA(0, 1), a2, 1, last);
            PG8_WAIT_L(8); PG8_BAR; PG8_WAIT_L(0); PG8_MMA(0, 0, At, B0); PG8_BAR; PG8_SCHED;
            PG8_LDB(B1, 1, 1); PG8_STAGE(PG8_SB(1, 0), b3, voffB);
            PG8_BAR; PG8_WAIT_L(0); PG8_MMA(0, 1, At, B1); PG8_BAR;
            PG8_LDA(At, 1, 1); PG8_STAGE_A(PG8_SA(1, 0), a3, 0, last);
            PG8_BAR; PG8_WAIT_L(0); PG8_MMA(1, 0, At, B0); PG8_BAR; PG8_SCHED;
            PG8_STAGE(PG8_SB(1, 1), b3 + hstep, voffB);
            PG8_WAIT_V(6); PG8_BAR; PG8_MMA(1, 1, At, B1); PG8_BAR;
            }
        }
        if constexpr (ALIGN_EPI) { if (wr == 0) PG8_BAR; }
        if constexpr (!Epi::AFTER_DRAIN) { E(acc, cur, wr, wc, fr, fq); S.done(cur); }
        if (!has_next) break;
#pragma unroll
        for (int a = 0; a < 2; ++a)
#pragma unroll
            for (int b = 0; b < 2; ++b)
#pragma unroll
                for (int m = 0; m < 4; ++m)
#pragma unroll
                    for (int n = 0; n < 2; ++n) acc[a][b][m][n] = (f32x4){0.f, 0.f, 0.f, 0.f};
        cur = nxt; cA = nA; cB = nB; ++ui;
        if (MODE == 0) { cvA[0][0] = nvA[0][0]; cvA[0][1] = nvA[0][1]; cvA[1][0] = nvA[1][0]; cvA[1][1] = nvA[1][1]; }
        if constexpr (ALIGN_EPI) { if (wr == 1) PG8_BAR; }
    }
    PG8_WAIT_V(0);
    if constexpr (!ALIGN_EPI) { if (wr == 0) PG8_BAR; }
    PG8_BAR;
    if constexpr (Epi::AFTER_DRAIN) { E.fused(acc, cur, wr, wc, fr, fq, lds, wid, lane); S.done(cur); }
#undef PG8_SA
#undef PG8_SB
#undef PG8_STAGE
#undef PG8_STAGE_A
#undef PG8_LDA
#undef PG8_LDB
#undef PG8_MMA
#undef PG8_WAIT_V
#undef PG8_WAIT_L
#undef PG8_BAR
#undef PG8_SCHED
}
}
namespace pg8 {
__device__ __forceinline__ float fast_sigmoid(float x) { return __builtin_amdgcn_rcpf(1.f + __expf(-x)); }
__device__ __forceinline__ float fast_gelu_tanh(float x) { const float t = 1.5957691216057308f * (x + 0.044715f * x * x * x); return x * __builtin_amdgcn_rcpf(1.f + __expf(-t)); }
__device__ __forceinline__ u32x4 pack8(const f32x4 a, const f32x4 b) { u32x4 w; w.x = cvt_pk_bf16(a[0], a[1]); w.y = cvt_pk_bf16(a[2], a[3]); w.z = cvt_pk_bf16(b[0], b[1]); w.w = cvt_pk_bf16(b[2], b[3]); return w; }

struct EpiProj {
    static constexpr bool PERM = true, AFTER_DRAIN = false;
    const float* rs1; const float* bg; const float* qg; const float* kg; const float* cosT; const float* sinT;
    bf16_t *QP, *KP, *VB, *LRX, *LRG, *GA, *GL;
    __device__ __forceinline__ void operator()(const f32x4 (&acc)[2][2][4][2], const Unit& u, int wr, int wc, int fr, int fq) const {
        const int type = u.pn >> 2;
        const int rowt = u.pm * BM + wr * 64 + fr;
        const int b = (u.pm * BM) >> 12;
        if (type <= 1) {
            const bool isq = (type == 0);
            const float* gsrc = isq ? qg : kg;
            f32x4 g[2][2];
#pragma unroll
            for (int bj = 0; bj < 2; ++bj)
#pragma unroll
                for (int n = 0; n < 2; ++n) g[bj][n] = *(const f32x4*)(gsrc + 32 * bj + 8 * fq + 4 * n);
            const int hc = (u.pn & 3) * 4 + wc;
            bf16_t* dstbase = (isq ? QP : KP) + ((size_t)(b * 16 + hc) * 4096) * 64 + 8 * fq;
            const float osc = isq ? (0.125f * 1.4426950408889634f) : 1.f;
#pragma unroll
            for (int ai = 0; ai < 2; ++ai)
#pragma unroll
                for (int m = 0; m < 4; ++m) {
                    const int row = rowt + ai * HALF + m * 16; const int pos = row & 4095; const float rsv = rs1[row];
                    f32x4 v[2][2]; float ss = 0.f;
#pragma unroll
                    for (int bj = 0; bj < 2; ++bj)
#pragma unroll
                        for (int n = 0; n < 2; ++n) { v[bj][n] = acc[ai][bj][m][n] * rsv; const f32x4 q = v[bj][n] * v[bj][n]; ss += (q[0] + q[1]) + (q[2] + q[3]); }
                    ss += __shfl_xor(ss, 16); ss += __shfl_xor(ss, 32);
                    const float rn = rsqrtf(ss * (1.f / 64.f) + 1e-6f);
                    f32x4 o0[2], o1[2];
#pragma unroll
                    for (int n = 0; n < 2; ++n) {
                        const f32x4 c = *(const f32x4*)(cosT + pos * 32 + 8 * fq + 4 * n), s = *(const f32x4*)(sinT + pos * 32 + 8 * fq + 4 * n);
                        const f32x4 y0 = v[0][n] * rn * g[0][n], y1 = v[1][n] * rn * g[1][n];
                        o0[n] = (y0 * c - y1 * s) * osc; o1[n] = (y0 * s + y1 * c) * osc;
                    }
                    bf16_t* dst = dstbase + (size_t)pos * 64;
                    *(u32x4*)dst = pack8(o0[0], o0[1]);
                    *(u32x4*)(dst + 32) = pack8(o1[0], o1[1]);
                }
        } else {
            const int colt = (u.pn & 3) * 256 + wc * 32 + 8 * fq;
#pragma unroll
            for (int ai = 0; ai < 2; ++ai)
#pragma unroll
                for (int m = 0; m < 4; ++m) {
                    const int row = rowt + ai * HALF + m * 16; const int pos = row & 4095; const float rsv = rs1[row];
#pragma unroll
                    for (int bj = 0; bj < 2; ++bj) {
                        const int col = colt + 128 * bj;
                        f32x4 v0 = acc[ai][bj][m][0] * rsv, v1 = acc[ai][bj][m][1] * rsv;
                        bf16_t* dst;
                        if (type == 2) { dst = VB + ((size_t)((b * 8 + (col >> 7)) * 4096 + pos)) * 128 + (col & 127); }
                        else if (type == 3) { dst = LRX + (size_t)row * 1024 + col; }
                        else if (type == 4) {
                            dst = LRG + (size_t)row * 1024 + col;
#pragma unroll
                            for (int j = 0; j < 4; ++j) { v0[j] = fast_gelu_tanh(v0[j]); v1[j] = fast_gelu_tanh(v1[j]); }
                        } else {
                            const float* bp = bg + (type == 6 ? 1024 : 0) + col;
                            const f32x4 b0 = *(const f32x4*)bp, b1 = *(const f32x4*)(bp + 4);
                            dst = (type == 5 ? GA : GL) + (size_t)row * 1024 + col;
#pragma unroll
                            for (int j = 0; j < 4; ++j) { v0[j] = fast_sigmoid(v0[j] + b0[j]); v1[j] = fast_sigmoid(v1[j] + b1[j]); }
                        }
                        *(u32x4*)dst = pack8(v0, v1);
                    }
                }
        }
    }
};
__device__ __forceinline__ void unpack8(const u32x4 w, f32x4& a, f32x4& b) {
    a[0] = __uint_as_float(w.x << 16); a[1] = __uint_as_float(w.x & 0xffff0000u); a[2] = __uint_as_float(w.y << 16); a[3] = __uint_as_float(w.y & 0xffff0000u);
    b[0] = __uint_as_float(w.z << 16); b[1] = __uint_as_float(w.z & 0xffff0000u); b[2] = __uint_as_float(w.w << 16); b[3] = __uint_as_float(w.w & 0xffff0000u);
}
template <int PASS> struct EpiMerge {
    static constexpr bool PERM = true, AFTER_DRAIN = false;
    bf16_t* M; const bf16_t* G;
    __device__ __forceinline__ void operator()(const f32x4 (&acc)[2][2][4][2], const Unit& u, int wr, int wc, int fr, int fq) const {
        const int row0 = u.pm * BM + wr * 64 + fr, col0 = u.pn * BM + wc * 32 + 8 * fq;
#pragma unroll
        for (int ai = 0; ai < 2; ++ai)
#pragma unroll
            for (int m = 0; m < 4; ++m)
#pragma unroll
                for (int bj = 0; bj < 2; ++bj) {
                    const size_t idx = (size_t)(row0 + ai * HALF + m * 16) * 1024 + col0 + bj * HALF;
                    f32x4 g0, g1; unpack8(*(const u32x4*)(G + idx), g0, g1);
                    f32x4 v0 = acc[ai][bj][m][0] * g0, v1 = acc[ai][bj][m][1] * g1;
                    if (PASS == 2) { f32x4 t0, t1; unpack8(*(const u32x4*)(M + idx), t0, t1); v0 += t0; v1 += t1; }
                    *(u32x4*)(M + idx) = pack8(v0, v1);
                }
    }
};
struct EpiResid {
    static constexpr bool PERM = false, AFTER_DRAIN = false;
    const float* X; float* O;
    __device__ __forceinline__ void operator()(const f32x4 (&acc)[2][2][4][2], const Unit& u, int wr, int wc, int fr, int fq) const {
        const int row0 = u.pm * BM + wr * 64 + fr, col0 = u.pn * BM + wc * 32 + 4 * fq;
#pragma unroll
        for (int ai = 0; ai < 2; ++ai)
#pragma unroll
            for (int m = 0; m < 4; ++m)
#pragma unroll
                for (int bj = 0; bj < 2; ++bj)
#pragma unroll
                    for (int n = 0; n < 2; ++n) {
                        const size_t idx = (size_t)(row0 + ai * HALF + m * 16) * 1024 + col0 + bj * HALF + n * 16;
                        *(f32x4*)(O + idx) = *(const f32x4*)(X + idx) + acc[ai][bj][m][n];
                    }
    }
};
}

constexpr int NWAVES = 8;
constexpr int RING_OFF = 0, RING_BYTES = 131072;
constexpr int LDSCTL_OFF = RING_BYTES, MISC_OFF = LDSCTL_OFF + 320;
constexpr int LDS_BYTES = 147456;
constexpr size_t WS_CTL = WS_S7, CTL_ZERO_BYTES = 1 * MiB;
constexpr size_t WS_SEL_E = WS_S7 + 1 * MiB, WS_SEL_W = WS_S7 + 2 * MiB;
constexpr size_t WS_RS1 = WS_S7 + 3 * MiB;
constexpr size_t WS_COS = WS_S7 + 3 * MiB + 512 * 1024, WS_SIN = WS_S7 + 4 * MiB;
constexpr size_t WS_WINT = WS_S7 + 5 * MiB;
constexpr size_t WS_WAT = WS_S7 + 19 * MiB, WS_WLT = WS_S7 + 21 * MiB, WS_WOT = WS_S7 + 23 * MiB;
constexpr size_t WS_LRUW = WS_S7 + 25 * MiB;
constexpr size_t WS_LRUS = WS_S7 + 26 * MiB;
constexpr size_t WS_LIST = WS_S7 + 30 * MiB;
constexpr int CW_BAR = 4096, CW_CNT = 8192;

#define GAS __attribute__((address_space(1)))
#define LAS __attribute__((address_space(3)))
typedef unsigned v4u __attribute__((ext_vector_type(4)));
typedef float f32x4 __attribute__((ext_vector_type(4)));
typedef GAS unsigned gu32;
typedef GAS unsigned long long gu64;
#define RLX_AGENT __ATOMIC_RELAXED, __HIP_MEMORY_SCOPE_AGENT
#define LDS_WAIT() asm volatile("s_waitcnt lgkmcnt(0)" ::: "memory")
#define VM_WAIT() asm volatile("s_waitcnt vmcnt(0)" ::: "memory")
__device__ __forceinline__ unsigned pk2(float lo, float hi) { return (unsigned)f2bf(lo) | ((unsigned)f2bf(hi) << 16); }
namespace pg8 {
struct GroupedOrder {
    const PG8_LAS int* tb;
    const int* listT;
    int G, c, nct;
    __device__ __forceinline__ bool next(int i, GUnit& u) const {
        const int L = i * G + c; const int Tn = __builtin_amdgcn_readfirstlane(tb[16]);
        if (L >= Tn * nct) return false;
        const int rt = L / nct; u.pn = L % nct; u.pm = rt;
        int e = 0;
#pragma unroll
        for (int k = 1; k < 16; ++k) e += (rt >= __builtin_amdgcn_readfirstlane(tb[k])) ? 1 : 0;
        u.e = e; u.pos0 = (rt - __builtin_amdgcn_readfirstlane(tb[e])) * 256; u.cnt = __builtin_amdgcn_readfirstlane(tb[32 + e]);
        return true;
    }
    __device__ __forceinline__ void rows(const GUnit& u, const unsigned (&voffA)[2], unsigned (&out)[2][2]) const {
#pragma unroll
        for (int h = 0; h < 2; ++h)
#pragma unroll
            for (int i = 0; i < 2; ++i) {
                const int R = (int)(voffA[i] >> 11) + 128 * h, pos = u.pos0 + R;
                const int tok = (pos < u.cnt) ? (listT[u.e * 16384 + pos] >> 1) : 0;
                out[h][i] = (unsigned)tok * 2048u + (voffA[i] & 2047u);
            }
    }
    __device__ __forceinline__ void a_ready(const GUnit&) const {}
    __device__ __forceinline__ void done(const GUnit&) const {}
};
struct EpiUp {
    static constexpr bool PERM = true, AFTER_DRAIN = false;
    bf16_t* HID; const float* listW;
    __device__ __forceinline__ void operator()(const f32x4 (&acc)[2][2][4][2], const GUnit& u, int wr, int wc, int fr, int fq) const {
        const int f0 = u.pn * 128 + wc * 32 + 8 * fq;
#pragma unroll
        for (int ai = 0; ai < 2; ++ai)
#pragma unroll
            for (int m = 0; m < 4; ++m) {
                const int r = ai * HALF + wr * 64 + m * 16 + fr, pos = u.pos0 + r;
                const float w = (pos < u.cnt) ? listW[u.e * 16384 + pos] : 0.f;
                f32x4 h0, h1;
#pragma unroll
                for (int j = 0; j < 4; ++j) {
                    const float g0 = acc[ai][0][m][0][j], g1 = acc[ai][0][m][1][j];
                    h0[j] = g0 * __builtin_amdgcn_rcpf(1.f + __expf(-g0)) * acc[ai][1][m][0][j] * w;
                    h1[j] = g1 * __builtin_amdgcn_rcpf(1.f + __expf(-g1)) * acc[ai][1][m][1][j] * w;
                }
                *(u32x4*)(HID + (size_t)(u.pm * BM + r) * 512 + f0) = pack8(h0, h1);
            }
    }
};
struct EpiDown {
    static constexpr bool PERM = true, AFTER_DRAIN = false;
    bf16_t* Y0; size_t ystride; const int* listT;
    __device__ __forceinline__ void operator()(const f32x4 (&acc)[2][2][4][2], const GUnit& u, int wr, int wc, int fr, int fq) const {
        const int col0 = u.pn * BM + wc * 32 + 8 * fq;
#pragma unroll
        for (int ai = 0; ai < 2; ++ai)
#pragma unroll
            for (int m = 0; m < 4; ++m) {
                const int r = ai * HALF + wr * 64 + m * 16 + fr, pos = u.pos0 + r;
                if (pos < u.cnt) {
                    const int ent = listT[u.e * 16384 + pos];
                    bf16_t* Y = Y0 + (size_t)(ent & 1) * ystride + (size_t)(ent >> 1) * 1024 + col0;
                    *(u32x4*)Y = pack8(acc[ai][0][m][0], acc[ai][0][m][1]);
                    *(u32x4*)(Y + HALF) = pack8(acc[ai][1][m][0], acc[ai][1][m][1]);
                }
            }
    }
};
}
namespace att {
using bf16x8 = __attribute__((ext_vector_type(8))) short;
using s16x4  = __attribute__((ext_vector_type(4))) short;
using f32x16 = __attribute__((ext_vector_type(16))) float;
using u32x4  = __attribute__((ext_vector_type(4))) unsigned;
constexpr int NW = 8, QBLK = 32, KVBLK = 64;
constexpr int SHM_K = KVBLK * 64 * 2, SHM_V = KVBLK * 128 * 2;
constexpr int LDS_V = 0, LDS_K = 2 * SHM_V, LDS_WS = LDS_K + 2 * SHM_K, LDS_OST = LDS_WS + NW * 256, LDS_END = LDS_OST + NW * 8192;
static_assert(LDS_END <= 131072, "attention LDS");
#define ATT_KSWZ(row, c16) ((row) * 128 + ((((c16) ^ ((row) >> 1)) & 7) << 4))
#define ATT_SBAR() __builtin_amdgcn_sched_barrier(0)
__device__ __forceinline__ int crow(int r, int hi) { return (r & 3) + 8 * (r >> 2) + 4 * hi; }
__device__ __forceinline__ unsigned cvtpk(float lo, float hi) { unsigned r; asm volatile("v_cvt_pk_bf16_f32 %0, %1, %2" : "=v"(r) : "v"(lo), "v"(hi)); return r; }

__device__ __forceinline__ void partialSM(f32x16& p0) {
#pragma unroll
  for (int r = 0; r < 16; ++r) p0[r] = __builtin_amdgcn_exp2f(p0[r]);
}
__device__ __forceinline__ void finishSM(f32x16& p0, f32x16& p1, float& l_reg, bf16x8& pa0, bf16x8& pa1, bf16x8& pa2, bf16x8& pa3) {
#pragma unroll
  for (int r = 0; r < 16; ++r) p1[r] = __builtin_amdgcn_exp2f(p1[r]);
  float ps = 0.f;
#pragma unroll
  for (int r = 0; r < 16; ++r) ps += p0[r];
#pragma unroll
  for (int r = 0; r < 16; ++r) ps += p1[r];
  l_reg += ps;
#define ATT_PK4(P, BASE, OUT) do { unsigned a0 = cvtpk(P[BASE + 0], P[BASE + 1]), a1 = cvtpk(P[BASE + 2], P[BASE + 3]);   \
    unsigned b0 = cvtpk(P[BASE + 4], P[BASE + 5]), b1 = cvtpk(P[BASE + 6], P[BASE + 7]);                              \
    auto r0 = __builtin_amdgcn_permlane32_swap(a0, b0, false, false); auto r1 = __builtin_amdgcn_permlane32_swap(a1, b1, false, false); \
    u32x4 w = {r0[0], r1[0], r0[1], r1[1]}; OUT = *reinterpret_cast<bf16x8*>(&w); } while (0)
  ATT_PK4(p0, 0, pa0); ATT_PK4(p0, 8, pa1); ATT_PK4(p1, 0, pa2); ATT_PK4(p1, 8, pa3);
#undef ATT_PK4
}
__device__ __forceinline__ void qkt(f32x16& p0, f32x16& p1, const char* Ks, const bf16x8* qr, int r32, int hi) {
  p0 = f32x16{}; p1 = f32x16{};
#pragma unroll
  for (int d0 = 0; d0 < 4; ++d0) { const int c16 = d0 * 2 + hi;
    const bf16x8 b0 = *reinterpret_cast<const bf16x8*>(Ks + ATT_KSWZ(r32, c16));
    const bf16x8 b1 = *reinterpret_cast<const bf16x8*>(Ks + ATT_KSWZ(32 + r32, c16));
    p0 = __builtin_amdgcn_mfma_f32_32x32x16_bf16(b0, qr[d0], p0, 0, 0, 0);
    p1 = __builtin_amdgcn_mfma_f32_32x32x16_bf16(b1, qr[d0], p1, 0, 0, 0); }
}
__device__ __forceinline__ int v_st(int k, int c) { const int kk = (k & ~0xC) | ((k & 4) << 1) | ((k & 8) >> 1); return ((kk >> 3) * 4 + (c >> 5)) * 512 + ((kk & 7) * 32 + (c & 31)) * 2; }
__device__ __forceinline__ int v_rd_base(int lane) { return ((lane & 3) << 3) | (((lane >> 2) & 3) << 6) | (((lane >> 4) & 1) << 5) | (((lane >> 5) & 1) << 8); }
constexpr int v_rd_off(int d0, int ks, int half) { return d0 * 512 + ks * 4096 + half * 2048; }
template <int OFF> __device__ __forceinline__ s16x4 tr_read(int vb) {
  s16x4 r; asm volatile("ds_read_b64_tr_b16 %0, %1 offset:%2" : "=&v"(r) : "v"(vb), "i"(OFF) : "memory"); return r;
}
template <int D0> __device__ __forceinline__ void pv_one(f32x16& od, int vb, bf16x8 pa0, bf16x8 pa1, bf16x8 pa2, bf16x8 pa3) {
  const s16x4 l0 = tr_read<v_rd_off(D0, 0, 0)>(vb), h0 = tr_read<v_rd_off(D0, 0, 1)>(vb), l1 = tr_read<v_rd_off(D0, 1, 0)>(vb), h1 = tr_read<v_rd_off(D0, 1, 1)>(vb);
  const s16x4 l2 = tr_read<v_rd_off(D0, 2, 0)>(vb), h2 = tr_read<v_rd_off(D0, 2, 1)>(vb), l3 = tr_read<v_rd_off(D0, 3, 0)>(vb), h3 = tr_read<v_rd_off(D0, 3, 1)>(vb);
  asm volatile("s_waitcnt lgkmcnt(0)" ::: "memory"); ATT_SBAR();
#define ATT_PK(L, H) (bf16x8){L[0], L[1], L[2], L[3], H[0], H[1], H[2], H[3]}
  od = __builtin_amdgcn_mfma_f32_32x32x16_bf16(pa0, ATT_PK(l0, h0), od, 0, 0, 0);
  od = __builtin_amdgcn_mfma_f32_32x32x16_bf16(pa1, ATT_PK(l1, h1), od, 0, 0, 0);
  od = __builtin_amdgcn_mfma_f32_32x32x16_bf16(pa2, ATT_PK(l2, h2), od, 0, 0, 0);
  od = __builtin_amdgcn_mfma_f32_32x32x16_bf16(pa3, ATT_PK(l3, h3), od, 0, 0, 0);
#undef ATT_PK
}
__device__ __forceinline__ void pv_d0(f32x16* o, int vb, bf16x8 pa0, bf16x8 pa1, bf16x8 pa2, bf16x8 pa3) {
  pv_one<0>(o[0], vb, pa0, pa1, pa2, pa3); pv_one<1>(o[1], vb, pa0, pa1, pa2, pa3); pv_one<2>(o[2], vb, pa0, pa1, pa2, pa3); pv_one<3>(o[3], vb, pa0, pa1, pa2, pa3);
}

__device__ __forceinline__ void attn_unit(const bf16_t* __restrict__ Qb, const bf16_t* __restrict__ Kh, const bf16_t* __restrict__ Vh, bf16_t* __restrict__ Ob, char* lds) {
  const int tid = threadIdx.x, wid = tid >> 6, lane = tid & 63, r32 = lane & 31, hi = lane >> 5;
  char* V_lds = lds + LDS_V; char* K_lds = lds + LDS_K;
  float* wsf = (float*)(lds + LDS_WS) + wid * 64;
  float l_reg = 0.f; f32x16 o[4] = {}; bf16x8 qr[4];
  const bf16_t* Qw = Qb + (size_t)(wid * QBLK + r32) * 64 + hi * 8;
#pragma unroll
  for (int d0 = 0; d0 < 4; ++d0) qr[d0] = *reinterpret_cast<const bf16x8*>(Qw + d0 * 16);
  const int kst = ATT_KSWZ(tid >> 3, tid & 7);
  const int vst0 = v_st(tid >> 4, (tid & 15) * 8), vst1 = v_st(32 + (tid >> 4), (tid & 15) * 8);
  const int vb0 = (int)(uintptr_t)V_lds + v_rd_base(lane);
  struct { bf16x8 ks, vs0, vs1; } sr_[1];
#define ATT_SLOAD(i, t) do { sr_[i].ks = *reinterpret_cast<const bf16x8*>(Kh + (size_t)(t) * (KVBLK * 64) + tid * 8); \
    sr_[i].vs0 = *reinterpret_cast<const bf16x8*>(Vh + (size_t)(t) * (KVBLK * 128) + tid * 8); \
    sr_[i].vs1 = *reinterpret_cast<const bf16x8*>(Vh + (size_t)(t) * (KVBLK * 128) + 4096 + tid * 8); } while (0)
#define ATT_SWRITE(b, i) do { *(bf16x8*)(K_lds + (b) * SHM_K + kst) = sr_[i].ks; \
    *(bf16x8*)(V_lds + (b) * SHM_V + vst0) = sr_[i].vs0; *(bf16x8*)(V_lds + (b) * SHM_V + vst1) = sr_[i].vs1; } while (0)
#define ATT_SWAIT() asm volatile("s_waitcnt vmcnt(0)" ::: "memory")
  f32x16 pA0, pA1, pB0, pB1; bf16x8 pa0, pa1, pa2, pa3; constexpr int NT = 4096 / KVBLK;
  constexpr int SE = 0, SO = 0;
  __syncthreads();
  ATT_SLOAD(SE, 0); asm volatile("s_waitcnt vmcnt(0)" ::: "memory"); ATT_SWRITE(0, SE); __syncthreads();
  qkt(pA0, pA1, K_lds, qr, r32, hi); partialSM(pA0);
  ATT_SLOAD(SO, 1);
  ATT_SWAIT(); ATT_SWRITE(1, SO); __syncthreads();
  for (int j = 1; j + 1 < NT; j += 2) {
    ATT_SBAR(); qkt(pB0, pB1, K_lds + SHM_K, qr, r32, hi);
    finishSM(pA0, pA1, l_reg, pa0, pa1, pa2, pa3); ATT_SBAR();
    ATT_SLOAD(SO, j + 1); ATT_SBAR();
    pv_d0(o, vb0, pa0, pa1, pa2, pa3); partialSM(pB0);
    __syncthreads(); ATT_SWAIT(); ATT_SWRITE(0, SE);
    __syncthreads();
    ATT_SBAR(); qkt(pA0, pA1, K_lds, qr, r32, hi);
    finishSM(pB0, pB1, l_reg, pa0, pa1, pa2, pa3); ATT_SBAR();
    ATT_SLOAD(SE, j + 2); ATT_SBAR();
    pv_d0(o, vb0 + SHM_V, pa0, pa1, pa2, pa3); partialSM(pA0);
    __syncthreads(); ATT_SWAIT(); ATT_SWRITE(1, SO);
    __syncthreads();
  }
  ATT_SBAR(); qkt(pB0, pB1, K_lds + SHM_K, qr, r32, hi);
  finishSM(pA0, pA1, l_reg, pa0, pa1, pa2, pa3); ATT_SBAR();
  pv_d0(o, vb0, pa0, pa1, pa2, pa3); partialSM(pB0);
  finishSM(pB0, pB1, l_reg, pa0, pa1, pa2, pa3); ATT_SBAR();
  pv_d0(o, vb0 + SHM_V, pa0, pa1, pa2, pa3);
  { auto rr = __builtin_amdgcn_permlane32_swap(__float_as_uint(l_reg), __float_as_uint(l_reg), false, false); l_reg = __uint_as_float(rr[0]) + __uint_as_float(rr[1]); }
  if (hi == 0) wsf[r32] = l_reg; asm volatile("s_waitcnt lgkmcnt(0)" ::: "memory");
  float rli[16];
#pragma unroll
  for (int r = 0; r < 16; ++r) rli[r] = __builtin_amdgcn_rcpf(wsf[crow(r, hi)]);
  bf16_t* stg = (bf16_t*)(lds + LDS_OST) + wid * 4096;
#pragma unroll
  for (int r = 0; r < 16; ++r) { const int orow = crow(r, hi);
#pragma unroll
    for (int d0 = 0; d0 < 4; ++d0) stg[orow * 128 + d0 * 32 + r32] = f2bf(o[d0][r] * rli[r]); }
  asm volatile("s_waitcnt lgkmcnt(0)" ::: "memory");
  bf16_t* Ow = Ob + (size_t)(wid * QBLK) * 1024;
#pragma unroll
  for (int i = 0; i < 8; ++i) { const int row = i * 4 + (lane >> 4), ch = lane & 15; const u32x4 v = *(const u32x4*)(stg + row * 128 + ch * 8); *(u32x4*)(Ow + (size_t)row * 1024 + ch * 8) = v; }
#undef ATT_SLOAD
#undef ATT_SWRITE
#undef ATT_SWAIT
}
}
namespace lru {
using bf16x8 = __attribute__((ext_vector_type(8))) short;
using f32x16 = __attribute__((ext_vector_type(16))) float;
using u32x4  = __attribute__((ext_vector_type(4))) unsigned;
typedef float f32x4_t __attribute__((ext_vector_type(4)));
constexpr int T = 64, NCH = 4096 / T;
constexpr int LDS_XR = 0, LDS_H = 16384, LDS_END = LDS_H + 2 * T * 128 * 4;
#define LRU_XSWZ(row, c16) ((row) * 256 + ((((c16) ^ (row)) & 15) << 4))
__device__ __forceinline__ int crow(int r, int hi) { return (r & 3) + 8 * (r >> 2) + 4 * hi; }
__device__ __forceinline__ float fsig(float x) { return __builtin_amdgcn_rcpf(1.f + __expf(-x)); }

template <int DIR, bool APPLY>
__device__ __forceinline__ void scan(f32x16 (&a)[2], f32x16 (&u)[2], float cin, int hi, float& Ptot, float& Hend) {
  float P[2][4], H[2][4], Pp[2][4], Hp[2][4];
#pragma unroll
  for (int rt = 0; rt < 2; ++rt)
#pragma unroll
    for (int q = 0; q < 4; ++q) {
      float p = 1.f, h = 0.f;
#pragma unroll
      for (int ii = 0; ii < 4; ++ii) { const int r = 4 * q + (DIR ? 3 - ii : ii); h = a[rt][r] * h + u[rt][r]; p *= a[rt][r]; }
      P[rt][q] = p; H[rt][q] = h;
      Pp[rt][q] = __shfl_xor(p, 32); Hp[rt][q] = __shfl_xor(h, 32);
    }
  float c = cin, pt = 1.f; float myc[2][4];
  const bool first = (hi == (DIR ? 1 : 0));
#pragma unroll
  for (int gg = 0; gg < 8; ++gg) {
    const int rt = DIR ? 1 - (gg >> 2) : (gg >> 2), q = DIR ? 3 - (gg & 3) : (gg & 3);
    const float Pf = first ? P[rt][q] : Pp[rt][q], Hf = first ? H[rt][q] : Hp[rt][q];
    const float Ps = first ? Pp[rt][q] : P[rt][q], Hs = first ? Hp[rt][q] : H[rt][q];
    const float c0 = c; c = Pf * c + Hf; const float c1 = c; c = Ps * c + Hs; pt *= Pf * Ps;
    myc[rt][q] = first ? c0 : c1;
  }
  Ptot = pt; Hend = c;
  if (APPLY) {
#pragma unroll
    for (int rt = 0; rt < 2; ++rt)
#pragma unroll
      for (int q = 0; q < 4; ++q) {
        float h = myc[rt][q];
#pragma unroll
        for (int ii = 0; ii < 4; ++ii) { const int r = 4 * q + (DIR ? 3 - ii : ii); h = a[rt][r] * h + u[rt][r]; u[rt][r] = h; }
      }
  }
}

struct Params {
  const bf16_t* LRX; const bf16_t* LRG; const bf16_t* Wt; const float* conv_w; const float* conv_b;
  const float* ba; const float* bi; const float* lam; float* SUM; bf16_t* YL;
};

template <int PASS>
__device__ __forceinline__ void lru_phase(const Params& p, char* lds, int vcu, int G) {
  const int tid = threadIdx.x, wid = tid >> 6, lane = tid & 63, r32 = lane & 31, hi = lane >> 5;
  const int dir = wid >> 2, cq = wid & 3;
  const int blk = vcu & 7, idx = vcu >> 3, nper = (NB * NCH) / (G >> 3);
  const int e = cq * 32 + r32, ch = blk * 128 + e;
  bf16x8 wb[2][8];
#pragma unroll
  for (int g = 0; g < 2; ++g)
#pragma unroll
    for (int ks = 0; ks < 8; ++ks) wb[g][ks] = *reinterpret_cast<const bf16x8*>(p.Wt + ((size_t)((dir * 2 + g) * 8 + blk) * 128 + e) * 128 + ks * 16 + hi * 8);
  const float bav = p.ba[dir * 1024 + ch], biv = p.bi[dir * 1024 + ch];
  const float c8 = -8.f * log1pf(__expf(-p.lam[dir * 1024 + ch]));
  for (int i = 0; i < nper; ++i) {
    const int un = idx * nper + i, b = un / NCH, chunk = un % NCH, t0 = chunk * T;
    const size_t rowb = (size_t)b * 4096;
    __syncthreads();
#pragma unroll
    for (int pp = 0; pp < 2; ++pp) {
      const int pc = tid + pp * 512, t = pc >> 4, c8i = pc & 15, cc = blk * 128 + c8i * 8;
      float acc8[8];
      { const f32x4_t b0 = *(const f32x4_t*)(p.conv_b + cc), b1 = *(const f32x4_t*)(p.conv_b + cc + 4);
        acc8[0] = b0[0]; acc8[1] = b0[1]; acc8[2] = b0[2]; acc8[3] = b0[3]; acc8[4] = b1[0]; acc8[5] = b1[1]; acc8[6] = b1[2]; acc8[7] = b1[3]; }
#pragma unroll
      for (int j = 0; j < 4; ++j) {
        const int ta = t0 + t - 1 + j;
        if (ta >= 0 && ta < 4096) {
          const bf16x8 xv = *reinterpret_cast<const bf16x8*>(p.LRX + (rowb + ta) * 1024 + cc);
          const f32x4_t w0 = *(const f32x4_t*)(p.conv_w + j * 1024 + cc), w1 = *(const f32x4_t*)(p.conv_w + j * 1024 + cc + 4);
#pragma unroll
          for (int k = 0; k < 4; ++k) { acc8[k] += w0[k] * bf2f((bf16_t)xv[k]); acc8[4 + k] += w1[k] * bf2f((bf16_t)xv[4 + k]); }
        }
      }
      u32x4 w; w.x = pk2(acc8[0], acc8[1]); w.y = pk2(acc8[2], acc8[3]); w.z = pk2(acc8[4], acc8[5]); w.w = pk2(acc8[6], acc8[7]);
      *(u32x4*)(lds + LDS_XR + LRU_XSWZ(t, c8i)) = w;
    }
    __syncthreads();
    f32x16 aA[2], aI[2];
    aA[0] = f32x16{}; aA[1] = f32x16{}; aI[0] = f32x16{}; aI[1] = f32x16{};
#pragma unroll
    for (int ks = 0; ks < 8; ++ks) {
      const int c16 = ks * 2 + hi;
      const bf16x8 x0 = *reinterpret_cast<const bf16x8*>(lds + LDS_XR + LRU_XSWZ(r32, c16));
      const bf16x8 x1 = *reinterpret_cast<const bf16x8*>(lds + LDS_XR + LRU_XSWZ(32 + r32, c16));
      aA[0] = __builtin_amdgcn_mfma_f32_32x32x16_bf16(x0, wb[0][ks], aA[0], 0, 0, 0);
      aA[1] = __builtin_amdgcn_mfma_f32_32x32x16_bf16(x1, wb[0][ks], aA[1], 0, 0, 0);
      aI[0] = __builtin_amdgcn_mfma_f32_32x32x16_bf16(x0, wb[1][ks], aI[0], 0, 0, 0);
      aI[1] = __builtin_amdgcn_mfma_f32_32x32x16_bf16(x1, wb[1][ks], aI[1], 0, 0, 0);
    }
#pragma unroll
    for (int rt = 0; rt < 2; ++rt)
#pragma unroll
      for (int r = 0; r < 16; ++r) {
        const int t = 32 * rt + crow(r, hi);
        const float xv = bf2f(*(const bf16_t*)(lds + LDS_XR + LRU_XSWZ(t, e >> 3) + (e & 7) * 2));
        const float rg = fsig(aA[rt][r] + bav), ig = fsig(aI[rt][r] + biv);
        const float a = __expf(c8 * rg);
        aA[rt][r] = a; aI[rt][r] = __builtin_amdgcn_sqrtf(1.f - a * a) * ig * xv;
      }
    float Ptot, Hend;
    if (PASS == 1) {
      if (dir == 0) scan<0, false>(aA, aI, 0.f, hi, Ptot, Hend); else scan<1, false>(aA, aI, 0.f, hi, Ptot, Hend);
      if (hi == 0) { float* s = p.SUM + ((size_t)((b * NCH + chunk) * 2 + dir) * 1024 + ch) * 2; s[0] = Ptot; s[1] = Hend; }
    } else {
      float cin = 0.f;
      if (dir == 0) { for (int j = 0; j < chunk; ++j) { const float* s = p.SUM + ((size_t)((b * NCH + j) * 2 + 0) * 1024 + ch) * 2; cin = s[0] * cin + s[1]; } }
      else { for (int j = NCH - 1; j > chunk; --j) { const float* s = p.SUM + ((size_t)((b * NCH + j) * 2 + 1) * 1024 + ch) * 2; cin = s[0] * cin + s[1]; } }
      if (dir == 0) scan<0, true>(aA, aI, cin, hi, Ptot, Hend); else scan<1, true>(aA, aI, cin, hi, Ptot, Hend);
      float* Hs = (float*)(lds + LDS_H) + dir * (T * 128);
#pragma unroll
      for (int rt = 0; rt < 2; ++rt)
#pragma unroll
        for (int r = 0; r < 16; ++r) Hs[(32 * rt + crow(r, hi)) * 128 + e] = aI[rt][r];
      __syncthreads();
#pragma unroll
      for (int pp = 0; pp < 2; ++pp) {
        const int pc = tid + pp * 512, t = pc >> 4, c8i = pc & 15;
        const float* hf = (const float*)(lds + LDS_H) + t * 128 + c8i * 8; const float* hb = hf + T * 128;
        const f32x4_t f0 = *(const f32x4_t*)hf, f1 = *(const f32x4_t*)(hf + 4), b0 = *(const f32x4_t*)hb, b1 = *(const f32x4_t*)(hb + 4);
        const size_t gi = (rowb + t0 + t) * 1024 + blk * 128 + c8i * 8;
        const bf16x8 gv = *reinterpret_cast<const bf16x8*>(p.LRG + gi);
        u32x4 w;
        w.x = pk2((f0[0] + b0[0]) * bf2f((bf16_t)gv[0]), (f0[1] + b0[1]) * bf2f((bf16_t)gv[1]));
        w.y = pk2((f0[2] + b0[2]) * bf2f((bf16_t)gv[2]), (f0[3] + b0[3]) * bf2f((bf16_t)gv[3]));
        w.z = pk2((f1[0] + b1[0]) * bf2f((bf16_t)gv[4]), (f1[1] + b1[1]) * bf2f((bf16_t)gv[5]));
        w.w = pk2((f1[2] + b1[2]) * bf2f((bf16_t)gv[6]), (f1[3] + b1[3]) * bf2f((bf16_t)gv[7]));
        *(u32x4*)(p.YL + gi) = w;
      }
    }
  }
}
}
#define XB_TMO      128
#define XB_XCNT(j)  (256  + 64 * (j))
#define XB_XSUB(j)  (1280 + 64 * (j))
#define XB_XGEN(j)  (2304 + 64 * (j))
#define XB_TOP      3328
#define XB_TOPGEN   3392
#define XCD_BAR_WORDS 3456
#define XB_SPIN_CAP (1u << 18)

__device__ __forceinline__ unsigned xb_ld(unsigned* p)              { return __hip_atomic_load(p, __ATOMIC_RELAXED, __HIP_MEMORY_SCOPE_AGENT); }
__device__ __forceinline__ unsigned xb_add(unsigned* p, unsigned v) { return __hip_atomic_fetch_add(p, v, __ATOMIC_RELAXED, __HIP_MEMORY_SCOPE_AGENT); }
__device__ __forceinline__ unsigned xb_xcc_id() { return (unsigned)__builtin_amdgcn_s_getreg((3 << 11) | 20) & 0xFu; }
#define XB_SPIN(cond, bar) do { unsigned _sp = 0; while (cond) { __builtin_amdgcn_s_sleep(1); \
    if ((++_sp & 255u) == 0u) { if (xb_ld(&(bar)[XB_TMO])) break; if (_sp > XB_SPIN_CAP) { atomicAdd(&(bar)[XB_TMO], 1u); break; } } } } while (0)

struct XcdBarrier {
    unsigned* bar; unsigned x;
    volatile LAS unsigned* st;
};

__device__ __forceinline__ XcdBarrier xcd_barrier_post(unsigned* bar, volatile LAS unsigned* st) {
    XcdBarrier b; b.bar = bar; b.x = xb_xcc_id(); b.st = st;
    if (threadIdx.x == 0) (void)xb_add(&bar[XB_XCNT(b.x)], 1u);
    return b;
}
__device__ __forceinline__ void xcd_barrier_complete(unsigned* bar, unsigned x, unsigned& nloc, unsigned& nx) {
    const unsigned G = gridDim.x * gridDim.y * gridDim.z;
    unsigned sum, cnt, mine, sp = 0u;
    for (;;) {
        sum = 0u; cnt = 0u; mine = 0u;
#pragma unroll
        for (unsigned j = 0; j < 16; ++j) { const unsigned c = xb_ld(&bar[XB_XCNT(j)]); sum += c; cnt += (c > 0u) ? 1u : 0u; mine = (j == x) ? c : mine; }
        if (sum == G) break;
        __builtin_amdgcn_s_sleep(1);
        if ((++sp & 255u) == 0u) { if (xb_ld(&bar[XB_TMO])) break; if (sp > XB_SPIN_CAP) { atomicAdd(&bar[XB_TMO], 1u); break; } }
    }
    nloc = mine > 0u ? mine : 1u; nx = cnt > 0u ? cnt : 1u;
}

__device__ __forceinline__ void xcd_barrier(const XcdBarrier& b) {
    asm volatile("s_waitcnt vmcnt(0)" ::: "memory");
    __syncthreads();
    if (threadIdx.x == 0) {
        unsigned* bar = b.bar;
        __builtin_amdgcn_s_waitcnt(0);
        unsigned nloc = b.st[0], nx = b.st[1];
        if (nloc == 0u) { xcd_barrier_complete(bar, b.x, nloc, nx); b.st[0] = nloc; b.st[1] = nx; }
        const unsigned old = xb_add(&bar[XB_XSUB(b.x)], 1u);
        const unsigned gen = old / nloc;
        if (old + 1u == (gen + 1u) * nloc) {
            __builtin_amdgcn_fence(__ATOMIC_RELEASE, "agent");
            asm volatile("s_waitcnt vmcnt(0)" ::: "memory");
            const unsigned og = xb_add(&bar[XB_TOP], 1u);
            const unsigned tg = og / nx;
            if (og + 1u == (tg + 1u) * nx) xb_add(&bar[XB_TOPGEN], 1u);
            else XB_SPIN(xb_ld(&bar[XB_TOPGEN]) == tg, bar);
            __builtin_amdgcn_fence(__ATOMIC_ACQUIRE, "agent");
            xb_add(&bar[XB_XGEN(b.x)], 1u);
            asm volatile("s_waitcnt vmcnt(0)" ::: "memory");
        } else {
            XB_SPIN(xb_ld(&bar[XB_XGEN(b.x)]) == gen, bar);
            __builtin_amdgcn_fence(__ATOMIC_ACQUIRE, "agent");
            asm volatile("s_waitcnt vmcnt(0)" ::: "memory");
        }
    }
    __syncthreads();
}
struct MkArgs { const float* in[29]; float* out; unsigned char* ws; int ph_lo, ph_hi; };
struct Frame {
    LAS unsigned char* lds;
    volatile LAS unsigned* MISC;
    gu32* ctl;
    int tid, lane, wave;
    int vcu, G;
};

__device__ __forceinline__ void p0_transpose_item(const float* W, int K, int N, bf16_t* WT, LAS float* scr, int item, int lane, const float* kscale, int mode) {
    const int nblk = N / 32, kb = item / nblk, nb = item % nblk, k0 = 64 * kb, n0 = 32 * nb;
#pragma unroll 8
    for (int i = 0; i < 32; ++i) { const int kk = 2 * i + (lane >> 5); float w = W[(size_t)(k0 + kk) * N + n0 + (lane & 31)]; if (kscale) w *= kscale[k0 + kk]; scr[kk * 33 + (lane & 31)] = w; }
    LDS_WAIT(); asm volatile("" ::: "memory");
    const int r0 = (mode == 1 && n0 < 2048) ? ((n0 & ~255) + 128 * ((n0 >> 5) & 1) + 32 * ((n0 >> 6) & 3)) : (mode >= 2) ? (256 * (n0 >> 7) + 128 * (mode - 2) + (n0 & 127)) : n0;
    const int c = lane & 7;
#pragma unroll
    for (int j = 0; j < 4; ++j) { const int n = (lane >> 3) + 8 * j; const LAS float* s = scr + (8 * c) * 33 + n;
        v4u o; o.x = pk2(s[0 * 33], s[1 * 33]); o.y = pk2(s[2 * 33], s[3 * 33]); o.z = pk2(s[4 * 33], s[5 * 33]); o.w = pk2(s[6 * 33], s[7 * 33]);
        *(GAS v4u*)(WT + (size_t)(r0 + n) * K + k0 + 8 * c) = o; }
    LDS_WAIT(); asm volatile("" ::: "memory");
}
__device__ __forceinline__ void p0_row(const float* xrow, bf16_t* orow, float* rs, int lane) {
    const GAS f32x4* xr = (const GAS f32x4*)xrow + lane;
    f32x4 v[4]; float s = 0.f;
#pragma unroll
    for (int j = 0; j < 4; ++j) { v[j] = xr[64 * j]; s += (v[j].x * v[j].x + v[j].y * v[j].y) + (v[j].z * v[j].z + v[j].w * v[j].w); }
    s = wave_sum(s);
    if (lane == 0) *rs = rsqrtf(s * (1.f / 1024.f) + 1e-6f);
    GAS unsigned long long* o8 = (GAS unsigned long long*)orow + lane;
#pragma unroll
    for (int j = 0; j < 4; ++j) o8[64 * j] = (unsigned long long)pk2(v[j].x, v[j].y) | ((unsigned long long)pk2(v[j].z, v[j].w) << 32);
}

__global__ void __launch_bounds__(NWAVES * 64, 2) persist(MkArgs args) {
    extern __shared__ __attribute__((aligned(16))) unsigned char lds[];
    Frame F;
    F.lds = (LAS unsigned char*)lds;
    F.MISC = (volatile LAS unsigned*)(F.lds + MISC_OFF);
    F.tid = threadIdx.x; F.lane = F.tid & 63; F.wave = __builtin_amdgcn_readfirstlane(F.tid >> 6);
    F.G = gridDim.x; { const int bx = blockIdx.x; F.vcu = (F.G % 8 == 0) ? (bx % 8) * (F.G / 8) + bx / 8 : bx; }
    unsigned char* ws = args.ws;
    F.ctl = (gu32*)(ws + WS_CTL);
    for (int u = F.tid; u < (LDS_BYTES - LDSCTL_OFF) / 4; u += NWAVES * 64) ((LAS unsigned*)(F.lds + LDSCTL_OFF))[u] = 0u;
    __syncthreads();
    const int lo = args.ph_lo, hi = args.ph_hi;
    XcdBarrier bar; bar.bar = (unsigned*)(F.ctl + CW_BAR); bar.x = 0; bar.st = nullptr;
    if (hi - lo > 1) bar = xcd_barrier_post((unsigned*)(F.ctl + CW_BAR), F.MISC + 8);
#define IN(k) (lo <= (k) && (k) < hi)
#define BOTH(k) (IN(k) && IN((k) + 1))
#define GRID_BAR() xcd_barrier(bar)

    const float* x = args.in[0];
    bf16_t* XB = (bf16_t*)args.out;
    float* RS1 = (float*)(ws + WS_RS1); float* COST = (float*)(ws + WS_COS); float* SINT = (float*)(ws + WS_SIN);
    bf16_t* WINT = (bf16_t*)(ws + WS_WINT); bf16_t* WAT = (bf16_t*)(ws + WS_WAT); bf16_t* WLT = (bf16_t*)(ws + WS_WLT); bf16_t* WOT = (bf16_t*)(ws + WS_WOT);
    bf16_t* LRUW = (bf16_t*)(ws + WS_LRUW); float* LRUS = (float*)(ws + WS_LRUS);
    bf16_t* QP = (bf16_t*)(ws + WS_S0); bf16_t* KP = (bf16_t*)(ws + WS_S1); bf16_t* VB = (bf16_t*)(ws + WS_S2);
    bf16_t* LRX = (bf16_t*)(ws + WS_S3); bf16_t* LRG = (bf16_t*)(ws + WS_S4); bf16_t* GA = (bf16_t*)(ws + WS_S5); bf16_t* GL = (bf16_t*)(ws + WS_S6);

    if (IN(0)) {
        LAS float* scr = (LAS float*)(F.lds + RING_OFF + F.wave * 16384);
        const int gw = F.vcu * NWAVES + F.wave, NGW = F.G * NWAVES;
        constexpr int I_IN = (1024 / 64) * (PROJ / 32), I_SQ = (1024 / 64) * (1024 / 32);
        constexpr int I_LRU = 32 * 8;
        constexpr int NITEMS = I_IN + 3 * I_SQ + I_LRU;
        for (int it = gw; it < NITEMS; it += NGW) {
            int r = it;
            if (r < I_IN) { p0_transpose_item(args.in[2], 1024, PROJ, WINT, scr, r, F.lane, args.in[1], 1); continue; } r -= I_IN;
            if (r < I_SQ) { p0_transpose_item(args.in[11], 1024, 1024, WAT, scr, r, F.lane, nullptr, 0); continue; } r -= I_SQ;
            if (r < I_SQ) { p0_transpose_item(args.in[19], 1024, 1024, WLT, scr, r, F.lane, nullptr, 0); continue; } r -= I_SQ;
            if (r < I_SQ) { p0_transpose_item(args.in[20], 1024, 1024, WOT, scr, r, F.lane, nullptr, 0); continue; } r -= I_SQ;
            { const int mat = r >> 3, gate = mat >> 4, dirblk = mat & 15, dir = dirblk >> 3, blk = dirblk & 7;
              p0_transpose_item((gate ? args.in[16] : args.in[14]) + (size_t)dirblk * 16384, 128, 128, LRUW + (size_t)((dir * 2 + gate) * 8 + blk) * 16384, scr, r & 7, F.lane, nullptr, 0); }
        }
        for (int m = gw; m < NTOK; m += NGW) p0_row(x + (size_t)m * 1024, XB + (size_t)m * 1024, RS1 + m, F.lane);
        {
            for (int e = blockIdx.x * (NWAVES * 64) + F.tid; e < 4096 * 32; e += F.G * NWAVES * 64) {
                const int pos = e >> 5, i = e & 31;
                const float inv_freq = expf(-9.210340371976184f * (float)i * (1.f / 32.f));
                float sn, cs; sincosf((float)pos * inv_freq, &sn, &cs);
                COST[e] = cs; SINT[e] = sn;
            }
        }
        if (BOTH(0)) GRID_BAR();
    }
    if (IN(1)) {
        pg8::Gemm g{XB, WINT, NTOK, PROJ, 1024}; pg8::StaticOrder S; S.init(NTOK, PROJ, F.G, (int)blockIdx.x);
        pg8::EpiProj E{RS1, args.in[3], args.in[4], args.in[5], COST, SINT, QP, KP, VB, LRX, LRG, GA, GL};
        pg8::gemm_phase<pg8::EpiProj, pg8::StaticOrder, true, true>(F.lds + RING_OFF, g, S, E);
        if (BOTH(1)) GRID_BAR();
    }
    bf16_t* O1N = (bf16_t*)args.out; bf16_t* O2N = O1N + (size_t)NTOK * 1024;
    if (IN(2)) {
        const int per = 1024 / F.G;
        for (int i = 0; i < per; ++i) {
            const int unit = F.vcu * per + i;
            const int bhc = unit >> 4, qb = unit & 15, b = bhc >> 4, hc = bhc & 15, h = hc >> 1, c = hc & 1;
            att::attn_unit(QP + ((size_t)bhc * 4096 + qb * 256) * 64, KP + (size_t)bhc * 4096 * 64, VB + ((size_t)(b * 8 + h) * 4096) * 128,
                           (c ? O2N : O1N) + ((size_t)b * 4096 + qb * 256) * 1024 + h * 128, (char*)lds + RING_OFF);
        }
        { const lru::Params lp{LRX, LRG, LRUW, args.in[12], args.in[13], args.in[15], args.in[17], args.in[18], LRUS, nullptr};
          lru::lru_phase<1>(lp, (char*)lds + RING_OFF, F.vcu, F.G); }
        if (BOTH(2)) GRID_BAR();
    }
    bf16_t* ON = (bf16_t*)(ws + WS_S0); bf16_t* YL = (bf16_t*)(ws + WS_S1);
    if (IN(3)) {
        {
            const float s1 = wave_sum(args.in[6][F.lane] * args.in[7][F.lane]), s2 = wave_sum(args.in[8][F.lane] * args.in[9][F.lane]);
            const float lam = expf(s1) - expf(s2) + 0.2f;
            const float g0 = args.in[10][F.lane] * 0.8f, g1 = args.in[10][64 + F.lane] * 0.8f;
            const int gw = F.vcu * NWAVES + F.wave, NGW = F.G * NWAVES;
            for (int it = gw; it < NTOK * 8; it += NGW) {
                const size_t base = (size_t)it * 128;
                const float a0 = bf2f(O1N[base + F.lane]) - lam * bf2f(O2N[base + F.lane]);
                const float a1 = bf2f(O1N[base + 64 + F.lane]) - lam * bf2f(O2N[base + 64 + F.lane]);
                const float ss = wave_sum(a0 * a0 + a1 * a1);
                const float rs = rsqrtf(ss * (1.f / 128.f) + 1e-6f);
                ON[base + F.lane] = f2bf(a0 * rs * g0); ON[base + 64 + F.lane] = f2bf(a1 * rs * g1);
            }
        }
        { const lru::Params lp{LRX, LRG, LRUW, args.in[12], args.in[13], args.in[15], args.in[17], args.in[18], LRUS, YL};
          lru::lru_phase<2>(lp, (char*)lds + RING_OFF, F.vcu, F.G); }
        if (BOTH(3)) GRID_BAR();
    }
    bf16_t* MERGED = (bf16_t*)(ws + WS_S2);
    if (IN(4)) {
        { pg8::Gemm g{ON, WAT, NTOK, 1024, 1024}; pg8::StaticOrder S; S.init(NTOK, 1024, F.G, (int)blockIdx.x);
          pg8::EpiMerge<1> E{MERGED, GA};
          pg8::gemm_phase<pg8::EpiMerge<1>, pg8::StaticOrder, false, true>(F.lds + RING_OFF, g, S, E); }
        { pg8::Gemm g{YL, WLT, NTOK, 1024, 1024}; pg8::StaticOrder S; S.init(NTOK, 1024, F.G, (int)blockIdx.x);
          pg8::EpiMerge<2> E{MERGED, GL};
          pg8::gemm_phase<pg8::EpiMerge<2>, pg8::StaticOrder, false, true>(F.lds + RING_OFF, g, S, E); }
        if (BOTH(4)) GRID_BAR();
    }
    if (IN(5)) {
        pg8::Gemm g{MERGED, WOT, NTOK, 1024, 1024}; pg8::StaticOrder S; S.init(NTOK, 1024, F.G, (int)blockIdx.x);
        pg8::EpiResid E{x, args.out};
        pg8::gemm_phase<pg8::EpiResid, pg8::StaticOrder, false, true>(F.lds + RING_OFF, g, S, E);
        if (BOTH(5)) GRID_BAR();
    }
    bf16_t* H2 = (bf16_t*)(ws + WS_S0); bf16_t* HID = (bf16_t*)(ws + WS_S3);
    bf16_t* WGU = (bf16_t*)(ws + WS_S5); bf16_t* WDN = (bf16_t*)(ws + WS_S6 + 2 * MiB);
    bf16_t* Y0 = (bf16_t*)(ws + WS_S1); bf16_t* Y1 = (bf16_t*)(ws + WS_S2);
    int* LISTT = (int*)(ws + WS_LIST); float* LISTW = (float*)(ws + WS_LIST + 1 * MiB);
    gu32* GCNT = F.ctl + CW_CNT;
    LAS int* TB = (LAS int*)(F.lds + LDSCTL_OFF + 1024);
    if (IN(6)) {
        const float* x1 = args.out;
        const int tpc = NTOK / F.G, tpw = tpc / NWAVES;
        LAS int* LE = (LAS int*)(F.lds + RING_OFF + 12288); LAS float* LW = (LAS float*)(F.lds + RING_OFF + 12288 + 1024);
        LAS int* LRK = (LAS int*)(F.lds + RING_OFF + 12288 + 2048); LAS int* LCNT = (LAS int*)(F.lds + RING_OFF + 12288 + 3072); LAS int* LBASE = LCNT + 16;
        LAS float* WR = (LAS float*)(F.lds + RING_OFF + 16384);
        __syncthreads();
        if (F.tid < 32) LCNT[F.tid] = 0;
        const float* gain2 = args.in[21]; const float* wg = args.in[22]; const float* bg = args.in[23]; const float* wer = args.in[24]; const float* ber = args.in[25];
        for (int i = F.tid; i < 1024 * 5; i += NWAVES * 64) {
            const int d = i / 5, q = i % 5;
            const f32x4 w4 = (q == 0) ? *(const f32x4*)&wg[d * 4] : *(const f32x4*)&wer[d * 16 + (q - 1) * 4];
            *(LAS f32x4*)&WR[d * 20 + q * 4] = w4;
        }
        __syncthreads();
        for (int k = 0; k < tpw; ++k) {
            const int tl = F.wave * tpw + k; const size_t tok = (size_t)F.vcu * tpc + tl;
            const float* xr = x1 + tok * 1024 + F.lane; const float* gp = gain2 + F.lane; bf16_t* hp = H2 + tok * 1024 + F.lane;
            float v[16]; float ss = 0.f;
#pragma unroll
            for (int j = 0; j < 16; ++j) { v[j] = xr[j * 64]; ss += v[j] * v[j]; }
            ss = wave_sum(ss);
            const float rs = rsqrtf(ss * (1.f / 1024.f) + 1e-6f);
            float lg[20];
#pragma unroll
            for (int q = 0; q < 20; ++q) lg[q] = 0.f;
            const LAS float* wl = WR + F.lane * 20;
#pragma unroll
            for (int j = 0; j < 16; ++j) {
                const float hv = v[j] * rs * gp[j * 64];
                hp[j * 64] = f2bf(hv);
#pragma unroll
                for (int q = 0; q < 5; ++q) { const f32x4 w4 = *(const LAS f32x4*)&wl[j * 64 * 20 + q * 4]; lg[q * 4 + 0] += hv * w4.x; lg[q * 4 + 1] += hv * w4.y; lg[q * 4 + 2] += hv * w4.z; lg[q * 4 + 3] += hv * w4.w; }
            }
#pragma unroll
            for (int q = 0; q < 20; ++q) lg[q] = wave_sum(lg[q]);
            const float gl0 = lg[0] + bg[0], gl1 = lg[1] + bg[1], gl2 = lg[2] + bg[2], gl3 = lg[3] + bg[3];
            int gs = 0; float gm = gl0;
            if (gl1 > gm) { gm = gl1; gs = 1; } if (gl2 > gm) { gm = gl2; gs = 2; } if (gl3 > gm) { gm = gl3; gs = 3; }
            const float gw = 1.f / (expf(gl0 - gm) + expf(gl1 - gm) + expf(gl2 - gm) + expf(gl3 - gm));
            float el[4];
#pragma unroll
            for (int j = 0; j < 4; ++j) { const float s0 = lg[4 + j], s1 = lg[8 + j], s2 = lg[12 + j], s3 = lg[16 + j]; el[j] = (gs == 0 ? s0 : gs == 1 ? s1 : gs == 2 ? s2 : s3) + ber[gs * 4 + j]; }
            int i0 = 0; float v0 = el[0];
            if (el[1] > v0) { v0 = el[1]; i0 = 1; } if (el[2] > v0) { v0 = el[2]; i0 = 2; } if (el[3] > v0) { v0 = el[3]; i0 = 3; }
            int i1 = (i0 == 0) ? 1 : 0; float v1 = -3.0e38f;
#pragma unroll
            for (int j = 0; j < 4; ++j) { if (j != i0 && el[j] > v1) { v1 = el[j]; i1 = j; } }
            const float ex = expf(v1 - v0);
            if (F.lane == 0) { LE[tl * 2] = gs * 4 + i0; LE[tl * 2 + 1] = gs * 4 + i1; LW[tl * 2] = gw / (1.f + ex); LW[tl * 2 + 1] = gw * ex / (1.f + ex); }
        }
        __syncthreads();
        const int npair = tpc * 2;
        int me = 0;
        if (F.tid < npair) { me = LE[F.tid]; LRK[F.tid] = __hip_atomic_fetch_add(&LCNT[me], 1, __ATOMIC_RELAXED, __HIP_MEMORY_SCOPE_WORKGROUP); }
        __syncthreads();
        if (F.tid < 16) LBASE[F.tid] = (int)__hip_atomic_fetch_add(GCNT + F.tid, (unsigned)LCNT[F.tid], RLX_AGENT);
        __syncthreads();
        if (F.tid < npair) { const int pos = LBASE[me] + LRK[F.tid]; LISTT[me * 16384 + pos] = (F.vcu * tpc + (F.tid >> 1)) * 2 + (F.tid & 1); LISTW[me * 16384 + pos] = LW[F.tid]; }
        __syncthreads();
        {
            LAS float* scr = (LAS float*)(F.lds + RING_OFF + F.wave * 16384);
            const int gw_ = F.vcu * NWAVES + F.wave, NGW = F.G * NWAVES;
            constexpr int I_GU = (1024 / 64) * (512 / 32), I_DN = (512 / 64) * (1024 / 32);
            for (int it = gw_; it < 16 * (2 * I_GU + I_DN); it += NGW) {
                const int e = it / (2 * I_GU + I_DN); int r = it % (2 * I_GU + I_DN);
                if (r < 2 * I_GU) {
                    const int isup = r >= I_GU; if (isup) r -= I_GU;
                    p0_transpose_item((isup ? args.in[27] : args.in[26]) + (size_t)e * 1024 * 512, 1024, 512, WGU + (size_t)e * 1024 * 1024, scr, r, F.lane, nullptr, 2 + isup);
                } else {
                    p0_transpose_item(args.in[28] + (size_t)e * 512 * 1024, 512, 1024, WDN + (size_t)e * 1024 * 512, scr, r - 2 * I_GU, F.lane, nullptr, 0);
                }
            }
        }
        if (BOTH(6)) GRID_BAR();
    }
    if (IN(7) || IN(8)) {
        __syncthreads();
        if (F.tid < 16) TB[32 + F.tid] = (int)__hip_atomic_load(GCNT + F.tid, RLX_AGENT);
        __syncthreads();
        if (F.tid == 0) { int accn = 0; for (int e = 0; e < 16; ++e) { TB[e] = accn; accn += (TB[32 + e] + 255) >> 8; } TB[16] = accn; }
        __syncthreads();
    }
    if (IN(7)) {
        pg8::Gemm g{H2, WGU, 0, 1024, 1024}; pg8::GroupedOrder S{TB, LISTT, F.G, F.vcu, 4};
        pg8::EpiUp E{HID, LISTW};
        pg8::gemm_grouped<pg8::EpiUp, pg8::GroupedOrder, 0, true>(F.lds + RING_OFF, g, S, E);
        if (BOTH(7)) GRID_BAR();
    }
    if (IN(8)) {
        pg8::Gemm g{HID, WDN, 0, 1024, 512}; pg8::GroupedOrder S{TB, LISTT, F.G, F.vcu, 4};
        pg8::EpiDown E{Y0, (size_t)(Y1 - Y0), LISTT};
        pg8::gemm_grouped<pg8::EpiDown, pg8::GroupedOrder, 1, true>(F.lds + RING_OFF, g, S, E);
        if (BOTH(8)) GRID_BAR();
    }
    if (IN(9)) {
        typedef unsigned u32x2_t __attribute__((ext_vector_type(2)));
        f32x4* o4 = (f32x4*)args.out; const u32x2_t* a2 = (const u32x2_t*)Y0; const u32x2_t* b2 = (const u32x2_t*)Y1;
        for (size_t i = (size_t)blockIdx.x * (NWAVES * 64) + F.tid; i < (size_t)NTOK * 256; i += (size_t)F.G * NWAVES * 64) {
            f32x4 v = o4[i]; const u32x2_t a = a2[i], b = b2[i];
            v[0] += __uint_as_float(a.x << 16) + __uint_as_float(b.x << 16); v[1] += __uint_as_float(a.x & 0xffff0000u) + __uint_as_float(b.x & 0xffff0000u);
            v[2] += __uint_as_float(a.y << 16) + __uint_as_float(b.y << 16); v[3] += __uint_as_float(a.y & 0xffff0000u) + __uint_as_float(b.y & 0xffff0000u);
            o4[i] = v;
        }
    }
#undef IN
#undef BOTH
}
extern "C" void kernel_launch(void* const* d_in, const int* in_sizes, int n_in, void* d_out, int out_size, void* d_ws, size_t ws_size, hipStream_t stream) {
  const float* x = (const float*)d_in[0];
  const float* lq1 = (const float*)d_in[6];
  const float* lk1 = (const float*)d_in[7];
  const float* lq2 = (const float*)d_in[8];
  const float* lk2 = (const float*)d_in[9];
  const float* subln_gain = (const float*)d_in[10];
  const float* w_attn_o = (const float*)d_in[11];
  const float* conv_w = (const float*)d_in[12];
  const float* conv_b = (const float*)d_in[13];
  const float* lru_wa = (const float*)d_in[14];
  const float* lru_ba = (const float*)d_in[15];
  const float* lru_wi = (const float*)d_in[16];
  const float* lru_bi = (const float*)d_in[17];
  const float* lru_lambda = (const float*)d_in[18];
  const float* w_lru_o = (const float*)d_in[19];
  const float* w_out = (const float*)d_in[20];
  const float* norm2_gain = (const float*)d_in[21];
  const float* w_group = (const float*)d_in[22];
  const float* b_group = (const float*)d_in[23];
  const float* w_er = (const float*)d_in[24];
  const float* b_er = (const float*)d_in[25];
  const float* w_eg = (const float*)d_in[26];
  const float* w_eu = (const float*)d_in[27];
  const float* w_ed = (const float*)d_in[28];
  static int once = 0;
  if (!once) {
    once = 1;
    if (ws_size < 8 * SLOT || n_in != 29) fprintf(stderr, "kernel_launch: unexpected ws %zu n_in %d\n", ws_size, n_in);
    (void)hipFuncSetAttribute((const void*)nv::nlru, hipFuncAttributeMaxDynamicSharedMemorySize, (2 * 128 * 128 + 256) * 4);
    (void)hipFuncSetAttribute((const void*)persist, hipFuncAttributeMaxDynamicSharedMemorySize, LDS_BYTES);
  }
  char* ws = (char*)d_ws; char* dout = (char*)d_out;
  bf16_t* qb = (bf16_t*)(ws + WS_S0); bf16_t* kb = (bf16_t*)(ws + WS_S1); bf16_t* vb = (bf16_t*)(ws + WS_S2);
  bf16_t* lrx = (bf16_t*)(ws + WS_S3); bf16_t* lrg = (bf16_t*)(ws + WS_S4); bf16_t* ga = (bf16_t*)(ws + WS_S5); bf16_t* gl = (bf16_t*)(ws + WS_S6);
  float* sc = (float*)(ws + WS_S7 + 1 * MiB - 256);
  int* sel_e = (int*)(ws + WS_SEL_E); float* sel_w = (float*)(ws + WS_SEL_W);

  (void)hipMemsetAsync(ws + WS_CTL, 0, CTL_ZERO_BYTES, stream);
  MkArgs a{};
  for (int i = 0; i < 29; ++i) a.in[i] = (const float*)d_in[i];
  a.out = (float*)d_out; a.ws = (unsigned char*)d_ws;
  const int GRID = 256;
  a.ph_lo = 0; a.ph_hi = 1; hipLaunchKernelGGL(persist, dim3(GRID), dim3(NWAVES * 64), LDS_BYTES, stream, a);
  a.ph_lo = 1; a.ph_hi = 2; hipLaunchKernelGGL(persist, dim3(GRID), dim3(NWAVES * 64), LDS_BYTES, stream, a);

  a.ph_lo = 2; a.ph_hi = 3; hipLaunchKernelGGL(persist, dim3(GRID), dim3(NWAVES * 64), LDS_BYTES, stream, a);
  a.ph_lo = 3; a.ph_hi = 4; hipLaunchKernelGGL(persist, dim3(GRID), dim3(NWAVES * 64), LDS_BYTES, stream, a);
  a.ph_lo = 4; a.ph_hi = 5; hipLaunchKernelGGL(persist, dim3(GRID), dim3(NWAVES * 64), LDS_BYTES, stream, a);
  a.ph_lo = 5; a.ph_hi = 6; hipLaunchKernelGGL(persist, dim3(GRID), dim3(NWAVES * 64), LDS_BYTES, stream, a);
  for (int ph = 6; ph < 10; ++ph) { a.ph_lo = ph; a.ph_hi = ph + 1; hipLaunchKernelGGL(persist, dim3(GRID), dim3(NWAVES * 64), LDS_BYTES, stream, a); }
}
```

```cpp
#include <hip/hip_runtime.h>
#include <cstdint>
#include <cstdio>

typedef unsigned short bf16_t;
__device__ __forceinline__ float bf2f(bf16_t v) { return __uint_as_float(((unsigned)v) << 16); }
__device__ __forceinline__ bf16_t f2bf(float f) { unsigned u = __float_as_uint(f); return (bf16_t)((u + 0x7fffu + ((u >> 16) & 1u)) >> 16); }
__device__ __forceinline__ float toF(float v) { return v; }
__device__ __forceinline__ float toF(bf16_t v) { return bf2f(v); }

constexpr int NTOK = 16384, DM = 1024, SEQ = 4096, NB = 4, PROJ = 7168;
constexpr size_t MiB = 1u << 20;
constexpr size_t SLOT = 32 * MiB;
constexpr size_t WS_S0 = 0, WS_S1 = SLOT, WS_S2 = 2 * SLOT, WS_S3 = 3 * SLOT, WS_S4 = 4 * SLOT, WS_S5 = 5 * SLOT, WS_S6 = 6 * SLOT, WS_S7 = 7 * SLOT;

__device__ __forceinline__ float wave_sum(float v) {
#pragma unroll
  for (int o = 1; o < 64; o <<= 1) v += __shfl_xor(v, o);
  return v;
}
__device__ __forceinline__ float sigmoidf_(float x) { return 1.f / (1.f + __expf(-x)); }
__device__ __forceinline__ float gelu_tanh(float x) {
  const float k0 = 0.7978845608028654f, k1 = 0.044715f;
  float t = k0 * (x + k1 * x * x * x);
  return 0.5f * x * (1.f + tanhf(t));
}

namespace nv {
__global__ __launch_bounds__(256) void rms1(const float* __restrict__ x, const float* __restrict__ gain, bf16_t* __restrict__ xn) {
  const int wave = threadIdx.x >> 6, lane = threadIdx.x & 63;
  const size_t tok = (size_t)blockIdx.x * 4 + wave;
  float v[16]; float ss = 0.f;
#pragma unroll
  for (int j = 0; j < 16; ++j) { v[j] = x[tok * DM + j * 64 + lane]; ss += v[j] * v[j]; }
  ss = wave_sum(ss);
  const float rs = rsqrtf(ss * (1.f / DM) + 1e-6f);
#pragma unroll
  for (int j = 0; j < 16; ++j) xn[tok * DM + j * 64 + lane] = f2bf(v[j] * rs * gain[j * 64 + lane]);
}

template <typename TA, class Epi>
__global__ __launch_bounds__(256) void ngemm(const TA* __restrict__ A, int lda, const float* __restrict__ B, int ldb, int K, Epi epi) {
  __shared__ float As[16][68];
  __shared__ float Bs[16][68];
  const int tid = threadIdx.x, tx = tid & 15, ty = tid >> 4;
  const int m0 = blockIdx.y * 64, n0 = blockIdx.x * 64;
  float acc[4][4];
#pragma unroll
  for (int i = 0; i < 4; ++i)
#pragma unroll
    for (int j = 0; j < 4; ++j) acc[i][j] = 0.f;
  const int ar = tid >> 2, akq = (tid & 3) * 4;
  const int bk = tid >> 4, bnq = (tid & 15) * 4;
  for (int k0 = 0; k0 < K; k0 += 16) {
#pragma unroll
    for (int j = 0; j < 4; ++j) As[akq + j][ar] = toF(A[(size_t)(m0 + ar) * lda + k0 + akq + j]);
    const float4 bv = *(const float4*)&B[(size_t)(k0 + bk) * ldb + n0 + bnq];
    Bs[bk][bnq + 0] = bv.x; Bs[bk][bnq + 1] = bv.y; Bs[bk][bnq + 2] = bv.z; Bs[bk][bnq + 3] = bv.w;
    __syncthreads();
#pragma unroll
    for (int kk = 0; kk < 16; ++kk) {
      float a[4], b[4];
#pragma unroll
      for (int i = 0; i < 4; ++i) a[i] = As[kk][ty * 4 + i];
#pragma unroll
      for (int j = 0; j < 4; ++j) b[j] = Bs[kk][tx * 4 + j];
#pragma unroll
      for (int i = 0; i < 4; ++i)
#pragma unroll
        for (int j = 0; j < 4; ++j) acc[i][j] += a[i] * b[j];
    }
    __syncthreads();
  }
#pragma unroll
  for (int i = 0; i < 4; ++i)
#pragma unroll
    for (int j = 0; j < 4; ++j) epi(m0 + ty * 4 + i, n0 + tx * 4 + j, acc[i][j]);
}

struct EpiProj {
  bf16_t *q, *k, *v, *lrx, *lrg, *ga, *gl; const float* bg;
  __device__ __forceinline__ void operator()(int row, int col, float val) const {
    const size_t r = (size_t)row * DM;
    if (col < 1024) q[r + col] = f2bf(val);
    else if (col < 2048) k[r + col - 1024] = f2bf(val);
    else if (col < 3072) { const int cc = col - 2048, hh = cc >> 7, dd = cc & 127; const int bb = row >> 12, ss = row & 4095; v[(((size_t)bb * 8 + hh) * SEQ + ss) * 128 + dd] = f2bf(val); }
    else if (col < 4096) lrx[r + col - 3072] = f2bf(val);
    else if (col < 5120) lrg[r + col - 4096] = f2bf(gelu_tanh(val));
    else if (col < 6144) ga[r + col - 5120] = f2bf(sigmoidf_(val + bg[col - 5120]));
    else gl[r + col - 6144] = f2bf(sigmoidf_(val + bg[col - 5120]));
  }
};
struct EpiGateSet { float* M; const bf16_t* g; __device__ __forceinline__ void operator()(int row, int col, float val) const { const size_t i = (size_t)row * DM + col; M[i] = bf2f(g[i]) * val; } };
struct EpiGateAdd { float* M; const bf16_t* g; __device__ __forceinline__ void operator()(int row, int col, float val) const { const size_t i = (size_t)row * DM + col; M[i] += bf2f(g[i]) * val; } };
struct EpiResid { float* O; const float* x; __device__ __forceinline__ void operator()(int row, int col, float val) const { const size_t i = (size_t)row * DM + col; O[i] = x[i] + val; } };

__global__ void scalars(const float* lq1, const float* lk1, const float* lq2, const float* lk2, float* sc) {
  if (threadIdx.x == 0) {
    float s1 = 0.f, s2 = 0.f;
    for (int i = 0; i < 64; ++i) { s1 += lq1[i] * lk1[i]; s2 += lq2[i] * lk2[i]; }
    sc[0] = expf(s1) - expf(s2) + 0.2f;
  }
}

__global__ __launch_bounds__(256) void qkprep(const bf16_t* __restrict__ q, const bf16_t* __restrict__ k, const float* __restrict__ qg, const float* __restrict__ kg, bf16_t* __restrict__ QP, bf16_t* __restrict__ KP) {
  const int wave = threadIdx.x >> 6, lane = threadIdx.x & 63;
  const size_t item = (size_t)blockIdx.x * 4 + wave;
  const size_t tok = item >> 5; const int which = (item >> 4) & 1, hc = item & 15;
  const bf16_t* p = (which ? k : q) + tok * DM + hc * 64;
  const float* g = which ? kg : qg;
  const float xv = bf2f(p[lane]);
  const float ss = wave_sum(xv * xv);
  const float y = xv * rsqrtf(ss * (1.f / 64.f) + 1e-6f) * g[lane];
  const int pos = (int)(tok & (SEQ - 1));
  const int i = lane & 31;
  const float inv_freq = expf(-9.210340371976184f * (float)i * (1.f / 32.f));
  const float ang = (float)pos * inv_freq;
  float sn, cs; sincosf(ang, &sn, &cs);
  const float other = __shfl_xor(y, 32);
  const float o = (lane < 32) ? (y * cs - other * sn) : (other * sn + y * cs);
  const int bb = (int)(tok >> 12);
  bf16_t* dst = (which ? KP : QP) + (((size_t)bb * 16 + hc) * SEQ + pos) * 64;
  dst[lane] = f2bf(which ? o : o * (0.125f * 1.4426950408889634f));
}

__global__ __launch_bounds__(256) void nattn(const bf16_t* __restrict__ Q, const bf16_t* __restrict__ Kp, const bf16_t* __restrict__ V, bf16_t* __restrict__ O1, bf16_t* __restrict__ O2) {
  __shared__ float Ks[64][64];
  __shared__ float Vs[64][128];
  const int tid = threadIdx.x, r = tid >> 2, cq = tid & 3;
  const int b = blockIdx.z, hc = blockIdx.y, h = hc >> 1, c = hc & 1;
  const size_t tok = (size_t)b * SEQ + blockIdx.x * 64 + r;
  float q[16];
#pragma unroll
  for (int i = 0; i < 16; ++i) q[i] = bf2f(Q[(((size_t)b * 16 + hc) * SEQ + blockIdx.x * 64 + r) * 64 + cq * 16 + i]);
  float acc[32];
#pragma unroll
  for (int i = 0; i < 32; ++i) acc[i] = 0.f;
  float m = -1e30f, l = 0.f;
  for (int kt = 0; kt < SEQ; kt += 64) {
    __syncthreads();
    for (int i = tid; i < 4096; i += 256) { const int kr = i >> 6, d = i & 63; Ks[kr][d] = bf2f(Kp[(((size_t)b * 16 + hc) * SEQ + kt + kr) * 64 + d]); }
    for (int i = tid; i < 8192; i += 256) { const int kr = i >> 7, d = i & 127; Vs[kr][d] = bf2f(V[(((size_t)b * 8 + h) * SEQ + kt + kr) * 128 + d]); }
    __syncthreads();
    for (int j = 0; j < 64; ++j) {
      float s = 0.f;
#pragma unroll
      for (int i = 0; i < 16; ++i) s += q[i] * Ks[j][cq * 16 + i];
      s += __shfl_xor(s, 1); s += __shfl_xor(s, 2);
      const float mn = fmaxf(m, s); const float al = exp2f(m - mn); const float p = exp2f(s - mn);
      l = l * al + p; m = mn;
#pragma unroll
      for (int i = 0; i < 32; ++i) acc[i] = acc[i] * al + p * Vs[j][cq * 32 + i];
    }
  }
  const float inv = 1.f / l;
  bf16_t* O = c ? O2 : O1;
#pragma unroll
  for (int i = 0; i < 32; ++i) O[tok * DM + h * 128 + cq * 32 + i] = f2bf(acc[i] * inv);
}

__global__ __launch_bounds__(256) void subln(const bf16_t* __restrict__ O1, const bf16_t* __restrict__ O2, const float* __restrict__ gain, const float* __restrict__ sc, bf16_t* __restrict__ On) {
  const int wave = threadIdx.x >> 6, lane = threadIdx.x & 63;
  const size_t item = (size_t)blockIdx.x * 4 + wave;
  const size_t base = item * 128;
  const float lam = sc[0];
  const float a0 = bf2f(O1[base + lane]) - lam * bf2f(O2[base + lane]);
  const float a1 = bf2f(O1[base + 64 + lane]) - lam * bf2f(O2[base + 64 + lane]);
  const float ss = wave_sum(a0 * a0 + a1 * a1);
  const float rs = rsqrtf(ss * (1.f / 128.f) + 1e-6f) * 0.8f;
  On[base + lane] = f2bf(a0 * rs * gain[lane]);
  On[base + 64 + lane] = f2bf(a1 * rs * gain[64 + lane]);
}

__global__ __launch_bounds__(128) void nlru(const bf16_t* __restrict__ lrx, const float* __restrict__ conv_w, const float* __restrict__ conv_b,
                                            const float* __restrict__ wa, const float* __restrict__ ba, const float* __restrict__ wi, const float* __restrict__ bi,
                                            const float* __restrict__ lam, bf16_t* __restrict__ hout_f, bf16_t* __restrict__ hout_b) {
  extern __shared__ __attribute__((aligned(16))) float sm[];
  float* Wa = sm; float* Wi = sm + 128 * 128; float* xs = sm + 2 * 128 * 128;
  const int e = threadIdx.x;
  const int dir = blockIdx.x & 1, blk = (blockIdx.x >> 1) & 7, b = blockIdx.x >> 4;
  const int c = blk * 128 + e;
  for (int d = 0; d < 128; ++d) { Wa[d * 128 + e] = wa[((size_t)(dir * 8 + blk) * 128 + d) * 128 + e]; Wi[d * 128 + e] = wi[((size_t)(dir * 8 + blk) * 128 + d) * 128 + e]; }
  const float sp = log1pf(expf(-lam[dir * 1024 + c]));
  const float bav = ba[dir * 1024 + c], biv = bi[dir * 1024 + c];
  const float cw0 = conv_w[0 * 1024 + c], cw1 = conv_w[1 * 1024 + c], cw2 = conv_w[2 * 1024 + c], cw3 = conv_w[3 * 1024 + c], cb = conv_b[c];
  float h = 0.f;
  bf16_t* ho = dir ? hout_b : hout_f;
  for (int step = 0; step < SEQ; ++step) {
    const int t = dir ? (SEQ - 1 - step) : step;
    const size_t rowb = (size_t)b * SEQ;
    float xv = cb;
    if (t - 1 >= 0) xv += cw0 * bf2f(lrx[(rowb + t - 1) * DM + c]);
    xv += cw1 * bf2f(lrx[(rowb + t) * DM + c]);
    if (t + 1 < SEQ) xv += cw2 * bf2f(lrx[(rowb + t + 1) * DM + c]);
    if (t + 2 < SEQ) xv += cw3 * bf2f(lrx[(rowb + t + 2) * DM + c]);
    float* xb = xs + (step & 1) * 128;
    xb[e] = xv;
    __syncthreads();
    float ra = bav, ia = biv;
#pragma unroll 8
    for (int d = 0; d < 128; ++d) { const float xd = xb[d]; ra += xd * Wa[d * 128 + e]; ia += xd * Wi[d * 128 + e]; }
    const float r = sigmoidf_(ra), ig = sigmoidf_(ia);
    const float log_a = -8.f * r * sp;
    const float a = expf(log_a);
    const float mult = sqrtf(-expm1f(2.f * log_a));
    h = a * h + mult * ig * xv;
    ho[(rowb + t) * DM + c] = f2bf(h);
  }
}
__global__ __launch_bounds__(256) void lru_y(const bf16_t* __restrict__ hf, const bf16_t* __restrict__ hb, const bf16_t* __restrict__ lrg, bf16_t* __restrict__ y) {
  const size_t i = (size_t)blockIdx.x * 256 + threadIdx.x;
  y[i] = f2bf((bf2f(hf[i]) + bf2f(hb[i])) * bf2f(lrg[i]));
}

__global__ __launch_bounds__(256) void router(const float* __restrict__ x1, const float* __restrict__ gain2, const float* __restrict__ wg, const float* __restrict__ bg,
                                              const float* __restrict__ wer, const float* __restrict__ ber, bf16_t* __restrict__ h2, int* __restrict__ sel_e, float* __restrict__ sel_w) {
  const int wave = threadIdx.x >> 6, lane = threadIdx.x & 63;
  const size_t tok = (size_t)blockIdx.x * 4 + wave;
  float v[16]; float ss = 0.f;
#pragma unroll
  for (int j = 0; j < 16; ++j) { v[j] = x1[tok * DM + j * 64 + lane]; ss += v[j] * v[j]; }
  ss = wave_sum(ss);
  const float rs = rsqrtf(ss * (1.f / DM) + 1e-6f);
  float lg[20];
#pragma unroll
  for (int k = 0; k < 20; ++k) lg[k] = 0.f;
#pragma unroll
  for (int j = 0; j < 16; ++j) {
    const int d = j * 64 + lane; const float hv = v[j] * rs * gain2[d];
    h2[tok * DM + d] = f2bf(hv);
    const float4 g4 = *(const float4*)&wg[d * 4];
    lg[0] += hv * g4.x; lg[1] += hv * g4.y; lg[2] += hv * g4.z; lg[3] += hv * g4.w;
#pragma unroll
    for (int q = 0; q < 4; ++q) { const float4 e4 = *(const float4*)&wer[d * 16 + q * 4]; lg[4 + q * 4 + 0] += hv * e4.x; lg[4 + q * 4 + 1] += hv * e4.y; lg[4 + q * 4 + 2] += hv * e4.z; lg[4 + q * 4 + 3] += hv * e4.w; }
  }
#pragma unroll
  for (int k = 0; k < 20; ++k) lg[k] = wave_sum(lg[k]);
  if (lane == 0) {
    float gl0 = lg[0] + bg[0], gl1 = lg[1] + bg[1], gl2 = lg[2] + bg[2], gl3 = lg[3] + bg[3];
    int gs = 0; float gm = gl0;
    if (gl1 > gm) { gm = gl1; gs = 1; } if (gl2 > gm) { gm = gl2; gs = 2; } if (gl3 > gm) { gm = gl3; gs = 3; }
    const float gden = expf(gl0 - gm) + expf(gl1 - gm) + expf(gl2 - gm) + expf(gl3 - gm);
    const float gw = 1.f / gden;
    float el[4];
#pragma unroll
    for (int j = 0; j < 4; ++j) {
      float s0 = lg[4 + j], s1 = lg[8 + j], s2 = lg[12 + j], s3 = lg[16 + j];
      el[j] = (gs == 0 ? s0 : gs == 1 ? s1 : gs == 2 ? s2 : s3) + ber[gs * 4 + j];
    }
    int i0 = 0; float v0 = el[0];
    if (el[1] > v0) { v0 = el[1]; i0 = 1; } if (el[2] > v0) { v0 = el[2]; i0 = 2; } if (el[3] > v0) { v0 = el[3]; i0 = 3; }
    int i1 = (i0 == 0) ? 1 : 0; float v1 = -3.0e38f;
#pragma unroll
    for (int j = 0; j < 4; ++j) { if (j != i0 && el[j] > v1) { v1 = el[j]; i1 = j; } }
    const float ex = expf(v1 - v0); const float w0 = gw / (1.f + ex), w1 = gw * ex / (1.f + ex);
    sel_e[tok * 2 + 0] = gs * 4 + i0; sel_e[tok * 2 + 1] = gs * 4 + i1;
    sel_w[tok * 2 + 0] = w0; sel_w[tok * 2 + 1] = w1;
  }
}

__global__ __launch_bounds__(256) void nmoe(const bf16_t* __restrict__ h2, const int* __restrict__ sel_e, const float* __restrict__ sel_w,
                                            const float* __restrict__ Wg, const float* __restrict__ Wu, const float* __restrict__ Wd, const float* __restrict__ x1, float* __restrict__ out) {
  __shared__ float hs[1024]; __shared__ float hid[512];
  const int tid = threadIdx.x; const size_t tok = blockIdx.x;
  for (int d = tid; d < 1024; d += 256) hs[d] = bf2f(h2[tok * DM + d]);
  float y0 = 0.f, y1 = 0.f, y2 = 0.f, y3 = 0.f;
  for (int s = 0; s < 2; ++s) {
    const int e = sel_e[tok * 2 + s]; const float w = sel_w[tok * 2 + s];
    __syncthreads();
#pragma unroll
    for (int ff = 0; ff < 2; ++ff) {
      const int f = tid + ff * 256; float a = 0.f, u = 0.f;
      const float* pg = Wg + (size_t)e * 1024 * 512 + f; const float* pu = Wu + (size_t)e * 1024 * 512 + f;
#pragma unroll 8
      for (int d = 0; d < 1024; ++d) { const float hv = hs[d]; a += hv * pg[(size_t)d * 512]; u += hv * pu[(size_t)d * 512]; }
      hid[f] = a / (1.f + __expf(-a)) * u * w;
    }
    __syncthreads();
    const float* pd = Wd + (size_t)e * 512 * 1024 + tid;
#pragma unroll 8
    for (int f = 0; f < 512; ++f) { const float hv = hid[f]; y0 += hv * pd[(size_t)f * 1024]; y1 += hv * pd[(size_t)f * 1024 + 256]; y2 += hv * pd[(size_t)f * 1024 + 512]; y3 += hv * pd[(size_t)f * 1024 + 768]; }
  }
  out[tok * DM + tid] = x1[tok * DM + tid] + y0; out[tok * DM + tid + 256] = x1[tok * DM + tid + 256] + y1;
  out[tok * DM + tid + 512] = x1[tok * DM + tid + 512] + y2; out[tok * DM + tid + 768] = x1[tok * DM + tid + 768] + y3;
}
}

namespace pg8 {
#define PG8_LAS __attribute__((address_space(3)))
typedef unsigned short bf16_t;
typedef short bf16x8 __attribute__((ext_vector_type(8)));
typedef float f32x4 __attribute__((ext_vector_type(4)));
typedef unsigned u32x4 __attribute__((ext_vector_type(4)));
constexpr int BM = 256, BK = 64, HALF = 128, HTB = HALF * BK * 2  , STAGE_BYTES = 8 * HTB, NXCD = 8, WGM = 8;

__host__ __device__ __forceinline__ int lds_byte(int r, int c) { const int st = (r >> 4) * 2 + (c >> 5), rr = r & 15, cc = c & 31, ob = rr * 64 + cc * 2; return st * 1024 + (ob ^ (((ob >> 9) & 1) << 5)); }
__host__ __device__ __forceinline__ void stage_rc(int b, int& R, int& C) { const int st = b / 1024, sb = b % 1024, swz = sb ^ (((sb >> 9) & 1) << 5); R = (st >> 1) * 16 + swz / 64; C = (st & 1) * 32 + (swz % 64) / 2; }
__host__ __device__ __forceinline__ int perm32(int rho) { const int n = rho >> 4, i = rho & 15; return 8 * (i >> 2) + 4 * n + (i & 3); }

struct Unit { int pm, pn; };
struct GUnit { int pm, pn, e, pos0, cnt; };
struct Gemm { const bf16_t* A; const bf16_t* Bt; int M, N, K; };

struct StaticOrder {
    int nM, nN, nwg, G, c;
    __host__ __device__ void init(int M, int N, int G_, int c_) { nM = M / BM; nN = N / BM; nwg = nM * nN; G = G_; c = c_; }
    __host__ __device__ bool next(int i, Unit& u) const {
        const long L = (long)i * G + c; if (L >= nwg) return false;
        int wgid = (int)L; { const int q = nwg / NXCD, r = nwg % NXCD, xcd = wgid % NXCD, off = wgid / NXCD; wgid = (xcd < r ? xcd * (q + 1) : r * (q + 1) + (xcd - r) * q) + off; }
        const int nig = WGM * nN, gid = wgid / nig, fm = gid * WGM, gsz = (nM - fm) < WGM ? (nM - fm) : WGM;
        u.pm = fm + ((wgid % nig) % gsz); u.pn = (wgid % nig) / gsz; return true;
    }
    __device__ __forceinline__ void a_ready(const Unit&) const {}
    __device__ __forceinline__ void done(const Unit&) const {}
};

__device__ __forceinline__ unsigned cvt_pk_bf16(float lo, float hi) { unsigned r; asm volatile("v_cvt_pk_bf16_f32 %0, %1, %2" : "=v"(r) : "v"(lo), "v"(hi)); return r; }
typedef float f32x2 __attribute__((ext_vector_type(2)));
template <class Epi, class Sched, bool ALIGN_EPI = false, bool SP2 = false>
__device__ __forceinline__ void gemm_phase(PG8_LAS unsigned char* lds, const Gemm g, const Sched& S, const Epi& E) {
    const int tid = threadIdx.x, wid = __builtin_amdgcn_readfirstlane(tid >> 6), lane = tid & 63, wr = wid >> 2, wc = wid & 3, fr = lane & 15, fq = lane >> 4;
    const int K = g.K, nt = K / BK;
    unsigned voffA[2], voffB[2];
#pragma unroll
    for (int i = 0; i < 2; ++i) { int R, C; stage_rc(tid * 16 + i * 8192, R, C); const int Rb = Epi::PERM ? ((R & ~31) + perm32(R & 31)) : R;
        voffA[i] = (unsigned)(R * K + C) * 2u; voffB[i] = (unsigned)(Rb * K + C) * 2u; }
    const size_t kstep = (size_t)(BK * 2);
    const size_t hstep = (size_t)HALF * K * 2;
    const size_t tstep = 2 * hstep;
    const unsigned ldsw = (unsigned)wid * 1024u;
    const int aoff = lds_byte(wr * 64 + fr, fq * 8), boff = lds_byte(wc * 32 + fr, fq * 8);
#define PG8_SA(b, h) (((b) * 2 + (h)) * HTB)
#define PG8_SB(b, h) ((4 + (b) * 2 + (h)) * HTB)
#define PG8_STAGE(bufoff, gbase, voff) do { _Pragma("unroll") for (int _i = 0; _i < 2; ++_i) \
        __builtin_amdgcn_global_load_lds((const unsigned*)((const char*)(gbase) + (voff)[_i]), (PG8_LAS unsigned*)(lds + (bufoff) + ldsw + _i * 8192), 16, 0, 0); } while (0)
#define PG8_LDA(dst, b, h) do { _Pragma("unroll") for (int m = 0; m < 4; ++m) _Pragma("unroll") for (int k = 0; k < 2; ++k) dst[m][k] = *(const PG8_LAS bf16x8*)(lds + PG8_SA(b, h) + aoff + m * 2048 + k * 1024); } while (0)
#define PG8_LDB(dst, b, h) do { _Pragma("unroll") for (int n = 0; n < 2; ++n) _Pragma("unroll") for (int k = 0; k < 2; ++k) dst[n][k] = *(const PG8_LAS bf16x8*)(lds + PG8_SB(b, h) + boff + n * 2048 + k * 1024); } while (0)
#define PG8_MMA(ai, bj, At, Bt) do { __builtin_amdgcn_s_setprio(1); _Pragma("unroll") for (int m = 0; m < 4; ++m) _Pragma("unroll") for (int n = 0; n < 2; ++n) _Pragma("unroll") for (int k = 0; k < 2; ++k) \
        acc[ai][bj][m][n] = __builtin_amdgcn_mfma_f32_16x16x32_bf16(Bt[n][k], At[m][k], acc[ai][bj][m][n], 0, 0, 0); __builtin_amdgcn_s_setprio(0); } while (0)
#define PG8_WAIT_V(n) asm volatile("s_waitcnt vmcnt(" #n ")" ::: "memory")
#define PG8_WAIT_L(n) asm volatile("s_waitcnt lgkmcnt(" #n ")" ::: "memory")
#define PG8_BAR __builtin_amdgcn_s_barrier()
#define PG8_SCHED __builtin_amdgcn_sched_barrier(0)
    Unit cur, nxt; int ui = 0;
    if (!S.next(0, cur)) return;
    f32x4 acc[2][2][4][2];
#pragma unroll
    for (int a = 0; a < 2; ++a)
#pragma unroll
        for (int b = 0; b < 2; ++b)
#pragma unroll
            for (int m = 0; m < 4; ++m)
#pragma unroll
                for (int n = 0; n < 2; ++n) acc[a][b][m][n] = (f32x4){0.f, 0.f, 0.f, 0.f};
    bf16x8 At[4][2], B0[2][2], B1[2][2];
    const char* cA = (const char*)g.A + (size_t)cur.pm * tstep; const char* cB = (const char*)g.Bt + (size_t)cur.pn * tstep;
    S.a_ready(cur);
    if constexpr (SP2) {
        PG8_STAGE(PG8_SB(0, 0), cB, voffB); PG8_STAGE(PG8_SB(0, 1), cB + hstep, voffB); PG8_STAGE(PG8_SA(0, 0), cA, voffA); PG8_STAGE(PG8_SA(0, 1), cA + hstep, voffA);
        if (wr == 1) PG8_BAR;
        PG8_WAIT_V(2); PG8_BAR;
        PG8_STAGE(PG8_SB(1, 0), cB + kstep, voffB); PG8_STAGE(PG8_SA(1, 0), cA + kstep, voffA); PG8_STAGE(PG8_SB(1, 1), cB + hstep + kstep, voffB);
        PG8_WAIT_V(6); PG8_BAR;
    } else {
        PG8_STAGE(PG8_SB(0, 0), cB, voffB); PG8_STAGE(PG8_SA(0, 0), cA, voffA); PG8_STAGE(PG8_SB(0, 1), cB + hstep, voffB); PG8_STAGE(PG8_SA(0, 1), cA + hstep, voffA);
        if (wr == 1) PG8_BAR;
        PG8_WAIT_V(4); PG8_BAR;
        PG8_STAGE(PG8_SB(1, 0), cB + kstep, voffB); PG8_STAGE(PG8_SA(1, 0), cA + kstep, voffA); PG8_STAGE(PG8_SB(1, 1), cB + hstep + kstep, voffB);
        PG8_WAIT_V(6); PG8_BAR;
    }
    for (;;) {
        const bool has_next = S.next(ui + 1, nxt);
        const char* nA = has_next ? (const char*)g.A + (size_t)nxt.pm * tstep : cA; const char* nB = has_next ? (const char*)g.Bt + (size_t)nxt.pn * tstep : cB;
        for (int t = 0; t < nt; t += 2) {
            const bool last = (t == nt - 2);
            const char* a1 = cA + (size_t)(t + 1) * kstep;
            const char* a2 = last ? nA : cA + (size_t)(t + 2) * kstep; const char* b2 = last ? nB : cB + (size_t)(t + 2) * kstep;
            const char* a3 = a2 + kstep; const char* b3 = b2 + kstep;
            if (last && has_next) S.a_ready(nxt);
            if constexpr (SP2) {
            PG8_LDB(B0, 0, 0); PG8_LDB(B1, 0, 1); PG8_SCHED; PG8_LDA(At, 0, 0); PG8_STAGE(PG8_SA(1, 1), a1 + hstep, voffA);
            PG8_WAIT_V(8); PG8_WAIT_L(0); PG8_BAR; PG8_MMA(0, 0, At, B0); PG8_MMA(0, 1, At, B1); PG8_BAR; PG8_SCHED;
            PG8_LDA(At, 0, 1); PG8_STAGE(PG8_SB(0, 0), b2, voffB); PG8_STAGE(PG8_SB(0, 1), b2 + hstep, voffB); PG8_STAGE(PG8_SA(0, 0), a2, voffA);
            PG8_WAIT_V(8); PG8_WAIT_L(0); PG8_BAR; PG8_MMA(1, 0, At, B0); PG8_MMA(1, 1, At, B1); PG8_BAR; PG8_SCHED;
            PG8_LDB(B0, 1, 0); PG8_LDB(B1, 1, 1); PG8_SCHED; PG8_LDA(At, 1, 0); PG8_STAGE(PG8_SA(0, 1), a2 + hstep, voffA);
            PG8_WAIT_V(8); PG8_WAIT_L(0); PG8_BAR; PG8_MMA(0, 0, At, B0); PG8_MMA(0, 1, At, B1); PG8_BAR; PG8_SCHED;
            PG8_LDA(At, 1, 1); PG8_STAGE(PG8_SB(1, 0), b3, voffB); PG8_STAGE(PG8_SB(1, 1), b3 + hstep, voffB); PG8_STAGE(PG8_SA(1, 0), a3, voffA);
            PG8_WAIT_V(8); PG8_WAIT_L(0); PG8_BAR; PG8_MMA(1, 0, At, B0); PG8_MMA(1, 1, At, B1); PG8_BAR; PG8_SCHED;
            } else {
            PG8_LDB(B0, 0, 0); PG8_SCHED; PG8_LDA(At, 0, 0); PG8_STAGE(PG8_SA(1, 1), a1 + hstep, voffA);
            PG8_WAIT_L(8); PG8_BAR; PG8_WAIT_L(0); PG8_MMA(0, 0, At, B0); PG8_BAR; PG8_SCHED;
            PG8_LDB(B1, 0, 1); PG8_STAGE(PG8_SB(0, 0), b2, voffB);
            PG8_BAR; PG8_WAIT_L(0); PG8_MMA(0, 1, At, B1); PG8_BAR;
            PG8_LDA(At, 0, 1); PG8_STAGE(PG8_SA(0, 0), a2, voffA);
            PG8_BAR; PG8_WAIT_L(0); PG8_MMA(1, 0, At, B0); PG8_BAR; PG8_SCHED;
            PG8_STAGE(PG8_SB(0, 1), b2 + hstep, voffB);
            PG8_WAIT_V(6); PG8_BAR; PG8_MMA(1, 1, At, B1); PG8_BAR;
            PG8_LDB(B0, 1, 0); PG8_SCHED; PG8_LDA(At, 1, 0); PG8_STAGE(PG8_SA(0, 1), a2 + hstep, voffA);
            PG8_WAIT_L(8); PG8_BAR; PG8_WAIT_L(0); PG8_MMA(0, 0, At, B0); PG8_BAR; PG8_SCHED;
            PG8_LDB(B1, 1, 1); PG8_STAGE(PG8_SB(1, 0), b3, voffB);
            PG8_BAR; PG8_WAIT_L(0); PG8_MMA(0, 1, At, B1); PG8_BAR;
            PG8_LDA(At, 1, 1); PG8_STAGE(PG8_SA(1, 0), a3, voffA);
            PG8_BAR; PG8_WAIT_L(0); PG8_MMA(1, 0, At, B0); PG8_BAR; PG8_SCHED;
            PG8_STAGE(PG8_SB(1, 1), b3 + hstep, voffB);
            PG8_WAIT_V(6); PG8_BAR; PG8_MMA(1, 1, At, B1); PG8_BAR;
            }
        }
        if constexpr (ALIGN_EPI) { if (wr == 0) PG8_BAR; }
        if constexpr (!Epi::AFTER_DRAIN) { E(acc, cur, wr, wc, fr, fq); S.done(cur); }
        if (!has_next) break;
#pragma unroll
        for (int a = 0; a < 2; ++a)
#pragma unroll
            for (int b = 0; b < 2; ++b)
#pragma unroll
                for (int m = 0; m < 4; ++m)
#pragma unroll
                    for (int n = 0; n < 2; ++n) acc[a][b][m][n] = (f32x4){0.f, 0.f, 0.f, 0.f};
        cur = nxt; cA = nA; cB = nB; ++ui;
        if constexpr (ALIGN_EPI) { if (wr == 1) PG8_BAR; }
    }
    PG8_WAIT_V(0);
    if constexpr (!ALIGN_EPI) { if (wr == 0) PG8_BAR; }
    PG8_BAR;
    if constexpr (Epi::AFTER_DRAIN) { E.fused(acc, cur, wr, wc, fr, fq, lds, wid, lane); S.done(cur); }
#undef PG8_SA
#undef PG8_SB
#undef PG8_STAGE
#undef PG8_LDA
#undef PG8_LDB
#undef PG8_MMA
#undef PG8_WAIT_V
#undef PG8_WAIT_L
#undef PG8_BAR
#undef PG8_SCHED
}
}
namespace pg8 {
template <class Epi, class Sched, int MODE, bool ALIGN_EPI = true>
__device__ __forceinline__ void gemm_grouped(PG8_LAS unsigned char* lds, const Gemm g, const Sched& S, const Epi& E) {
    constexpr bool SP2 = true;
    const int tid = threadIdx.x, wid = __builtin_amdgcn_readfirstlane(tid >> 6), lane = tid & 63, wr = wid >> 2, wc = wid & 3, fr = lane & 15, fq = lane >> 4;
    const int K = g.K, nt = K / BK;
    unsigned voffA[2], voffB[2];
#pragma unroll
    for (int i = 0; i < 2; ++i) { int R, C; stage_rc(tid * 16 + i * 8192, R, C); const int Rb = Epi::PERM ? ((R & ~31) + perm32(R & 31)) : R;
        voffA[i] = (unsigned)(R * K + C) * 2u; voffB[i] = (unsigned)(Rb * K + C) * 2u; }
    const size_t kstep = (size_t)(BK * 2);
    const size_t hstep = (size_t)HALF * K * 2;
    const size_t tstep = 2 * hstep;
    const unsigned ldsw = (unsigned)wid * 1024u;
    const int aoff = lds_byte(wr * 64 + fr, fq * 8), boff = lds_byte(wc * 32 + fr, fq * 8);
#define PG8_SA(b, h) (((b) * 2 + (h)) * HTB)
#define PG8_SB(b, h) ((4 + (b) * 2 + (h)) * HTB)
#define PG8_STAGE(bufoff, gbase, voff) do { _Pragma("unroll") for (int _i = 0; _i < 2; ++_i) \
        __builtin_amdgcn_global_load_lds((const unsigned*)((const char*)(gbase) + (voff)[_i]), (PG8_LAS unsigned*)(lds + (bufoff) + ldsw + _i * 8192), 16, 0, 0); } while (0)
#define PG8_STAGE_A(bufoff, kptr, h, nx) do { if (MODE == 0) { unsigned _v[2]; _v[0] = (nx) ? nvA[h][0] : cvA[h][0]; _v[1] = (nx) ? nvA[h][1] : cvA[h][1]; PG8_STAGE(bufoff, kptr, _v); } else { PG8_STAGE(bufoff, (kptr) + (h) * hstep, voffA); } } while (0)
#define PG8_LDA(dst, b, h) do { _Pragma("unroll") for (int m = 0; m < 4; ++m) _Pragma("unroll") for (int k = 0; k < 2; ++k) dst[m][k] = *(const PG8_LAS bf16x8*)(lds + PG8_SA(b, h) + aoff + m * 2048 + k * 1024); } while (0)
#define PG8_LDB(dst, b, h) do { _Pragma("unroll") for (int n = 0; n < 2; ++n) _Pragma("unroll") for (int k = 0; k < 2; ++k) dst[n][k] = *(const PG8_LAS bf16x8*)(lds + PG8_SB(b, h) + boff + n * 2048 + k * 1024); } while (0)
#define PG8_MMA(ai, bj, At, Bt) do { __builtin_amdgcn_s_setprio(1); _Pragma("unroll") for (int m = 0; m < 4; ++m) _Pragma("unroll") for (int n = 0; n < 2; ++n) _Pragma("unroll") for (int k = 0; k < 2; ++k) \
        acc[ai][bj][m][n] = __builtin_amdgcn_mfma_f32_16x16x32_bf16(Bt[n][k], At[m][k], acc[ai][bj][m][n], 0, 0, 0); __builtin_amdgcn_s_setprio(0); } while (0)
#define PG8_WAIT_V(n) asm volatile("s_waitcnt vmcnt(" #n ")" ::: "memory")
#define PG8_WAIT_L(n) asm volatile("s_waitcnt lgkmcnt(" #n ")" ::: "memory")
#define PG8_BAR __builtin_amdgcn_s_barrier()
#define PG8_SCHED __builtin_amdgcn_sched_barrier(0)
    GUnit cur, nxt; int ui = 0;
    if (!S.next(0, cur)) return;
    unsigned cvA[2][2], nvA[2][2];
    if (MODE == 0) S.rows(cur, voffA, cvA);
    f32x4 acc[2][2][4][2];
#pragma unroll
    for (int a = 0; a < 2; ++a)
#pragma unroll
        for (int b = 0; b < 2; ++b)
#pragma unroll
            for (int m = 0; m < 4; ++m)
#pragma unroll
                for (int n = 0; n < 2; ++n) acc[a][b][m][n] = (f32x4){0.f, 0.f, 0.f, 0.f};
    bf16x8 At[4][2], B0[2][2], B1[2][2];
    const size_t estep = (size_t)g.N * K * 2;
    const char* cA = (const char*)g.A + (MODE == 0 ? (size_t)0 : (size_t)cur.pm * tstep); const char* cB = (const char*)g.Bt + (size_t)cur.e * estep + (size_t)cur.pn * tstep;
    S.a_ready(cur);
    if constexpr (SP2) {
        PG8_STAGE(PG8_SB(0, 0), cB, voffB); PG8_STAGE(PG8_SB(0, 1), cB + hstep, voffB); PG8_STAGE_A(PG8_SA(0, 0), cA, 0, false); PG8_STAGE_A(PG8_SA(0, 1), cA, 1, false);
        if (wr == 1) PG8_BAR;
        PG8_WAIT_V(2); PG8_BAR;
        PG8_STAGE(PG8_SB(1, 0), cB + kstep, voffB); PG8_STAGE_A(PG8_SA(1, 0), cA + kstep, 0, false); PG8_STAGE(PG8_SB(1, 1), cB + hstep + kstep, voffB);
        PG8_WAIT_V(6); PG8_BAR;
    } else {
        PG8_STAGE(PG8_SB(0, 0), cB, voffB); PG8_STAGE(PG8_SA(0, 0), cA, voffA); PG8_STAGE(PG8_SB(0, 1), cB + hstep, voffB); PG8_STAGE(PG8_SA(0, 1), cA + hstep, voffA);
        if (wr == 1) PG8_BAR;
        PG8_WAIT_V(4); PG8_BAR;
        PG8_STAGE(PG8_SB(1, 0), cB + kstep, voffB); PG8_STAGE_A(PG8_SA(1, 0), cA + kstep, 0, false); PG8_STAGE(PG8_SB(1, 1), cB + hstep + kstep, voffB);
        PG8_WAIT_V(6); PG8_BAR;
    }
    for (;;) {
        const bool has_next = S.next(ui + 1, nxt);
        const char* nA = (MODE == 0) ? cA : (has_next ? (const char*)g.A + (size_t)nxt.pm * tstep : cA); const char* nB = has_next ? (const char*)g.Bt + (size_t)nxt.e * estep + (size_t)nxt.pn * tstep : cB;
        if (MODE == 0) { if (has_next) S.rows(nxt, voffA, nvA); else { nvA[0][0] = cvA[0][0]; nvA[0][1] = cvA[0][1]; nvA[1][0] = cvA[1][0]; nvA[1][1] = cvA[1][1]; } }
        for (int t = 0; t < nt; t += 2) {
            const bool last = (t == nt - 2);
            const char* a1 = cA + (size_t)(t + 1) * kstep;
            const char* a2 = last ? nA : cA + (size_t)(t + 2) * kstep; const char* b2 = last ? nB : cB + (size_t)(t + 2) * kstep;
            const char* a3 = a2 + kstep; const char* b3 = b2 + kstep;
            if (last && has_next) S.a_ready(nxt);
            if constexpr (SP2) {
            PG8_LDB(B0, 0, 0); PG8_LDB(B1, 0, 1); PG8_SCHED; PG8_LDA(At, 0, 0); PG8_STAGE_A(PG8_SA(1, 1), a1, 1, false);
            PG8_WAIT_V(8); PG8_WAIT_L(0); PG8_BAR; PG8_MMA(0, 0, At, B0); PG8_MMA(0, 1, At, B1); PG8_BAR; PG8_SCHED;
            PG8_LDA(At, 0, 1); PG8_STAGE(PG8_SB(0, 0), b2, voffB); PG8_STAGE(PG8_SB(0, 1), b2 + hstep, voffB); PG8_STAGE_A(PG8_SA(0, 0), a2, 0, last);
            PG8_WAIT_V(8); PG8_WAIT_L(0); PG8_BAR; PG8_MMA(1, 0, At, B0); PG8_MMA(1, 1, At, B1); PG8_BAR; PG8_SCHED;
            PG8_LDB(B0, 1, 0); PG8_LDB(B1, 1, 1); PG8_SCHED; PG8_LDA(At, 1, 0); PG8_STAGE_A(PG8_SA(0, 1), a2, 1, last);
            PG8_WAIT_V(8); PG8_WAIT_L(0); PG8_BAR; PG8_MMA(0, 0, At, B0); PG8_MMA(0, 1, At, B1); PG8_BAR; PG8_SCHED;
            PG8_LDA(At, 1, 1); PG8_STAGE(PG8_SB(1, 0), b3, voffB); PG8_STAGE(PG8_SB(1, 1), b3 + hstep, voffB); PG8_STAGE_A(PG8_SA(1, 0), a3, 0, last);
            PG8_WAIT_V(8); PG8_WAIT_L(0); PG8_BAR; PG8_MMA(1, 0, At, B0); PG8_MMA(1, 1, At, B1); PG8_BAR; PG8_SCHED;
            } else {
            PG8_LDB(B0, 0, 0); PG8_SCHED; PG8_LDA(At, 0, 0); PG8_STAGE_A(PG8_SA(1, 1), a1, 1, false);
            PG8_WAIT_L(8); PG8_BAR; PG8_WAIT_L(0); PG8_MMA(0, 0, At, B0); PG8_BAR; PG8_SCHED;
            PG8_LDB(B1, 0, 1); PG8_STAGE(PG8_SB(0, 0), b2, voffB);
            PG8_BAR; PG8_WAIT_L(0); PG8_MMA(0, 1, At, B1); PG8_BAR;
            PG8_LDA(At, 0, 1); PG8_STAGE_A(PG8_SA(0, 0), a2, 0, last);
            PG8_BAR; PG8_WAIT_L(0); PG8_MMA(1, 0, At, B0); PG8_BAR; PG8_SCHED;
            PG8_STAGE(PG8_SB(0, 1), b2 + hstep, voffB);
            PG8_WAIT_V(6); PG8_BAR; PG8_MMA(1, 1, At, B1); PG8_BAR;
            PG8_LDB(B0, 1, 0); PG8_SCHED; PG8_LDA(At, 1, 0); PG8_STAGE_A(PG8_SA(0, 1), a2, 1, last);
            PG8_WAIT_L(8); PG8_BAR; PG8_WAIT_L(0); PG8_MMA(0, 0, At, B0); PG8_BAR; PG8_SCHED;
            PG8_LDB(B1, 1, 1); PG8_STAGE(PG8_SB(1, 0), b3, voffB);
            PG8_BAR; PG8_WAIT_L(0); PG8_MMA(0, 1, At, B1); PG8_BAR;
            PG8_LDA(At, 1, 1); PG8_STAGE_A(PG8_SA(1, 0), a3, 0, last);
            PG8_BAR; PG8_WAIT_L(0); PG8_MMA(1, 0, At, B0); PG8_BAR; PG8_SCHED;
            PG8_STAGE(PG8_SB(1, 1), b3 + hstep, voffB);
            PG8_WAIT_V(6); PG8_BAR; PG8_MMA(1, 1, At, B1); PG8_BAR;
            }
        }
        if constexpr (ALIGN_EPI) { if (wr == 0) PG8_BAR; }
        if constexpr (!Epi::AFTER_DRAIN) { E(acc, cur, wr, wc, fr, fq); S.done(cur); }
        if (!has_next) break;
#pragma unroll
        for (int a = 0; a < 2; ++a)
#pragma unroll
            for (int b = 0; b < 2; ++b)
#pragma unroll
                for (int m = 0; m < 4; ++m)
#pragma unroll
                    for (int n = 0; n < 2; ++n) acc[a][b][m][n] = (f32x4){0.f, 0.f, 0.f, 0.f};
        cur = nxt; cA = nA; cB = nB; ++ui;
        if (MODE == 0) { cvA[0][0] = nvA[0][0]; cvA[0][1] = nvA[0][1]; cvA[1][0] = nvA[1][0]; cvA[1][1] = nvA[1][1]; }
        if constexpr (ALIGN_EPI) { if (wr == 1) PG8_BAR; }
    }
    PG8_WAIT_V(0);
    if constexpr (!ALIGN_EPI) { if (wr == 0) PG8_BAR; }
    PG8_BAR;
    if constexpr (Epi::AFTER_DRAIN) { E.fused(acc, cur, wr, wc, fr, fq, lds, wid, lane); S.done(cur); }
#undef PG8_SA
#undef PG8_SB
#undef PG8_STAGE
#undef PG8_STAGE_A
#undef PG8_LDA
#undef PG8_LDB
#undef PG8_MMA
#undef PG8_WAIT_V
#undef PG8_WAIT_L
#undef PG8_BAR
#undef PG8_SCHED
}
}
namespace pg8 {
__device__ __forceinline__ float fast_sigmoid(float x) { return __builtin_amdgcn_rcpf(1.f + __expf(-x)); }
__device__ __forceinline__ float fast_gelu_tanh(float x) { const float t = 1.5957691216057308f * (x + 0.044715f * x * x * x); return x * __builtin_amdgcn_rcpf(1.f + __expf(-t)); }
__device__ __forceinline__ u32x4 pack8(const f32x4 a, const f32x4 b) { u32x4 w; w.x = cvt_pk_bf16(a[0], a[1]); w.y = cvt_pk_bf16(a[2], a[3]); w.z = cvt_pk_bf16(b[0], b[1]); w.w = cvt_pk_bf16(b[2], b[3]); return w; }

struct EpiProj {
    static constexpr bool PERM = true, AFTER_DRAIN = false;
    const float* rs1; const float* bg; const float* qg; const float* kg; const float* cosT; const float* sinT;
    bf16_t *QP, *KP, *VB, *LRX, *LRG, *GA, *GL;
    __device__ __forceinline__ void operator()(const f32x4 (&acc)[2][2][4][2], const Unit& u, int wr, int wc, int fr, int fq) const {
        const int type = u.pn >> 2;
        const int rowt = u.pm * BM + wr * 64 + fr;
        const int b = (u.pm * BM) >> 12;
        if (type <= 1) {
            const bool isq = (type == 0);
            const float* gsrc = isq ? qg : kg;
            f32x4 g[2][2];
#pragma unroll
            for (int bj = 0; bj < 2; ++bj)
#pragma unroll
                for (int n = 0; n < 2; ++n) g[bj][n] = *(const f32x4*)(gsrc + 32 * bj + 8 * fq + 4 * n);
            const int hc = (u.pn & 3) * 4 + wc;
            bf16_t* dstbase = (isq ? QP : KP) + ((size_t)(b * 16 + hc) * 4096) * 64 + 8 * fq;
            const float osc = isq ? (0.125f * 1.4426950408889634f) : 1.f;
#pragma unroll
            for (int ai = 0; ai < 2; ++ai)
#pragma unroll
                for (int m = 0; m < 4; ++m) {
                    const int row = rowt + ai * HALF + m * 16; const int pos = row & 4095; const float rsv = rs1[row];
                    f32x4 v[2][2]; float ss = 0.f;
#pragma unroll
                    for (int bj = 0; bj < 2; ++bj)
#pragma unroll
                        for (int n = 0; n < 2; ++n) { v[bj][n] = acc[ai][bj][m][n] * rsv; const f32x4 q = v[bj][n] * v[bj][n]; ss += (q[0] + q[1]) + (q[2] + q[3]); }
                    ss += __shfl_xor(ss, 16); ss += __shfl_xor(ss, 32);
                    const float rn = rsqrtf(ss * (1.f / 64.f) + 1e-6f);
                    f32x4 o0[2], o1[2];
#pragma unroll
                    for (int n = 0; n < 2; ++n) {
                        const f32x4 c = *(const f32x4*)(cosT + pos * 32 + 8 * fq + 4 * n), s = *(const f32x4*)(sinT + pos * 32 + 8 * fq + 4 * n);
                        const f32x4 y0 = v[0][n] * rn * g[0][n], y1 = v[1][n] * rn * g[1][n];
                        o0[n] = (y0 * c - y1 * s) * osc; o1[n] = (y0 * s + y1 * c) * osc;
                    }
                    bf16_t* dst = dstbase + (size_t)pos * 64;
                    *(u32x4*)dst = pack8(o0[0], o0[1]);
                    *(u32x4*)(dst + 32) = pack8(o1[0], o1[1]);
                }
        } else {
            const int colt = (u.pn & 3) * 256 + wc * 32 + 8 * fq;
#pragma unroll
            for (int ai = 0; ai < 2; ++ai)
#pragma unroll
                for (int m = 0; m < 4; ++m) {
                    const int row = rowt + ai * HALF + m * 16; const int pos = row & 4095; const float rsv = rs1[row];
#pragma unroll
                    for (int bj = 0; bj < 2; ++bj) {
                        const int col = colt + 128 * bj;
                        f32x4 v0 = acc[ai][bj][m][0] * rsv, v1 = acc[ai][bj][m][1] * rsv;
                        bf16_t* dst;
                        if (type == 2) { dst = VB + ((size_t)((b * 8 + (col >> 7)) * 4096 + pos)) * 128 + (col & 127); }
                        else if (type == 3) { dst = LRX + (size_t)row * 1024 + col; }
                        else if (type == 4) {
                            dst = LRG + (size_t)row * 1024 + col;
#pragma unroll
                            for (int j = 0; j < 4; ++j) { v0[j] = fast_gelu_tanh(v0[j]); v1[j] = fast_gelu_tanh(v1[j]); }
                        } else {
                            const float* bp = bg + (type == 6 ? 1024 : 0) + col;
                            const f32x4 b0 = *(const f32x4*)bp, b1 = *(const f32x4*)(bp + 4);
                            dst = (type == 5 ? GA : GL) + (size_t)row * 1024 + col;
#pragma unroll
                            for (int j = 0; j < 4; ++j) { v0[j] = fast_sigmoid(v0[j] + b0[j]); v1[j] = fast_sigmoid(v1[j] + b1[j]); }
                        }
                        *(u32x4*)dst = pack8(v0, v1);
                    }
                }
        }
    }
};
__device__ __forceinline__ void unpack8(const u32x4 w, f32x4& a, f32x4& b) {
    a[0] = __uint_as_float(w.x << 16); a[1] = __uint_as_float(w.x & 0xffff0000u); a[2] = __uint_as_float(w.y << 16); a[3] = __uint_as_float(w.y & 0xffff0000u);
    b[0] = __uint_as_float(w.z << 16); b[1] = __uint_as_float(w.z & 0xffff0000u); b[2] = __uint_as_float(w.w << 16); b[3] = __uint_as_float(w.w & 0xffff0000u);
}
template <int PASS> struct EpiMerge {
    static constexpr bool PERM = true, AFTER_DRAIN = false;
    bf16_t* M; const bf16_t* G;
    __device__ __forceinline__ void operator()(const f32x4 (&acc)[2][2][4][2], const Unit& u, int wr, int wc, int fr, int fq) const {
        const int row0 = u.pm * BM + wr * 64 + fr, col0 = u.pn * BM + wc * 32 + 8 * fq;
#pragma unroll
        for (int ai = 0; ai < 2; ++ai)
#pragma unroll
            for (int m = 0; m < 4; ++m)
#pragma unroll
                for (int bj = 0; bj < 2; ++bj) {
                    const size_t idx = (size_t)(row0 + ai * HALF + m * 16) * 1024 + col0 + bj * HALF;
                    f32x4 g0, g1; unpack8(*(const u32x4*)(G + idx), g0, g1);
                    f32x4 v0 = acc[ai][bj][m][0] * g0, v1 = acc[ai][bj][m][1] * g1;
                    if (PASS == 2) { f32x4 t0, t1; unpack8(*(const u32x4*)(M + idx), t0, t1); v0 += t0; v1 += t1; }
                    *(u32x4*)(M + idx) = pack8(v0, v1);
                }
    }
};
struct EpiResid {
    static constexpr bool PERM = false, AFTER_DRAIN = false;
    const float* X; float* O;
    __device__ __forceinline__ void operator()(const f32x4 (&acc)[2][2][4][2], const Unit& u, int wr, int wc, int fr, int fq) const {
        const int row0 = u.pm * BM + wr * 64 + fr, col0 = u.pn * BM + wc * 32 + 4 * fq;
#pragma unroll
        for (int ai = 0; ai < 2; ++ai)
#pragma unroll
            for (int m = 0; m < 4; ++m)
#pragma unroll
                for (int bj = 0; bj < 2; ++bj)
#pragma unroll
                    for (int n = 0; n < 2; ++n) {
                        const size_t idx = (size_t)(row0 + ai * HALF + m * 16) * 1024 + col0 + bj * HALF + n * 16;
                        *(f32x4*)(O + idx) = *(const f32x4*)(X + idx) + acc[ai][bj][m][n];
                    }
    }
};
}

constexpr int NWAVES = 8;
constexpr int RING_OFF = 0, RING_BYTES = 131072;
constexpr int LDSCTL_OFF = RING_BYTES, MISC_OFF = LDSCTL_OFF + 320;
constexpr int LDS_BYTES = 147456;
constexpr size_t WS_CTL = WS_S7, CTL_ZERO_BYTES = 1 * MiB;
constexpr size_t WS_SEL_E = WS_S7 + 1 * MiB, WS_SEL_W = WS_S7 + 2 * MiB;
constexpr size_t WS_RS1 = WS_S7 + 3 * MiB;
constexpr size_t WS_COS = WS_S7 + 3 * MiB + 512 * 1024, WS_SIN = WS_S7 + 4 * MiB;
constexpr size_t WS_WINT = WS_S7 + 5 * MiB;
constexpr size_t WS_WAT = WS_S7 + 19 * MiB, WS_WLT = WS_S7 + 21 * MiB, WS_WOT = WS_S7 + 23 * MiB;
constexpr size_t WS_LRUW = WS_S7 + 25 * MiB;
constexpr size_t WS_LRUS = WS_S7 + 26 * MiB;
constexpr size_t WS_LIST = WS_S7 + 30 * MiB;
constexpr int CW_BAR = 4096, CW_CNT = 8192;

#define GAS __attribute__((address_space(1)))
#define LAS __attribute__((address_space(3)))
typedef unsigned v4u __attribute__((ext_vector_type(4)));
typedef float f32x4 __attribute__((ext_vector_type(4)));
typedef GAS unsigned gu32;
typedef GAS unsigned long long gu64;
#define RLX_AGENT __ATOMIC_RELAXED, __HIP_MEMORY_SCOPE_AGENT
#define LDS_WAIT() asm volatile("s_waitcnt lgkmcnt(0)" ::: "memory")
#define VM_WAIT() asm volatile("s_waitcnt vmcnt(0)" ::: "memory")
__device__ __forceinline__ unsigned pk2(float lo, float hi) { return (unsigned)f2bf(lo) | ((unsigned)f2bf(hi) << 16); }
namespace pg8 {
struct GroupedOrder {
    const PG8_LAS int* tb;
    const int* listT;
    int G, c, nct;
    __device__ __forceinline__ bool next(int i, GUnit& u) const {
        const int L = i * G + c; const int Tn = __builtin_amdgcn_readfirstlane(tb[16]);
        if (L >= Tn * nct) return false;
        const int rt = L / nct; u.pn = L % nct; u.pm = rt;
        int e = 0;
#pragma unroll
        for (int k = 1; k < 16; ++k) e += (rt >= __builtin_amdgcn_readfirstlane(tb[k])) ? 1 : 0;
        u.e = e; u.pos0 = (rt - __builtin_amdgcn_readfirstlane(tb[e])) * 256; u.cnt = __builtin_amdgcn_readfirstlane(tb[32 + e]);
        return true;
    }
    __device__ __forceinline__ void rows(const GUnit& u, const unsigned (&voffA)[2], unsigned (&out)[2][2]) const {
#pragma unroll
        for (int h = 0; h < 2; ++h)
#pragma unroll
            for (int i = 0; i < 2; ++i) {
                const int R = (int)(voffA[i] >> 11) + 128 * h, pos = u.pos0 + R;
                const int tok = (pos < u.cnt) ? (listT[u.e * 16384 + pos] >> 1) : 0;
                out[h][i] = (unsigned)tok * 2048u + (voffA[i] & 2047u);
            }
    }
    __device__ __forceinline__ void a_ready(const GUnit&) const {}
    __device__ __forceinline__ void done(const GUnit&) const {}
};
struct EpiUp {
    static constexpr bool PERM = true, AFTER_DRAIN = false;
    bf16_t* HID; const float* listW;
    __device__ __forceinline__ void operator()(const f32x4 (&acc)[2][2][4][2], const GUnit& u, int wr, int wc, int fr, int fq) const {
        const int f0 = u.pn * 128 + wc * 32 + 8 * fq;
#pragma unroll
        for (int ai = 0; ai < 2; ++ai)
#pragma unroll
            for (int m = 0; m < 4; ++m) {
                const int r = ai * HALF + wr * 64 + m * 16 + fr, pos = u.pos0 + r;
                const float w = (pos < u.cnt) ? listW[u.e * 16384 + pos] : 0.f;
                f32x4 h0, h1;
#pragma unroll
                for (int j = 0; j < 4; ++j) {
                    const float g0 = acc[ai][0][m][0][j], g1 = acc[ai][0][m][1][j];
                    h0[j] = g0 * __builtin_amdgcn_rcpf(1.f + __expf(-g0)) * acc[ai][1][m][0][j] * w;
                    h1[j] = g1 * __builtin_amdgcn_rcpf(1.f + __expf(-g1)) * acc[ai][1][m][1][j] * w;
                }
                *(u32x4*)(HID + (size_t)(u.pm * BM + r) * 512 + f0) = pack8(h0, h1);
            }
    }
};
struct EpiDown {
    static constexpr bool PERM = true, AFTER_DRAIN = false;
    bf16_t* Y0; size_t ystride; const int* listT;
    __device__ __forceinline__ void operator()(const f32x4 (&acc)[2][2][4][2], const GUnit& u, int wr, int wc, int fr, int fq) const {
        const int col0 = u.pn * BM + wc * 32 + 8 * fq;
#pragma unroll
        for (int ai = 0; ai < 2; ++ai)
#pragma unroll
            for (int m = 0; m < 4; ++m) {
                const int r = ai * HALF + wr * 64 + m * 16 + fr, pos = u.pos0 + r;
                if (pos < u.cnt) {
                    const int ent = listT[u.e * 16384 + pos];
                    bf16_t* Y = Y0 + (size_t)(ent & 1) * ystride + (size_t)(ent >> 1) * 1024 + col0;
                    *(u32x4*)Y = pack8(acc[ai][0][m][0], acc[ai][0][m][1]);
                    *(u32x4*)(Y + HALF) = pack8(acc[ai][1][m][0], acc[ai][1][m][1]);
                }
            }
    }
};
}
namespace att {
using bf16x8 = __attribute__((ext_vector_type(8))) short;
using s16x4  = __attribute__((ext_vector_type(4))) short;
using f32x16 = __attribute__((ext_vector_type(16))) float;
using u32x4  = __attribute__((ext_vector_type(4))) unsigned;
constexpr int NW = 8, QBLK = 32, KVBLK = 64;
constexpr int SHM_K = KVBLK * 64 * 2, SHM_V = KVBLK * 128 * 2;
constexpr int LDS_V = 0, LDS_K = 2 * SHM_V, LDS_WS = LDS_K + 2 * SHM_K, LDS_OST = LDS_WS + NW * 256, LDS_END = LDS_OST + NW * 8192;
static_assert(LDS_END <= 131072, "attention LDS");
#define ATT_KSWZ(row, c16) ((row) * 128 + ((((c16) ^ ((row) >> 1)) & 7) << 4))
#define ATT_SBAR() __builtin_amdgcn_sched_barrier(0)
__device__ __forceinline__ int crow(int r, int hi) { return (r & 3) + 8 * (r >> 2) + 4 * hi; }
__device__ __forceinline__ unsigned cvtpk(float lo, float hi) { unsigned r; asm volatile("v_cvt_pk_bf16_f32 %0, %1, %2" : "=v"(r) : "v"(lo), "v"(hi)); return r; }

__device__ __forceinline__ void partialSM(f32x16& p0) {
#pragma unroll
  for (int r = 0; r < 16; ++r) p0[r] = __builtin_amdgcn_exp2f(p0[r]);
}
__device__ __forceinline__ void finishSM(f32x16& p0, f32x16& p1, float& l_reg, bf16x8& pa0, bf16x8& pa1, bf16x8& pa2, bf16x8& pa3) {
#pragma unroll
  for (int r = 0; r < 16; ++r) p1[r] = __builtin_amdgcn_exp2f(p1[r]);
  float ps = 0.f;
#pragma unroll
  for (int r = 0; r < 16; ++r) ps += p0[r];
#pragma unroll
  for (int r = 0; r < 16; ++r) ps += p1[r];
  l_reg += ps;
#define ATT_PK4(P, BASE, OUT) do { unsigned a0 = cvtpk(P[BASE + 0], P[BASE + 1]), a1 = cvtpk(P[BASE + 2], P[BASE + 3]);   \
    unsigned b0 = cvtpk(P[BASE + 4], P[BASE + 5]), b1 = cvtpk(P[BASE + 6], P[BASE + 7]);                              \
    auto r0 = __builtin_amdgcn_permlane32_swap(a0, b0, false, false); auto r1 = __builtin_amdgcn_permlane32_swap(a1, b1, false, false); \
    u32x4 w = {r0[0], r1[0], r0[1], r1[1]}; OUT = *reinterpret_cast<bf16x8*>(&w); } while (0)
  ATT_PK4(p0, 0, pa0); ATT_PK4(p0, 8, pa1); ATT_PK4(p1, 0, pa2); ATT_PK4(p1, 8, pa3);
#undef ATT_PK4
}
__device__ __forceinline__ void qkt(f32x16& p0, f32x16& p1, const char* Ks, const bf16x8* qr, int r32, int hi) {
  p0 = f32x16{}; p1 = f32x16{};
#pragma unroll
  for (int d0 = 0; d0 < 4; ++d0) { const int c16 = d0 * 2 + hi;
    const bf16x8 b0 = *reinterpret_cast<const bf16x8*>(Ks + ATT_KSWZ(r32, c16));
    const bf16x8 b1 = *reinterpret_cast<const bf16x8*>(Ks + ATT_KSWZ(32 + r32, c16));
    p0 = __builtin_amdgcn_mfma_f32_32x32x16_bf16(b0, qr[d0], p0, 0, 0, 0);
    p1 = __builtin_amdgcn_mfma_f32_32x32x16_bf16(b1, qr[d0], p1, 0, 0, 0); }
}
__device__ __forceinline__ int v_st(int k, int c) { const int kk = (k & ~0xC) | ((k & 4) << 1) | ((k & 8) >> 1); return ((kk >> 3) * 4 + (c >> 5)) * 512 + ((kk & 7) * 32 + (c & 31)) * 2; }
__device__ __forceinline__ int v_rd_base(int lane) { return ((lane & 3) << 3) | (((lane >> 2) & 3) << 6) | (((lane >> 4) & 1) << 5) | (((lane >> 5) & 1) << 8); }
constexpr int v_rd_off(int d0, int ks, int half) { return d0 * 512 + ks * 4096 + half * 2048; }
template <int OFF> __device__ __forceinline__ s16x4 tr_read(int vb) {
  s16x4 r; asm volatile("ds_read_b64_tr_b16 %0, %1 offset:%2" : "=&v"(r) : "v"(vb), "i"(OFF) : "memory"); return r;
}
template <int D0> __device__ __forceinline__ void pv_one(f32x16& od, int vb, bf16x8 pa0, bf16x8 pa1, bf16x8 pa2, bf16x8 pa3) {
  const s16x4 l0 = tr_read<v_rd_off(D0, 0, 0)>(vb), h0 = tr_read<v_rd_off(D0, 0, 1)>(vb), l1 = tr_read<v_rd_off(D0, 1, 0)>(vb), h1 = tr_read<v_rd_off(D0, 1, 1)>(vb);
  const s16x4 l2 = tr_read<v_rd_off(D0, 2, 0)>(vb), h2 = tr_read<v_rd_off(D0, 2, 1)>(vb), l3 = tr_read<v_rd_off(D0, 3, 0)>(vb), h3 = tr_read<v_rd_off(D0, 3, 1)>(vb);
  asm volatile("s_waitcnt lgkmcnt(0)" ::: "memory"); ATT_SBAR();
#define ATT_PK(L, H) (bf16x8){L[0], L[1], L[2], L[3], H[0], H[1], H[2], H[3]}
  od = __builtin_amdgcn_mfma_f32_32x32x16_bf16(pa0, ATT_PK(l0, h0), od, 0, 0, 0);
  od = __builtin_amdgcn_mfma_f32_32x32x16_bf16(pa1, ATT_PK(l1, h1), od, 0, 0, 0);
  od = __builtin_amdgcn_mfma_f32_32x32x16_bf16(pa2, ATT_PK(l2, h2), od, 0, 0, 0);
  od = __builtin_amdgcn_mfma_f32_32x32x16_bf16(pa3, ATT_PK(l3, h3), od, 0, 0, 0);
#undef ATT_PK
}
__device__ __forceinline__ void pv_d0(f32x16* o, int vb, bf16x8 pa0, bf16x8 pa1, bf16x8 pa2, bf16x8 pa3) {
  pv_one<0>(o[0], vb, pa0, pa1, pa2, pa3); pv_one<1>(o[1], vb, pa0, pa1, pa2, pa3); pv_one<2>(o[2], vb, pa0, pa1, pa2, pa3); pv_one<3>(o[3], vb, pa0, pa1, pa2, pa3);
}

__device__ __forceinline__ void attn_unit(const bf16_t* __restrict__ Qb, const bf16_t* __restrict__ Kh, const bf16_t* __restrict__ Vh, bf16_t* __restrict__ Ob, char* lds) {
  const int tid = threadIdx.x, wid = tid >> 6, lane = tid & 63, r32 = lane & 31, hi = lane >> 5;
  char* V_lds = lds + LDS_V; char* K_lds = lds + LDS_K;
  float* wsf = (float*)(lds + LDS_WS) + wid * 64;
  float l_reg = 0.f; f32x16 o[4] = {}; bf16x8 qr[4];
  const bf16_t* Qw = Qb + (size_t)(wid * QBLK + r32) * 64 + hi * 8;
#pragma unroll
  for (int d0 = 0; d0 < 4; ++d0) qr[d0] = *reinterpret_cast<const bf16x8*>(Qw + d0 * 16);
  const int kst = ATT_KSWZ(tid >> 3, tid & 7);
  const int vst0 = v_st(tid >> 4, (tid & 15) * 8), vst1 = v_st(32 + (tid >> 4), (tid & 15) * 8);
  const int vb0 = (int)(uintptr_t)V_lds + v_rd_base(lane);
  struct { bf16x8 ks, vs0, vs1; } sr_[1];
#define ATT_SLOAD(i, t) do { sr_[i].ks = *reinterpret_cast<const bf16x8*>(Kh + (size_t)(t) * (KVBLK * 64) + tid * 8); \
    sr_[i].vs0 = *reinterpret_cast<const bf16x8*>(Vh + (size_t)(t) * (KVBLK * 128) + tid * 8); \
    sr_[i].vs1 = *reinterpret_cast<const bf16x8*>(Vh + (size_t)(t) * (KVBLK * 128) + 4096 + tid * 8); } while (0)
#define ATT_SWRITE(b, i) do { *(bf16x8*)(K_lds + (b) * SHM_K + kst) = sr_[i].ks; \
    *(bf16x8*)(V_lds + (b) * SHM_V + vst0) = sr_[i].vs0; *(bf16x8*)(V_lds + (b) * SHM_V + vst1) = sr_[i].vs1; } while (0)
#define ATT_SWAIT() asm volatile("s_waitcnt vmcnt(0)" ::: "memory")
  f32x16 pA0, pA1, pB0, pB1; bf16x8 pa0, pa1, pa2, pa3; constexpr int NT = 4096 / KVBLK;
  constexpr int SE = 0, SO = 0;
  __syncthreads();
  ATT_SLOAD(SE, 0); asm volatile("s_waitcnt vmcnt(0)" ::: "memory"); ATT_SWRITE(0, SE); __syncthreads();
  qkt(pA0, pA1, K_lds, qr, r32, hi); partialSM(pA0);
  ATT_SLOAD(SO, 1);
  ATT_SWAIT(); ATT_SWRITE(1, SO); __syncthreads();
  for (int j = 1; j + 1 < NT; j += 2) {
    ATT_SBAR(); qkt(pB0, pB1, K_lds + SHM_K, qr, r32, hi);
    finishSM(pA0, pA1, l_reg, pa0, pa1, pa2, pa3); ATT_SBAR();
    ATT_SLOAD(SO, j + 1); ATT_SBAR();
    pv_d0(o, vb0, pa0, pa1, pa2, pa3); partialSM(pB0);
    __syncthreads(); ATT_SWAIT(); ATT_SWRITE(0, SE);
    __syncthreads();
    ATT_SBAR(); qkt(pA0, pA1, K_lds, qr, r32, hi);
    finishSM(pB0, pB1, l_reg, pa0, pa1, pa2, pa3); ATT_SBAR();
    ATT_SLOAD(SE, j + 2); ATT_SBAR();
    pv_d0(o, vb0 + SHM_V, pa0, pa1, pa2, pa3); partialSM(pA0);
    __syncthreads(); ATT_SWAIT(); ATT_SWRITE(1, SO);
    __syncthreads();
  }
  ATT_SBAR(); qkt(pB0, pB1, K_lds + SHM_K, qr, r32, hi);
  finishSM(pA0, pA1, l_reg, pa0, pa1, pa2, pa3); ATT_SBAR();
  pv_d0(o, vb0, pa0, pa1, pa2, pa3); partialSM(pB0);
  finishSM(pB0, pB1, l_reg, pa0, pa1, pa2, pa3); ATT_SBAR();
  pv_d0(o, vb0 + SHM_V, pa0, pa1, pa2, pa3);
  { auto rr = __builtin_amdgcn_permlane32_swap(__float_as_uint(l_reg), __float_as_uint(l_reg), false, false); l_reg = __uint_as_float(rr[0]) + __uint_as_float(rr[1]); }
  if (hi == 0) wsf[r32] = l_reg; asm volatile("s_waitcnt lgkmcnt(0)" ::: "memory");
  float rli[16];
#pragma unroll
  for (int r = 0; r < 16; ++r) rli[r] = __builtin_amdgcn_rcpf(wsf[crow(r, hi)]);
  bf16_t* stg = (bf16_t*)(lds + LDS_OST) + wid * 4096;
#pragma unroll
  for (int r = 0; r < 16; ++r) { const int orow = crow(r, hi);
#pragma unroll
    for (int d0 = 0; d0 < 4; ++d0) stg[orow * 128 + d0 * 32 + r32] = f2bf(o[d0][r] * rli[r]); }
  asm volatile("s_waitcnt lgkmcnt(0)" ::: "memory");
  bf16_t* Ow = Ob + (size_t)(wid * QBLK) * 1024;
#pragma unroll
  for (int i = 0; i < 8; ++i) { const int row = i * 4 + (lane >> 4), ch = lane & 15; const u32x4 v = *(const u32x4*)(stg + row * 128 + ch * 8); *(u32x4*)(Ow + (size_t)row * 1024 + ch * 8) = v; }
#undef ATT_SLOAD
#undef ATT_SWRITE
#undef ATT_SWAIT
}
}
namespace lru {
using bf16x8 = __attribute__((ext_vector_type(8))) short;
using f32x16 = __attribute__((ext_vector_type(16))) float;
using u32x4  = __attribute__((ext_vector_type(4))) unsigned;
typedef float f32x4_t __attribute__((ext_vector_type(4)));
constexpr int T = 64, NCH = 4096 / T;
constexpr int LDS_XR = 0, LDS_H = 16384, LDS_END = LDS_H + 2 * T * 128 * 4;
#define LRU_XSWZ(row, c16) ((row) * 256 + ((((c16) ^ (row)) & 15) << 4))
__device__ __forceinline__ int crow(int r, int hi) { return (r & 3) + 8 * (r >> 2) + 4 * hi; }
__device__ __forceinline__ float fsig(float x) { return __builtin_amdgcn_rcpf(1.f + __expf(-x)); }

template <int DIR, bool APPLY>
__device__ __forceinline__ void scan(f32x16 (&a)[2], f32x16 (&u)[2], float cin, int hi, float& Ptot, float& Hend) {
  float P[2][4], H[2][4], Pp[2][4], Hp[2][4];
#pragma unroll
  for (int rt = 0; rt < 2; ++rt)
#pragma unroll
    for (int q = 0; q < 4; ++q) {
      float p = 1.f, h = 0.f;
#pragma unroll
      for (int ii = 0; ii < 4; ++ii) { const int r = 4 * q + (DIR ? 3 - ii : ii); h = a[rt][r] * h + u[rt][r]; p *= a[rt][r]; }
      P[rt][q] = p; H[rt][q] = h;
      Pp[rt][q] = __shfl_xor(p, 32); Hp[rt][q] = __shfl_xor(h, 32);
    }
  float c = cin, pt = 1.f; float myc[2][4];
  const bool first = (hi == (DIR ? 1 : 0));
#pragma unroll
  for (int gg = 0; gg < 8; ++gg) {
    const int rt = DIR ? 1 - (gg >> 2) : (gg >> 2), q = DIR ? 3 - (gg & 3) : (gg & 3);
    const float Pf = first ? P[rt][q] : Pp[rt][q], Hf = first ? H[rt][q] : Hp[rt][q];
    const float Ps = first ? Pp[rt][q] : P[rt][q], Hs = first ? Hp[rt][q] : H[rt][q];
    const float c0 = c; c = Pf * c + Hf; const float c1 = c; c = Ps * c + Hs; pt *= Pf * Ps;
    myc[rt][q] = first ? c0 : c1;
  }
  Ptot = pt; Hend = c;
  if (APPLY) {
#pragma unroll
    for (int rt = 0; rt < 2; ++rt)
#pragma unroll
      for (int q = 0; q < 4; ++q) {
        float h = myc[rt][q];
#pragma unroll
        for (int ii = 0; ii < 4; ++ii) { const int r = 4 * q + (DIR ? 3 - ii : ii); h = a[rt][r] * h + u[rt][r]; u[rt][r] = h; }
      }
  }
}

struct Params {
  const bf16_t* LRX; const bf16_t* LRG; const bf16_t* Wt; const float* conv_w; const float* conv_b;
  const float* ba; const float* bi; const float* lam; float* SUM; bf16_t* YL;
};

template <int PASS>
__device__ __forceinline__ void lru_phase(const Params& p, char* lds, int vcu, int G) {
  const int tid = threadIdx.x, wid = tid >> 6, lane = tid & 63, r32 = lane & 31, hi = lane >> 5;
  const int dir = wid >> 2, cq = wid & 3;
  const int blk = vcu & 7, idx = vcu >> 3, nper = (NB * NCH) / (G >> 3);
  const int e = cq * 32 + r32, ch = blk * 128 + e;
  bf16x8 wb[2][8];
#pragma unroll
  for (int g = 0; g < 2; ++g)
#pragma unroll
    for (int ks = 0; ks < 8; ++ks) wb[g][ks] = *reinterpret_cast<const bf16x8*>(p.Wt + ((size_t)((dir * 2 + g) * 8 + blk) * 128 + e) * 128 + ks * 16 + hi * 8);
  const float bav = p.ba[dir * 1024 + ch], biv = p.bi[dir * 1024 + ch];
  const float c8 = -8.f * log1pf(__expf(-p.lam[dir * 1024 + ch]));
  for (int i = 0; i < nper; ++i) {
    const int un = idx * nper + i, b = un / NCH, chunk = un % NCH, t0 = chunk * T;
    const size_t rowb = (size_t)b * 4096;
    __syncthreads();
#pragma unroll
    for (int pp = 0; pp < 2; ++pp) {
      const int pc = tid + pp * 512, t = pc >> 4, c8i = pc & 15, cc = blk * 128 + c8i * 8;
      float acc8[8];
      { const f32x4_t b0 = *(const f32x4_t*)(p.conv_b + cc), b1 = *(const f32x4_t*)(p.conv_b + cc + 4);
        acc8[0] = b0[0]; acc8[1] = b0[1]; acc8[2] = b0[2]; acc8[3] = b0[3]; acc8[4] = b1[0]; acc8[5] = b1[1]; acc8[6] = b1[2]; acc8[7] = b1[3]; }
#pragma unroll
      for (int j = 0; j < 4; ++j) {
        const int ta = t0 + t - 1 + j;
        if (ta >= 0 && ta < 4096) {
          const bf16x8 xv = *reinterpret_cast<const bf16x8*>(p.LRX + (rowb + ta) * 1024 + cc);
          const f32x4_t w0 = *(const f32x4_t*)(p.conv_w + j * 1024 + cc), w1 = *(const f32x4_t*)(p.conv_w + j * 1024 + cc + 4);
#pragma unroll
          for (int k = 0; k < 4; ++k) { acc8[k] += w0[k] * bf2f((bf16_t)xv[k]); acc8[4 + k] += w1[k] * bf2f((bf16_t)xv[4 + k]); }
        }
      }
      u32x4 w; w.x = pk2(acc8[0], acc8[1]); w.y = pk2(acc8[2], acc8[3]); w.z = pk2(acc8[4], acc8[5]); w.w = pk2(acc8[6], acc8[7]);
      *(u32x4*)(lds + LDS_XR + LRU_XSWZ(t, c8i)) = w;
    }
    __syncthreads();
    f32x16 aA[2], aI[2];
    aA[0] = f32x16{}; aA[1] = f32x16{}; aI[0] = f32x16{}; aI[1] = f32x16{};
#pragma unroll
    for (int ks = 0; ks < 8; ++ks) {
      const int c16 = ks * 2 + hi;
      const bf16x8 x0 = *reinterpret_cast<const bf16x8*>(lds + LDS_XR + LRU_XSWZ(r32, c16));
      const bf16x8 x1 = *reinterpret_cast<const bf16x8*>(lds + LDS_XR + LRU_XSWZ(32 + r32, c16));
      aA[0] = __builtin_amdgcn_mfma_f32_32x32x16_bf16(x0, wb[0][ks], aA[0], 0, 0, 0);
      aA[1] = __builtin_amdgcn_mfma_f32_32x32x16_bf16(x1, wb[0][ks], aA[1], 0, 0, 0);
      aI[0] = __builtin_amdgcn_mfma_f32_32x32x16_bf16(x0, wb[1][ks], aI[0], 0, 0, 0);
      aI[1] = __builtin_amdgcn_mfma_f32_32x32x16_bf16(x1, wb[1][ks], aI[1], 0, 0, 0);
    }
#pragma unroll
    for (int rt = 0; rt < 2; ++rt)
#pragma unroll
      for (int r = 0; r < 16; ++r) {
        const int t = 32 * rt + crow(r, hi);
        const float xv = bf2f(*(const bf16_t*)(lds + LDS_XR + LRU_XSWZ(t, e >> 3) + (e & 7) * 2));
        const float rg = fsig(aA[rt][r] + bav), ig = fsig(aI[rt][r] + biv);
        const float a = __expf(c8 * rg);
        aA[rt][r] = a; aI[rt][r] = __builtin_amdgcn_sqrtf(1.f - a * a) * ig * xv;
      }
    float Ptot, Hend;
    if (PASS == 1) {
      if (dir == 0) scan<0, false>(aA, aI, 0.f, hi, Ptot, Hend); else scan<1, false>(aA, aI, 0.f, hi, Ptot, Hend);
      if (hi == 0) { float* s = p.SUM + ((size_t)((b * NCH + chunk) * 2 + dir) * 1024 + ch) * 2; s[0] = Ptot; s[1] = Hend; }
    } else {
      float cin = 0.f;
      if (dir == 0) { for (int j = 0; j < chunk; ++j) { const float* s = p.SUM + ((size_t)((b * NCH + j) * 2 + 0) * 1024 + ch) * 2; cin = s[0] * cin + s[1]; } }
      else { for (int j = NCH - 1; j > chunk; --j) { const float* s = p.SUM + ((size_t)((b * NCH + j) * 2 + 1) * 1024 + ch) * 2; cin = s[0] * cin + s[1]; } }
      if (dir == 0) scan<0, true>(aA, aI, cin, hi, Ptot, Hend); else scan<1, true>(aA, aI, cin, hi, Ptot, Hend);
      float* Hs = (float*)(lds + LDS_H) + dir * (T * 128);
#pragma unroll
      for (int rt = 0; rt < 2; ++rt)
#pragma unroll
        for (int r = 0; r < 16; ++r) Hs[(32 * rt + crow(r, hi)) * 128 + e] = aI[rt][r];
      __syncthreads();
#pragma unroll
      for (int pp = 0; pp < 2; ++pp) {
        const int pc = tid + pp * 512, t = pc >> 4, c8i = pc & 15;
        const float* hf = (const float*)(lds + LDS_H) + t * 128 + c8i * 8; const float* hb = hf + T * 128;
        const f32x4_t f0 = *(const f32x4_t*)hf, f1 = *(const f32x4_t*)(hf + 4), b0 = *(const f32x4_t*)hb, b1 = *(const f32x4_t*)(hb + 4);
        const size_t gi = (rowb + t0 + t) * 1024 + blk * 128 + c8i * 8;
        const bf16x8 gv = *reinterpret_cast<const bf16x8*>(p.LRG + gi);
        u32x4 w;
        w.x = pk2((f0[0] + b0[0]) * bf2f((bf16_t)gv[0]), (f0[1] + b0[1]) * bf2f((bf16_t)gv[1]));
        w.y = pk2((f0[2] + b0[2]) * bf2f((bf16_t)gv[2]), (f0[3] + b0[3]) * bf2f((bf16_t)gv[3]));
        w.z = pk2((f1[0] + b1[0]) * bf2f((bf16_t)gv[4]), (f1[1] + b1[1]) * bf2f((bf16_t)gv[5]));
        w.w = pk2((f1[2] + b1[2]) * bf2f((bf16_t)gv[6]), (f1[3] + b1[3]) * bf2f((bf16_t)gv[7]));
        *(u32x4*)(p.YL + gi) = w;
      }
    }
  }
}
}
#define XB_TMO      128
#define XB_XCNT(j)  (256  + 64 * (j))
#define XB_XSUB(j)  (1280 + 64 * (j))
#define XB_XGEN(j)  (2304 + 64 * (j))
#define XB_TOP      3328
#define XB_TOPGEN   3392
#define XCD_BAR_WORDS 3456
#define XB_SPIN_CAP (1u << 18)

__device__ __forceinline__ unsigned xb_ld(unsigned* p)              { return __hip_atomic_load(p, __ATOMIC_RELAXED, __HIP_MEMORY_SCOPE_AGENT); }
__device__ __forceinline__ unsigned xb_add(unsigned* p, unsigned v) { return __hip_atomic_fetch_add(p, v, __ATOMIC_RELAXED, __HIP_MEMORY_SCOPE_AGENT); }
__device__ __forceinline__ unsigned xb_xcc_id() { return (unsigned)__builtin_amdgcn_s_getreg((3 << 11) | 20) & 0xFu; }
#define XB_SPIN(cond, bar) do { unsigned _sp = 0; while (cond) { __builtin_amdgcn_s_sleep(1); \
    if ((++_sp & 255u) == 0u) { if (xb_ld(&(bar)[XB_TMO])) break; if (_sp > XB_SPIN_CAP) { atomicAdd(&(bar)[XB_TMO], 1u); break; } } } } while (0)

struct XcdBarrier {
    unsigned* bar; unsigned x;
    volatile LAS unsigned* st;
};

__device__ __forceinline__ XcdBarrier xcd_barrier_post(unsigned* bar, volatile LAS unsigned* st) {
    XcdBarrier b; b.bar = bar; b.x = xb_xcc_id(); b.st = st;
    if (threadIdx.x == 0) (void)xb_add(&bar[XB_XCNT(b.x)], 1u);
    return b;
}
__device__ __forceinline__ void xcd_barrier_complete(unsigned* bar, unsigned x, unsigned& nloc, unsigned& nx) {
    const unsigned G = gridDim.x * gridDim.y * gridDim.z;
    unsigned sum, cnt, mine, sp = 0u;
    for (;;) {
        sum = 0u; cnt = 0u; mine = 0u;
#pragma unroll
        for (unsigned j = 0; j < 16; ++j) { const unsigned c = xb_ld(&bar[XB_XCNT(j)]); sum += c; cnt += (c > 0u) ? 1u : 0u; mine = (j == x) ? c : mine; }
        if (sum == G) break;
        __builtin_amdgcn_s_sleep(1);
        if ((++sp & 255u) == 0u) { if (xb_ld(&bar[XB_TMO])) break; if (sp > XB_SPIN_CAP) { atomicAdd(&bar[XB_TMO], 1u); break; } }
    }
    nloc = mine > 0u ? mine : 1u; nx = cnt > 0u ? cnt : 1u;
}

__device__ __forceinline__ void xcd_barrier(const XcdBarrier& b) {
    asm volatile("s_waitcnt vmcnt(0)" ::: "memory");
    __syncthreads();
    if (threadIdx.x == 0) {
        unsigned* bar = b.bar;
        __builtin_amdgcn_s_waitcnt(0);
        unsigned nloc = b.st[0], nx = b.st[1];
        if (nloc == 0u) { xcd_barrier_complete(bar, b.x, nloc, nx); b.st[0] = nloc; b.st[1] = nx; }
        const unsigned old = xb_add(&bar[XB_XSUB(b.x)], 1u);
        const unsigned gen = old / nloc;
        if (old + 1u == (gen + 1u) * nloc) {
            __builtin_amdgcn_fence(__ATOMIC_RELEASE, "agent");
            asm volatile("s_waitcnt vmcnt(0)" ::: "memory");
            const unsigned og = xb_add(&bar[XB_TOP], 1u);
            const unsigned tg = og / nx;
            if (og + 1u == (tg + 1u) * nx) xb_add(&bar[XB_TOPGEN], 1u);
            else XB_SPIN(xb_ld(&bar[XB_TOPGEN]) == tg, bar);
            __builtin_amdgcn_fence(__ATOMIC_ACQUIRE, "agent");
            xb_add(&bar[XB_XGEN(b.x)], 1u);
            asm volatile("s_waitcnt vmcnt(0)" ::: "memory");
        } else {
            XB_SPIN(xb_ld(&bar[XB_XGEN(b.x)]) == gen, bar);
            __builtin_amdgcn_fence(__ATOMIC_ACQUIRE, "agent");
            asm volatile("s_waitcnt vmcnt(0)" ::: "memory");
        }
    }
    __syncthreads();
}
struct MkArgs { const float* in[29]; float* out; unsigned char* ws; int ph_lo, ph_hi; };
struct Frame {
    LAS unsigned char* lds;
    volatile LAS unsigned* MISC;
    gu32* ctl;
    int tid, lane, wave;
    int vcu, G;
};

__device__ __forceinline__ void p0_transpose_item(const float* W, int K, int N, bf16_t* WT, LAS float* scr, int item, int lane, const float* kscale, int mode) {
    const int nblk = N / 32, kb = item / nblk, nb = item % nblk, k0 = 64 * kb, n0 = 32 * nb;
#pragma unroll 8
    for (int i = 0; i < 32; ++i) { const int kk = 2 * i + (lane >> 5); float w = W[(size_t)(k0 + kk) * N + n0 + (lane & 31)]; if (kscale) w *= kscale[k0 + kk]; scr[kk * 33 + (lane & 31)] = w; }
    LDS_WAIT(); asm volatile("" ::: "memory");
    const int r0 = (mode == 1 && n0 < 2048) ? ((n0 & ~255) + 128 * ((n0 >> 5) & 1) + 32 * ((n0 >> 6) & 3)) : (mode >= 2) ? (256 * (n0 >> 7) + 128 * (mode - 2) + (n0 & 127)) : n0;
    const int c = lane & 7;
#pragma unroll
    for (int j = 0; j < 4; ++j) { const int n = (lane >> 3) + 8 * j; const LAS float* s = scr + (8 * c) * 33 + n;
        v4u o; o.x = pk2(s[0 * 33], s[1 * 33]); o.y = pk2(s[2 * 33], s[3 * 33]); o.z = pk2(s[4 * 33], s[5 * 33]); o.w = pk2(s[6 * 33], s[7 * 33]);
        *(GAS v4u*)(WT + (size_t)(r0 + n) * K + k0 + 8 * c) = o; }
    LDS_WAIT(); asm volatile("" ::: "memory");
}
__device__ __forceinline__ void p0_row(const float* xrow, bf16_t* orow, float* rs, int lane) {
    const GAS f32x4* xr = (const GAS f32x4*)xrow + lane;
    f32x4 v[4]; float s = 0.f;
#pragma unroll
    for (int j = 0; j < 4; ++j) { v[j] = xr[64 * j]; s += (v[j].x * v[j].x + v[j].y * v[j].y) + (v[j].z * v[j].z + v[j].w * v[j].w); }
    s = wave_sum(s);
    if (lane == 0) *rs = rsqrtf(s * (1.f / 1024.f) + 1e-6f);
    GAS unsigned long long* o8 = (GAS unsigned long long*)orow + lane;
#pragma unroll
    for (int j = 0; j < 4; ++j) o8[64 * j] = (unsigned long long)pk2(v[j].x, v[j].y) | ((unsigned long long)pk2(v[j].z, v[j].w) << 32);
}

__global__ void __launch_bounds__(NWAVES * 64, 2) persist(MkArgs args) {
    extern __shared__ __attribute__((aligned(16))) unsigned char lds[];
    Frame F;
    F.lds = (LAS unsigned char*)lds;
    F.MISC = (volatile LAS unsigned*)(F.lds + MISC_OFF);
    F.tid = threadIdx.x; F.lane = F.tid & 63; F.wave = __builtin_amdgcn_readfirstlane(F.tid >> 6);
    F.G = gridDim.x; { const int bx = blockIdx.x; F.vcu = (F.G % 8 == 0) ? (bx % 8) * (F.G / 8) + bx / 8 : bx; }
    unsigned char* ws = args.ws;
    F.ctl = (gu32*)(ws + WS_CTL);
    for (int u = F.tid; u < (LDS_BYTES - LDSCTL_OFF) / 4; u += NWAVES * 64) ((LAS unsigned*)(F.lds + LDSCTL_OFF))[u] = 0u;
    __syncthreads();
    const int lo = args.ph_lo, hi = args.ph_hi;
    XcdBarrier bar; bar.bar = (unsigned*)(F.ctl + CW_BAR); bar.x = 0; bar.st = nullptr;
    if (hi - lo > 1) bar = xcd_barrier_post((unsigned*)(F.ctl + CW_BAR), F.MISC + 8);
#define IN(k) (lo <= (k) && (k) < hi)
#define BOTH(k) (IN(k) && IN((k) + 1))
#define GRID_BAR() xcd_barrier(bar)

    const float* x = args.in[0];
    bf16_t* XB = (bf16_t*)args.out;
    float* RS1 = (float*)(ws + WS_RS1); float* COST = (float*)(ws + WS_COS); float* SINT = (float*)(ws + WS_SIN);
    bf16_t* WINT = (bf16_t*)(ws + WS_WINT); bf16_t* WAT = (bf16_t*)(ws + WS_WAT); bf16_t* WLT = (bf16_t*)(ws + WS_WLT); bf16_t* WOT = (bf16_t*)(ws + WS_WOT);
    bf16_t* LRUW = (bf16_t*)(ws + WS_LRUW); float* LRUS = (float*)(ws + WS_LRUS);
    bf16_t* QP = (bf16_t*)(ws + WS_S0); bf16_t* KP = (bf16_t*)(ws + WS_S1); bf16_t* VB = (bf16_t*)(ws + WS_S2);
    bf16_t* LRX = (bf16_t*)(ws + WS_S3); bf16_t* LRG = (bf16_t*)(ws + WS_S4); bf16_t* GA = (bf16_t*)(ws + WS_S5); bf16_t* GL = (bf16_t*)(ws + WS_S6);

    if (IN(0)) {
        LAS float* scr = (LAS float*)(F.lds + RING_OFF + F.wave * 16384);
        const int gw = F.vcu * NWAVES + F.wave, NGW = F.G * NWAVES;
        constexpr int I_IN = (1024 / 64) * (PROJ / 32), I_SQ = (1024 / 64) * (1024 / 32);
        constexpr int I_LRU = 32 * 8;
        constexpr int NITEMS = I_IN + 3 * I_SQ + I_LRU;
        for (int it = gw; it < NITEMS; it += NGW) {
            int r = it;
            if (r < I_IN) { p0_transpose_item(args.in[2], 1024, PROJ, WINT, scr, r, F.lane, args.in[1], 1); continue; } r -= I_IN;
            if (r < I_SQ) { p0_transpose_item(args.in[11], 1024, 1024, WAT, scr, r, F.lane, nullptr, 0); continue; } r -= I_SQ;
            if (r < I_SQ) { p0_transpose_item(args.in[19], 1024, 1024, WLT, scr, r, F.lane, nullptr, 0); continue; } r -= I_SQ;
            if (r < I_SQ) { p0_transpose_item(args.in[20], 1024, 1024, WOT, scr, r, F.lane, nullptr, 0); continue; } r -= I_SQ;
            { const int mat = r >> 3, gate = mat >> 4, dirblk = mat & 15, dir = dirblk >> 3, blk = dirblk & 7;
              p0_transpose_item((gate ? args.in[16] : args.in[14]) + (size_t)dirblk * 16384, 128, 128, LRUW + (size_t)((dir * 2 + gate) * 8 + blk) * 16384, scr, r & 7, F.lane, nullptr, 0); }
        }
        for (int m = gw; m < NTOK; m += NGW) p0_row(x + (size_t)m * 1024, XB + (size_t)m * 1024, RS1 + m, F.lane);
        {
            for (int e = blockIdx.x * (NWAVES * 64) + F.tid; e < 4096 * 32; e += F.G * NWAVES * 64) {
                const int pos = e >> 5, i = e & 31;
                const float inv_freq = expf(-9.210340371976184f * (float)i * (1.f / 32.f));
                float sn, cs; sincosf((float)pos * inv_freq, &sn, &cs);
                COST[e] = cs; SINT[e] = sn;
            }
        }
        if (BOTH(0)) GRID_BAR();
    }
    if (IN(1)) {
        pg8::Gemm g{XB, WINT, NTOK, PROJ, 1024}; pg8::StaticOrder S; S.init(NTOK, PROJ, F.G, (int)blockIdx.x);
        pg8::EpiProj E{RS1, args.in[3], args.in[4], args.in[5], COST, SINT, QP, KP, VB, LRX, LRG, GA, GL};
        pg8::gemm_phase<pg8::EpiProj, pg8::StaticOrder, true, true>(F.lds + RING_OFF, g, S, E);
        if (BOTH(1)) GRID_BAR();
    }
    bf16_t* O1N = (bf16_t*)args.out; bf16_t* O2N = O1N + (size_t)NTOK * 1024;
    if (IN(2)) {
        const int per = 1024 / F.G;
        for (int i = 0; i < per; ++i) {
            const int unit = F.vcu * per + i;
            const int bhc = unit >> 4, qb = unit & 15, b = bhc >> 4, hc = bhc & 15, h = hc >> 1, c = hc & 1;
            att::attn_unit(QP + ((size_t)bhc * 4096 + qb * 256) * 64, KP + (size_t)bhc * 4096 * 64, VB + ((size_t)(b * 8 + h) * 4096) * 128,
                           (c ? O2N : O1N) + ((size_t)b * 4096 + qb * 256) * 1024 + h * 128, (char*)lds + RING_OFF);
        }
        { const lru::Params lp{LRX, LRG, LRUW, args.in[12], args.in[13], args.in[15], args.in[17], args.in[18], LRUS, nullptr};
          lru::lru_phase<1>(lp, (char*)lds + RING_OFF, F.vcu, F.G); }
        if (BOTH(2)) GRID_BAR();
    }
    bf16_t* ON = (bf16_t*)(ws + WS_S0); bf16_t* YL = (bf16_t*)(ws + WS_S1);
    if (IN(3)) {
        {
            const float s1 = wave_sum(args.in[6][F.lane] * args.in[7][F.lane]), s2 = wave_sum(args.in[8][F.lane] * args.in[9][F.lane]);
            const float lam = expf(s1) - expf(s2) + 0.2f;
            const float g0 = args.in[10][F.lane] * 0.8f, g1 = args.in[10][64 + F.lane] * 0.8f;
            const int gw = F.vcu * NWAVES + F.wave, NGW = F.G * NWAVES;
            for (int it = gw; it < NTOK * 8; it += NGW) {
                const size_t base = (size_t)it * 128;
                const float a0 = bf2f(O1N[base + F.lane]) - lam * bf2f(O2N[base + F.lane]);
                const float a1 = bf2f(O1N[base + 64 + F.lane]) - lam * bf2f(O2N[base + 64 + F.lane]);
                const float ss = wave_sum(a0 * a0 + a1 * a1);
                const float rs = rsqrtf(ss * (1.f / 128.f) + 1e-6f);
                ON[base + F.lane] = f2bf(a0 * rs * g0); ON[base + 64 + F.lane] = f2bf(a1 * rs * g1);
            }
        }
        { const lru::Params lp{LRX, LRG, LRUW, args.in[12], args.in[13], args.in[15], args.in[17], args.in[18], LRUS, YL};
          lru::lru_phase<2>(lp, (char*)lds + RING_OFF, F.vcu, F.G); }
        if (BOTH(3)) GRID_BAR();
    }
    bf16_t* MERGED = (bf16_t*)(ws + WS_S2);
    if (IN(4)) {
        { pg8::Gemm g{ON, WAT, NTOK, 1024, 1024}; pg8::StaticOrder S; S.init(NTOK, 1024, F.G, (int)blockIdx.x);
          pg8::EpiMerge<1> E{MERGED, GA};
          pg8::gemm_phase<pg8::EpiMerge<1>, pg8::StaticOrder, false, true>(F.lds + RING_OFF, g, S, E); }
        { pg8::Gemm g{YL, WLT, NTOK, 1024, 1024}; pg8::StaticOrder S; S.init(NTOK, 1024, F.G, (int)blockIdx.x);
          pg8::EpiMerge<2> E{MERGED, GL};
          pg8::gemm_phase<pg8::EpiMerge<2>, pg8::StaticOrder, false, true>(F.lds + RING_OFF, g, S, E); }
        if (BOTH(4)) GRID_BAR();
    }
    if (IN(5)) {
        pg8::Gemm g{MERGED, WOT, NTOK, 1024, 1024}; pg8::StaticOrder S; S.init(NTOK, 1024, F.G, (int)blockIdx.x);
        pg8::EpiResid E{x, args.out};
        pg8::gemm_phase<pg8::EpiResid, pg8::StaticOrder, false, true>(F.lds + RING_OFF, g, S, E);
        if (BOTH(5)) GRID_BAR();
    }
    bf16_t* H2 = (bf16_t*)(ws + WS_S0); bf16_t* HID = (bf16_t*)(ws + WS_S3);
    bf16_t* WGU = (bf16_t*)(ws + WS_S5); bf16_t* WDN = (bf16_t*)(ws + WS_S6 + 2 * MiB);
    bf16_t* Y0 = (bf16_t*)(ws + WS_S1); bf16_t* Y1 = (bf16_t*)(ws + WS_S2);
    int* LISTT = (int*)(ws + WS_LIST); float* LISTW = (float*)(ws + WS_LIST + 1 * MiB);
    gu32* GCNT = F.ctl + CW_CNT;
    LAS int* TB = (LAS int*)(F.lds + LDSCTL_OFF + 1024);
    if (IN(6)) {
        const float* x1 = args.out;
        const int tpc = NTOK / F.G, tpw = tpc / NWAVES;
        LAS int* LE = (LAS int*)(F.lds + RING_OFF + 12288); LAS float* LW = (LAS float*)(F.lds + RING_OFF + 12288 + 1024);
        LAS int* LRK = (LAS int*)(F.lds + RING_OFF + 12288 + 2048); LAS int* LCNT = (LAS int*)(F.lds + RING_OFF + 12288 + 3072); LAS int* LBASE = LCNT + 16;
        LAS float* WR = (LAS float*)(F.lds + RING_OFF + 16384);
        __syncthreads();
        if (F.tid < 32) LCNT[F.tid] = 0;
        const float* gain2 = args.in[21]; const float* wg = args.in[22]; const float* bg = args.in[23]; const float* wer = args.in[24]; const float* ber = args.in[25];
        for (int i = F.tid; i < 1024 * 5; i += NWAVES * 64) {
            const int d = i / 5, q = i % 5;
            const f32x4 w4 = (q == 0) ? *(const f32x4*)&wg[d * 4] : *(const f32x4*)&wer[d * 16 + (q - 1) * 4];
            *(LAS f32x4*)&WR[d * 20 + q * 4] = w4;
        }
        __syncthreads();
        for (int k = 0; k < tpw; ++k) {
            const int tl = F.wave * tpw + k; const size_t tok = (size_t)F.vcu * tpc + tl;
            const float* xr = x1 + tok * 1024 + F.lane; const float* gp = gain2 + F.lane; bf16_t* hp = H2 + tok * 1024 + F.lane;
            float v[16]; float ss = 0.f;
#pragma unroll
            for (int j = 0; j < 16; ++j) { v[j] = xr[j * 64]; ss += v[j] * v[j]; }
            ss = wave_sum(ss);
            const float rs = rsqrtf(ss * (1.f / 1024.f) + 1e-6f);
            float lg[20];
#pragma unroll
            for (int q = 0; q < 20; ++q) lg[q] = 0.f;
            const LAS float* wl = WR + F.lane * 20;
#pragma unroll
            for (int j = 0; j < 16; ++j) {
                const float hv = v[j] * rs * gp[j * 64];
                hp[j * 64] = f2bf(hv);
#pragma unroll
                for (int q = 0; q < 5; ++q) { const f32x4 w4 = *(const LAS f32x4*)&wl[j * 64 * 20 + q * 4]; lg[q * 4 + 0] += hv * w4.x; lg[q * 4 + 1] += hv * w4.y; lg[q * 4 + 2] += hv * w4.z; lg[q * 4 + 3] += hv * w4.w; }
            }
#pragma unroll
            for (int q = 0; q < 20; ++q) lg[q] = wave_sum(lg[q]);
            const float gl0 = lg[0] + bg[0], gl1 = lg[1] + bg[1], gl2 = lg[2] + bg[2], gl3 = lg[3] + bg[3];
            int gs = 0; float gm = gl0;
            if (gl1 > gm) { gm = gl1; gs = 1; } if (gl2 > gm) { gm = gl2; gs = 2; } if (gl3 > gm) { gm = gl3; gs = 3; }
            const float gw = 1.f / (expf(gl0 - gm) + expf(gl1 - gm) + expf(gl2 - gm) + expf(gl3 - gm));
            float el[4];
#pragma unroll
            for (int j = 0; j < 4; ++j) { const float s0 = lg[4 + j], s1 = lg[8 + j], s2 = lg[12 + j], s3 = lg[16 + j]; el[j] = (gs == 0 ? s0 : gs == 1 ? s1 : gs == 2 ? s2 : s3) + ber[gs * 4 + j]; }
            int i0 = 0; float v0 = el[0];
            if (el[1] > v0) { v0 = el[1]; i0 = 1; } if (el[2] > v0) { v0 = el[2]; i0 = 2; } if (el[3] > v0) { v0 = el[3]; i0 = 3; }
            int i1 = (i0 == 0) ? 1 : 0; float v1 = -3.0e38f;
#pragma unroll
            for (int j = 0; j < 4; ++j) { if (j != i0 && el[j] > v1) { v1 = el[j]; i1 = j; } }
            const float ex = expf(v1 - v0);
            if (F.lane == 0) { LE[tl * 2] = gs * 4 + i0; LE[tl * 2 + 1] = gs * 4 + i1; LW[tl * 2] = gw / (1.f + ex); LW[tl * 2 + 1] = gw * ex / (1.f + ex); }
        }
        __syncthreads();
        const int npair = tpc * 2;
        int me = 0;
        if (F.tid < npair) { me = LE[F.tid]; LRK[F.tid] = __hip_atomic_fetch_add(&LCNT[me], 1, __ATOMIC_RELAXED, __HIP_MEMORY_SCOPE_WORKGROUP); }
        __syncthreads();
        if (F.tid < 16) LBASE[F.tid] = (int)__hip_atomic_fetch_add(GCNT + F.tid, (unsigned)LCNT[F.tid], RLX_AGENT);
        __syncthreads();
        if (F.tid < npair) { const int pos = LBASE[me] + LRK[F.tid]; LISTT[me * 16384 + pos] = (F.vcu * tpc + (F.tid >> 1)) * 2 + (F.tid & 1); LISTW[me * 16384 + pos] = LW[F.tid]; }
        __syncthreads();
        {
            LAS float* scr = (LAS float*)(F.lds + RING_OFF + F.wave * 16384);
            const int gw_ = F.vcu * NWAVES + F.wave, NGW = F.G * NWAVES;
            constexpr int I_GU = (1024 / 64) * (512 / 32), I_DN = (512 / 64) * (1024 / 32);
            for (int it = gw_; it < 16 * (2 * I_GU + I_DN); it += NGW) {
                const int e = it / (2 * I_GU + I_DN); int r = it % (2 * I_GU + I_DN);
                if (r < 2 * I_GU) {
                    const int isup = r >= I_GU; if (isup) r -= I_GU;
                    p0_transpose_item((isup ? args.in[27] : args.in[26]) + (size_t)e * 1024 * 512, 1024, 512, WGU + (size_t)e * 1024 * 1024, scr, r, F.lane, nullptr, 2 + isup);
                } else {
                    p0_transpose_item(args.in[28] + (size_t)e * 512 * 1024, 512, 1024, WDN + (size_t)e * 1024 * 512, scr, r - 2 * I_GU, F.lane, nullptr, 0);
                }
            }
        }
        if (BOTH(6)) GRID_BAR();
    }
    if (IN(7) || IN(8)) {
        __syncthreads();
        if (F.tid < 16) TB[32 + F.tid] = (int)__hip_atomic_load(GCNT + F.tid, RLX_AGENT);
        __syncthreads();
        if (F.tid == 0) { int accn = 0; for (int e = 0; e < 16; ++e) { TB[e] = accn; accn += (TB[32 + e] + 255) >> 8; } TB[16] = accn; }
        __syncthreads();
    }
    if (IN(7)) {
        pg8::Gemm g{H2, WGU, 0, 1024, 1024}; pg8::GroupedOrder S{TB, LISTT, F.G, F.vcu, 4};
        pg8::EpiUp E{HID, LISTW};
        pg8::gemm_grouped<pg8::EpiUp, pg8::GroupedOrder, 0, true>(F.lds + RING_OFF, g, S, E);
        if (BOTH(7)) GRID_BAR();
    }
    if (IN(8)) {
        pg8::Gemm g{HID, WDN, 0, 1024, 512}; pg8::GroupedOrder S{TB, LISTT, F.G, F.vcu, 4};
        pg8::EpiDown E{Y0, (size_t)(Y1 - Y0), LISTT};
        pg8::gemm_grouped<pg8::EpiDown, pg8::GroupedOrder, 1, true>(F.lds + RING_OFF, g, S, E);
        if (BOTH(8)) GRID_BAR();
    }
    if (IN(9)) {
        typedef unsigned u32x2_t __attribute__((ext_vector_type(2)));
        f32x4* o4 = (f32x4*)args.out; const u32x2_t* a2 = (const u32x2_t*)Y0; const u32x2_t* b2 = (const u32x2_t*)Y1;
        for (size_t i = (size_t)blockIdx.x * (NWAVES * 64) + F.tid; i < (size_t)NTOK * 256; i += (size_t)F.G * NWAVES * 64) {
            f32x4 v = o4[i]; const u32x2_t a = a2[i], b = b2[i];
            v[0] += __uint_as_float(a.x << 16) + __uint_as_float(b.x << 16); v[1] += __uint_as_float(a.x & 0xffff0000u) + __uint_as_float(b.x & 0xffff0000u);
            v[2] += __uint_as_float(a.y << 16) + __uint_as_float(b.y << 16); v[3] += __uint_as_float(a.y & 0xffff0000u) + __uint_as_float(b.y & 0xffff0000u);
            o4[i] = v;
        }
    }
#undef IN
#undef BOTH
}
extern "C" void kernel_launch(void* const* d_in, const int* in_sizes, int n_in, void* d_out, int out_size, void* d_ws, size_t ws_size, hipStream_t stream) {
  const float* x = (const float*)d_in[0];
  const float* lq1 = (const float*)d_in[6];
  const float* lk1 = (const float*)d_in[7];
  const float* lq2 = (const float*)d_in[8];
  const float* lk2 = (const float*)d_in[9];
  const float* subln_gain = (const float*)d_in[10];
  const float* w_attn_o = (const float*)d_in[11];
  const float* conv_w = (const float*)d_in[12];
  const float* conv_b = (const float*)d_in[13];
  const float* lru_wa = (const float*)d_in[14];
  const float* lru_ba = (const float*)d_in[15];
  const float* lru_wi = (const float*)d_in[16];
  const float* lru_bi = (const float*)d_in[17];
  const float* lru_lambda = (const float*)d_in[18];
  const float* w_lru_o = (const float*)d_in[19];
  const float* w_out = (const float*)d_in[20];
  const float* norm2_gain = (const float*)d_in[21];
  const float* w_group = (const float*)d_in[22];
  const float* b_group = (const float*)d_in[23];
  const float* w_er = (const float*)d_in[24];
  const float* b_er = (const float*)d_in[25];
  const float* w_eg = (const float*)d_in[26];
  const float* w_eu = (const float*)d_in[27];
  const float* w_ed = (const float*)d_in[28];
  static int once = 0;
  if (!once) {
    once = 1;
    if (ws_size < 8 * SLOT || n_in != 29) fprintf(stderr, "kernel_launch: unexpected ws %zu n_in %d\n", ws_size, n_in);
    (void)hipFuncSetAttribute((const void*)nv::nlru, hipFuncAttributeMaxDynamicSharedMemorySize, (2 * 128 * 128 + 256) * 4);
    (void)hipFuncSetAttribute((const void*)persist, hipFuncAttributeMaxDynamicSharedMemorySize, LDS_BYTES);
  }
  char* ws = (char*)d_ws; char* dout = (char*)d_out;
  bf16_t* qb = (bf16_t*)(ws + WS_S0); bf16_t* kb = (bf16_t*)(ws + WS_S1); bf16_t* vb = (bf16_t*)(ws + WS_S2);
  bf16_t* lrx = (bf16_t*)(ws + WS_S3); bf16_t* lrg = (bf16_t*)(ws + WS_S4); bf16_t* ga = (bf16_t*)(ws + WS_S5); bf16_t* gl = (bf16_t*)(ws + WS_S6);
  float* sc = (float*)(ws + WS_S7 + 1 * MiB - 256);
  int* sel_e = (int*)(ws + WS_SEL_E); float* sel_w = (float*)(ws + WS_SEL_W);

  (void)hipMemsetAsync(ws + WS_CTL, 0, CTL_ZERO_BYTES, stream);
  MkArgs a{};
  for (int i = 0; i < 29; ++i) a.in[i] = (const float*)d_in[i];
  a.out = (float*)d_out; a.ws = (unsigned char*)d_ws;
  const int GRID = 256;
  a.ph_lo = 0; a.ph_hi = 10; hipLaunchKernelGGL(persist, dim3(GRID), dim3(NWAVES * 64), LDS_BYTES, stream, a);
}
```

```cpp
#include <hip/hip_runtime.h>
#include <cstdint>
#include <cstdio>

typedef unsigned short bf16_t;
__device__ __forceinline__ float bf2f(bf16_t v) { return __uint_as_float(((unsigned)v) << 16); }
__device__ __forceinline__ bf16_t f2bf(float f) { unsigned u = __float_as_uint(f); return (bf16_t)((u + 0x7fffu + ((u >> 16) & 1u)) >> 16); }
__device__ __forceinline__ float toF(float v) { return v; }
__device__ __forceinline__ float toF(bf16_t v) { return bf2f(v); }

constexpr int NTOK = 16384, DM = 1024, SEQ = 4096, NB = 4, PROJ = 7168;
constexpr size_t MiB = 1u << 20;
constexpr size_t SLOT = 32 * MiB;
constexpr size_t WS_S0 = 0, WS_S1 = SLOT, WS_S2 = 2 * SLOT, WS_S3 = 3 * SLOT, WS_S4 = 4 * SLOT, WS_S5 = 5 * SLOT, WS_S6 = 6 * SLOT, WS_S7 = 7 * SLOT;

__device__ __forceinline__ float wave_sum(float v) {
#pragma unroll
  for (int o = 1; o < 64; o <<= 1) v += __shfl_xor(v, o);
  return v;
}
__device__ __forceinline__ float sigmoidf_(float x) { return 1.f / (1.f + __expf(-x)); }
__device__ __forceinline__ float gelu_tanh(float x) {
  const float k0 = 0.7978845608028654f, k1 = 0.044715f;
  float t = k0 * (x + k1 * x * x * x);
  return 0.5f * x * (1.f + tanhf(t));
}

#ifndef PROBE_PHASE
#define PROBE_PHASE -1
#endif
#define REPEAT(k) for (int _rep = 0; _rep < ((PROBE_PHASE == (k)) ? 2 : 1); ++_rep)
namespace pg8 {
#define PG8_LAS __attribute__((address_space(3)))
typedef unsigned short bf16_t;
typedef short bf16x8 __attribute__((ext_vector_type(8)));
typedef float f32x4 __attribute__((ext_vector_type(4)));
typedef unsigned u32x4 __attribute__((ext_vector_type(4)));
constexpr int BM = 256, BK = 64, HALF = 128, HTB = HALF * BK * 2  , STAGE_BYTES = 8 * HTB, NXCD = 8, WGM = 8;

__host__ __device__ __forceinline__ int lds_byte(int r, int c) { const int st = (r >> 4) * 2 + (c >> 5), rr = r & 15, cc = c & 31, ob = rr * 64 + cc * 2; return st * 1024 + (ob ^ (((ob >> 9) & 1) << 5)); }
__host__ __device__ __forceinline__ void stage_rc(int b, int& R, int& C) { const int st = b / 1024, sb = b % 1024, swz = sb ^ (((sb >> 9) & 1) << 5); R = (st >> 1) * 16 + swz / 64; C = (st & 1) * 32 + (swz % 64) / 2; }
__host__ __device__ __forceinline__ int perm32(int rho) { const int n = rho >> 4, i = rho & 15; return 8 * (i >> 2) + 4 * n + (i & 3); }

struct Unit { int pm, pn; };
struct GUnit { int pm, pn, e, pos0, cnt; };
struct Gemm { const bf16_t* A; const bf16_t* Bt; int M, N, K; };

struct StaticOrder {
    int nM, nN, nwg, G, c;
    __host__ __device__ void init(int M, int N, int G_, int c_) { nM = M / BM; nN = N / BM; nwg = nM * nN; G = G_; c = c_; }
    __host__ __device__ bool next(int i, Unit& u) const {
        const long L = (long)i * G + c; if (L >= nwg) return false;
        int wgid = (int)L; { const int q = nwg / NXCD, r = nwg % NXCD, xcd = wgid % NXCD, off = wgid / NXCD; wgid = (xcd < r ? xcd * (q + 1) : r * (q + 1) + (xcd - r) * q) + off; }
        const int nig = WGM * nN, gid = wgid / nig, fm = gid * WGM, gsz = (nM - fm) < WGM ? (nM - fm) : WGM;
        u.pm = fm + ((wgid % nig) % gsz); u.pn = (wgid % nig) / gsz; return true;
    }
    __device__ __forceinline__ void a_ready(const Unit&) const {}
    __device__ __forceinline__ void done(const Unit&) const {}
};

__device__ __forceinline__ unsigned cvt_pk_bf16(float lo, float hi) { unsigned r; asm volatile("v_cvt_pk_bf16_f32 %0, %1, %2" : "=v"(r) : "v"(lo), "v"(hi)); return r; }
typedef float f32x2 __attribute__((ext_vector_type(2)));
template <class Epi, class Sched, bool ALIGN_EPI = false, bool SP2 = false>
__device__ __forceinline__ void gemm_phase(PG8_LAS unsigned char* lds, const Gemm g, const Sched& S, const Epi& E) {
    const int tid = threadIdx.x, wid = __builtin_amdgcn_readfirstlane(tid >> 6), lane = tid & 63, wr = wid >> 2, wc = wid & 3, fr = lane & 15, fq = lane >> 4;
    const int K = g.K, nt = K / BK;
    unsigned voffA[2], voffB[2];
#pragma unroll
    for (int i = 0; i < 2; ++i) { int R, C; stage_rc(tid * 16 + i * 8192, R, C); const int Rb = Epi::PERM ? ((R & ~31) + perm32(R & 31)) : R;
        voffA[i] = (unsigned)(R * K + C) * 2u; voffB[i] = (unsigned)(Rb * K + C) * 2u; }
    const size_t kstep = (size_t)(BK * 2);
    const size_t hstep = (size_t)HALF * K * 2;
    const size_t tstep = 2 * hstep;
    const unsigned ldsw = (unsigned)wid * 1024u;
    const int aoff = lds_byte(wr * 64 + fr, fq * 8), boff = lds_byte(wc * 32 + fr, fq * 8);
#define PG8_SA(b, h) (((b) * 2 + (h)) * HTB)
#define PG8_SB(b, h) ((4 + (b) * 2 + (h)) * HTB)
#define PG8_STAGE(bufoff, gbase, voff) do { _Pragma("unroll") for (int _i = 0; _i < 2; ++_i) \
        __builtin_amdgcn_global_load_lds((const unsigned*)((const char*)(gbase) + (voff)[_i]), (PG8_LAS unsigned*)(lds + (bufoff) + ldsw + _i * 8192), 16, 0, 0); } while (0)
#define PG8_LDA(dst, b, h) do { _Pragma("unroll") for (int m = 0; m < 4; ++m) _Pragma("unroll") for (int k = 0; k < 2; ++k) dst[m][k] = *(const PG8_LAS bf16x8*)(lds + PG8_SA(b, h) + aoff + m * 2048 + k * 1024); } while (0)
#define PG8_LDB(dst, b, h) do { _Pragma("unroll") for (int n = 0; n < 2; ++n) _Pragma("unroll") for (int k = 0; k < 2; ++k) dst[n][k] = *(const PG8_LAS bf16x8*)(lds + PG8_SB(b, h) + boff + n * 2048 + k * 1024); } while (0)
#define PG8_MMA(ai, bj, At, Bt) do { __builtin_amdgcn_s_setprio(1); _Pragma("unroll") for (int m = 0; m < 4; ++m) _Pragma("unroll") for (int n = 0; n < 2; ++n) _Pragma("unroll") for (int k = 0; k < 2; ++k) \
        acc[ai][bj][m][n] = __builtin_amdgcn_mfma_f32_16x16x32_bf16(Bt[n][k], At[m][k], acc[ai][bj][m][n], 0, 0, 0); __builtin_amdgcn_s_setprio(0); } while (0)
#define PG8_WAIT_V(n) asm volatile("s_waitcnt vmcnt(" #n ")" ::: "memory")
#define PG8_WAIT_L(n) asm volatile("s_waitcnt lgkmcnt(" #n ")" ::: "memory")
#define PG8_BAR __builtin_amdgcn_s_barrier()
#define PG8_SCHED __builtin_amdgcn_sched_barrier(0)
    Unit cur, nxt; int ui = 0;
    if (!S.next(0, cur)) return;
    f32x4 acc[2][2][4][2];
#pragma unroll
    for (int a = 0; a < 2; ++a)
#pragma unroll
        for (int b = 0; b < 2; ++b)
#pragma unroll
            for (int m = 0; m < 4; ++m)
#pragma unroll
                for (int n = 0; n < 2; ++n) acc[a][b][m][n] = (f32x4){0.f, 0.f, 0.f, 0.f};
    bf16x8 At[4][2], B0[2][2], B1[2][2];
    const char* cA = (const char*)g.A + (size_t)cur.pm * tstep; const char* cB = (const char*)g.Bt + (size_t)cur.pn * tstep;
    S.a_ready(cur);
    if constexpr (SP2) {
        PG8_STAGE(PG8_SB(0, 0), cB, voffB); PG8_STAGE(PG8_SB(0, 1), cB + hstep, voffB); PG8_STAGE(PG8_SA(0, 0), cA, voffA); PG8_STAGE(PG8_SA(0, 1), cA + hstep, voffA);
        if (wr == 1) PG8_BAR;
        PG8_WAIT_V(2); PG8_BAR;
        PG8_STAGE(PG8_SB(1, 0), cB + kstep, voffB); PG8_STAGE(PG8_SA(1, 0), cA + kstep, voffA); PG8_STAGE(PG8_SB(1, 1), cB + hstep + kstep, voffB);
        PG8_WAIT_V(6); PG8_BAR;
    } else {
        PG8_STAGE(PG8_SB(0, 0), cB, voffB); PG8_STAGE(PG8_SA(0, 0), cA, voffA); PG8_STAGE(PG8_SB(0, 1), cB + hstep, voffB); PG8_STAGE(PG8_SA(0, 1), cA + hstep, voffA);
        if (wr == 1) PG8_BAR;
        PG8_WAIT_V(4); PG8_BAR;
        PG8_STAGE(PG8_SB(1, 0), cB + kstep, voffB); PG8_STAGE(PG8_SA(1, 0), cA + kstep, voffA); PG8_STAGE(PG8_SB(1, 1), cB + hstep + kstep, voffB);
        PG8_WAIT_V(6); PG8_BAR;
    }
    for (;;) {
        const bool has_next = S.next(ui + 1, nxt);
        const char* nA = has_next ? (const char*)g.A + (size_t)nxt.pm * tstep : cA; const char* nB = has_next ? (const char*)g.Bt + (size_t)nxt.pn * tstep : cB;
        for (int t = 0; t < nt; t += 2) {
            const bool last = (t == nt - 2);
            const char* a1 = cA + (size_t)(t + 1) * kstep;
            const char* a2 = last ? nA : cA + (size_t)(t + 2) * kstep; const char* b2 = last ? nB : cB + (size_t)(t + 2) * kstep;
            const char* a3 = a2 + kstep; const char* b3 = b2 + kstep;
            if (last && has_next) S.a_ready(nxt);
            if constexpr (SP2) {
            PG8_LDB(B0, 0, 0); PG8_LDB(B1, 0, 1); PG8_SCHED; PG8_LDA(At, 0, 0); PG8_STAGE(PG8_SA(1, 1), a1 + hstep, voffA);
            PG8_WAIT_V(8); PG8_WAIT_L(0); PG8_BAR; PG8_MMA(0, 0, At, B0); PG8_MMA(0, 1, At, B1); PG8_BAR; PG8_SCHED;
            PG8_LDA(At, 0, 1); PG8_STAGE(PG8_SB(0, 0), b2, voffB); PG8_STAGE(PG8_SB(0, 1), b2 + hstep, voffB); PG8_STAGE(PG8_SA(0, 0), a2, voffA);
            PG8_WAIT_V(8); PG8_WAIT_L(0); PG8_BAR; PG8_MMA(1, 0, At, B0); PG8_MMA(1, 1, At, B1); PG8_BAR; PG8_SCHED;
            PG8_LDB(B0, 1, 0); PG8_LDB(B1, 1, 1); PG8_SCHED; PG8_LDA(At, 1, 0); PG8_STAGE(PG8_SA(0, 1), a2 + hstep, voffA);
            PG8_WAIT_V(8); PG8_WAIT_L(0); PG8_BAR; PG8_MMA(0, 0, At, B0); PG8_MMA(0, 1, At, B1); PG8_BAR; PG8_SCHED;
            PG8_LDA(At, 1, 1); PG8_STAGE(PG8_SB(1, 0), b3, voffB); PG8_STAGE(PG8_SB(1, 1), b3 + hstep, voffB); PG8_STAGE(PG8_SA(1, 0), a3, voffA);
            PG8_WAIT_V(8); PG8_WAIT_L(0); PG8_BAR; PG8_MMA(1, 0, At, B0); PG8_MMA(1, 1, At, B1); PG8_BAR; PG8_SCHED;
            } else {
            PG8_LDB(B0, 0, 0); PG8_SCHED; PG8_LDA(At, 0, 0); PG8_STAGE(PG8_SA(1, 1), a1 + hstep, voffA);
            PG8_WAIT_L(8); PG8_BAR; PG8_WAIT_L(0); PG8_MMA(0, 0, At, B0); PG8_BAR; PG8_SCHED;
            PG8_LDB(B1, 0, 1); PG8_STAGE(PG8_SB(0, 0), b2, voffB);
            PG8_BAR; PG8_WAIT_L(0); PG8_MMA(0, 1, At, B1); PG8_BAR;
            PG8_LDA(At, 0, 1); PG8_STAGE(PG8_SA(0, 0), a2, voffA);
            PG8_BAR; PG8_WAIT_L(0); PG8_MMA(1, 0, At, B0); PG8_BAR; PG8_SCHED;
            PG8_STAGE(PG8_SB(0, 1), b2 + hstep, voffB);
            PG8_WAIT_V(6); PG8_BAR; PG8_MMA(1, 1, At, B1); PG8_BAR;
            PG8_LDB(B0, 1, 0); PG8_SCHED; PG8_LDA(At, 1, 0); PG8_STAGE(PG8_SA(0, 1), a2 + hstep, voffA);
            PG8_WAIT_L(8); PG8_BAR; PG8_WAIT_L(0); PG8_MMA(0, 0, At, B0); PG8_BAR; PG8_SCHED;
            PG8_LDB(B1, 1, 1); PG8_STAGE(PG8_SB(1, 0), b3, voffB);
            PG8_BAR; PG8_WAIT_L(0); PG8_MMA(0, 1, At, B1); PG8_BAR;
            PG8_LDA(At, 1, 1); PG8_STAGE(PG8_SA(1, 0), a3, voffA);
            PG8_BAR; PG8_WAIT_L(0); PG8_MMA(1, 0, At, B0); PG8_BAR; PG8_SCHED;
            PG8_STAGE(PG8_SB(1, 1), b3 + hstep, voffB);
            PG8_WAIT_V(6); PG8_BAR; PG8_MMA(1, 1, At, B1); PG8_BAR;
            }
        }
        if constexpr (ALIGN_EPI) { if (wr == 0) PG8_BAR; }
        if constexpr (!Epi::AFTER_DRAIN) { E(acc, cur, wr, wc, fr, fq); S.done(cur); }
        if (!has_next) break;
#pragma unroll
        for (int a = 0; a < 2; ++a)
#pragma unroll
            for (int b = 0; b < 2; ++b)
#pragma unroll
                for (int m = 0; m < 4; ++m)
#pragma unroll
                    for (int n = 0; n < 2; ++n) acc[a][b][m][n] = (f32x4){0.f, 0.f, 0.f, 0.f};
        cur = nxt; cA = nA; cB = nB; ++ui;
        if constexpr (ALIGN_EPI) { if (wr == 1) PG8_BAR; }
    }
    PG8_WAIT_V(0);
    if constexpr (!ALIGN_EPI) { if (wr == 0) PG8_BAR; }
    PG8_BAR;
    if constexpr (Epi::AFTER_DRAIN) { E.fused(acc, cur, wr, wc, fr, fq, lds, wid, lane); S.done(cur); }
#undef PG8_SA
#undef PG8_SB
#undef PG8_STAGE
#undef PG8_LDA
#undef PG8_LDB
#undef PG8_MMA
#undef PG8_WAIT_V
#undef PG8_WAIT_L
#undef PG8_BAR
#undef PG8_SCHED
}
}
namespace pg8 {
template <class Epi, class Sched, int MODE, bool ALIGN_EPI = true>
__device__ __forceinline__ void gemm_grouped(PG8_LAS unsigned char* lds, const Gemm g, const Sched& S, const Epi& E) {
    constexpr bool SP2 = true;
    const int tid = threadIdx.x, wid = __builtin_amdgcn_readfirstlane(tid >> 6), lane = tid & 63, wr = wid >> 2, wc = wid & 3, fr = lane & 15, fq = lane >> 4;
    const int K = g.K, nt = K / BK;
    unsigned voffA[2], voffB[2];
#pragma unroll
    for (int i = 0; i < 2; ++i) { int R, C; stage_rc(tid * 16 + i * 8192, R, C); const int Rb = Epi::PERM ? ((R & ~31) + perm32(R & 31)) : R;
        voffA[i] = (unsigned)(R * K + C) * 2u; voffB[i] = (unsigned)(Rb * K + C) * 2u; }
    const size_t kstep = (size_t)(BK * 2);
    const size_t hstep = (size_t)HALF * K * 2;
    const size_t tstep = 2 * hstep;
    const unsigned ldsw = (unsigned)wid * 1024u;
    const int aoff = lds_byte(wr * 64 + fr, fq * 8), boff = lds_byte(wc * 32 + fr, fq * 8);
#define PG8_SA(b, h) (((b) * 2 + (h)) * HTB)
#define PG8_SB(b, h) ((4 + (b) * 2 + (h)) * HTB)
#define PG8_STAGE(bufoff, gbase, voff) do { _Pragma("unroll") for (int _i = 0; _i < 2; ++_i) \
        __builtin_amdgcn_global_load_lds((const unsigned*)((const char*)(gbase) + (voff)[_i]), (PG8_LAS unsigned*)(lds + (bufoff) + ldsw + _i * 8192), 16, 0, 0); } while (0)
#define PG8_STAGE_A(bufoff, kptr, h, nx) do { if (MODE == 0) { unsigned _v[2]; _v[0] = (nx) ? nvA[h][0] : cvA[h][0]; _v[1] = (nx) ? nvA[h][1] : cvA[h][1]; PG8_STAGE(bufoff, kptr, _v); } else { PG8_STAGE(bufoff, (kptr) + (h) * hstep, voffA); } } while (0)
#define PG8_LDA(dst, b, h) do { _Pragma("unroll") for (int m = 0; m < 4; ++m) _Pragma("unroll") for (int k = 0; k < 2; ++k) dst[m][k] = *(const PG8_LAS bf16x8*)(lds + PG8_SA(b, h) + aoff + m * 2048 + k * 1024); } while (0)
#define PG8_LDB(dst, b, h) do { _Pragma("unroll") for (int n = 0; n < 2; ++n) _Pragma("unroll") for (int k = 0; k < 2; ++k) dst[n][k] = *(const PG8_LAS bf16x8*)(lds + PG8_SB(b, h) + boff + n * 2048 + k * 1024); } while (0)
#define PG8_MMA(ai, bj, At, Bt) do { __builtin_amdgcn_s_setprio(1); _Pragma("unroll") for (int m = 0; m < 4; ++m) _Pragma("unroll") for (int n = 0; n < 2; ++n) _Pragma("unroll") for (int k = 0; k < 2; ++k) \
        acc[ai][bj][m][n] = __builtin_amdgcn_mfma_f32_16x16x32_bf16(Bt[n][k], At[m][k], acc[ai][bj][m][n], 0, 0, 0); __builtin_amdgcn_s_setprio(0); } while (0)
#define PG8_WAIT_V(n) asm volatile("s_waitcnt vmcnt(" #n ")" ::: "memory")
#define PG8_WAIT_L(n) asm volatile("s_waitcnt lgkmcnt(" #n ")" ::: "memory")
#define PG8_BAR __builtin_amdgcn_s_barrier()
#define PG8_SCHED __builtin_amdgcn_sched_barrier(0)
    GUnit cur, nxt; int ui = 0;
    if (!S.next(0, cur)) return;
    unsigned cvA[2][2], nvA[2][2];
    if (MODE == 0) S.rows(cur, voffA, cvA);
    f32x4 acc[2][2][4][2];
#pragma unroll
    for (int a = 0; a < 2; ++a)
#pragma unroll
        for (int b = 0; b < 2; ++b)
#pragma unroll
            for (int m = 0; m < 4; ++m)
#pragma unroll
                for (int n = 0; n < 2; ++n) acc[a][b][m][n] = (f32x4){0.f, 0.f, 0.f, 0.f};
    bf16x8 At[4][2], B0[2][2], B1[2][2];
    const size_t estep = (size_t)g.N * K * 2;
    const char* cA = (const char*)g.A + (MODE == 0 ? (size_t)0 : (size_t)cur.pm * tstep); const char* cB = (const char*)g.Bt + (size_t)cur.e * estep + (size_t)cur.pn * tstep;
    S.a_ready(cur);
    if constexpr (SP2) {
        PG8_STAGE(PG8_SB(0, 0), cB, voffB); PG8_STAGE(PG8_SB(0, 1), cB + hstep, voffB); PG8_STAGE_A(PG8_SA(0, 0), cA, 0, false); PG8_STAGE_A(PG8_SA(0, 1), cA, 1, false);
        if (wr == 1) PG8_BAR;
        PG8_WAIT_V(2); PG8_BAR;
        PG8_STAGE(PG8_SB(1, 0), cB + kstep, voffB); PG8_STAGE_A(PG8_SA(1, 0), cA + kstep, 0, false); PG8_STAGE(PG8_SB(1, 1), cB + hstep + kstep, voffB);
        PG8_WAIT_V(6); PG8_BAR;
    } else {
        PG8_STAGE(PG8_SB(0, 0), cB, voffB); PG8_STAGE(PG8_SA(0, 0), cA, voffA); PG8_STAGE(PG8_SB(0, 1), cB + hstep, voffB); PG8_STAGE(PG8_SA(0, 1), cA + hstep, voffA);
        if (wr == 1) PG8_BAR;
        PG8_WAIT_V(4); PG8_BAR;
        PG8_STAGE(PG8_SB(1, 0), cB + kstep, voffB); PG8_STAGE_A(PG8_SA(1, 0), cA + kstep, 0, false); PG8_STAGE(PG8_SB(1, 1), cB + hstep + kstep, voffB);
        PG8_WAIT_V(6); PG8_BAR;
    }
    for (;;) {
        const bool has_next = S.next(ui + 1, nxt);
        const char* nA = (MODE == 0) ? cA : (has_next ? (const char*)g.A + (size_t)nxt.pm * tstep : cA); const char* nB = has_next ? (const char*)g.Bt + (size_t)nxt.e * estep + (size_t)nxt.pn * tstep : cB;
        if (MODE == 0) { if (has_next) S.rows(nxt, voffA, nvA); else { nvA[0][0] = cvA[0][0]; nvA[0][1] = cvA[0][1]; nvA[1][0] = cvA[1][0]; nvA[1][1] = cvA[1][1]; } }
        for (int t = 0; t < nt; t += 2) {
            const bool last = (t == nt - 2);
            const char* a1 = cA + (size_t)(t + 1) * kstep;
            const char* a2 = last ? nA : cA + (size_t)(t + 2) * kstep; const char* b2 = last ? nB : cB + (size_t)(t + 2) * kstep;
            const char* a3 = a2 + kstep; const char* b3 = b2 + kstep;
            if (last && has_next) S.a_ready(nxt);
            if constexpr (SP2) {
            PG8_LDB(B0, 0, 0); PG8_LDB(B1, 0, 1); PG8_SCHED; PG8_LDA(At, 0, 0); PG8_STAGE_A(PG8_SA(1, 1), a1, 1, false);
            PG8_WAIT_V(8); PG8_WAIT_L(0); PG8_BAR; PG8_MMA(0, 0, At, B0); PG8_MMA(0, 1, At, B1); PG8_BAR; PG8_SCHED;
            PG8_LDA(At, 0, 1); PG8_STAGE(PG8_SB(0, 0), b2, voffB); PG8_STAGE(PG8_SB(0, 1), b2 + hstep, voffB); PG8_STAGE_A(PG8_SA(0, 0), a2, 0, last);
            PG8_WAIT_V(8); PG8_WAIT_L(0); PG8_BAR; PG8_MMA(1, 0, At, B0); PG8_MMA(1, 1, At, B1); PG8_BAR; PG8_SCHED;
            PG8_LDB(B0, 1, 0); PG8_LDB(B1, 1, 1); PG8_SCHED; PG8_LDA(At, 1, 0); PG8_STAGE_A(PG8_SA(0, 1), a2, 1, last);
            PG8_WAIT_V(8); PG8_WAIT_L(0); PG8_BAR; PG8_MMA(0, 0, At, B0); PG8_MMA(0, 1, At, B1); PG8_BAR; PG8_SCHED;
            PG8_LDA(At, 1, 1); PG8_STAGE(PG8_SB(1, 0), b3, voffB); PG8_STAGE(PG8_SB(1, 1), b3 + hstep, voffB); PG8_STAGE_A(PG8_SA(1, 0), a3, 0, last);
            PG8_WAIT_V(8); PG8_WAIT_L(0); PG8_BAR; PG8_MMA(1, 0, At, B0); PG8_MMA(1, 1, At, B1); PG8_BAR; PG8_SCHED;
            } else {
            PG8_LDB(B0, 0, 0); PG8_SCHED; PG8_LDA(At, 0, 0); PG8_STAGE_A(PG8_SA(1, 1), a1, 1, false);
            PG8_WAIT_L(8); PG8_BAR; PG8_WAIT_L(0); PG8_MMA(0, 0, At, B0); PG8_BAR; PG8_SCHED;
            PG8_LDB(B1, 0, 1); PG8_STAGE(PG8_SB(0, 0), b2, voffB);
            PG8_BAR; PG8_WAIT_L(0); PG8_MMA(0, 1, At, B1); PG8_BAR;
            PG8_LDA(At, 0, 1); PG8_STAGE_A(PG8_SA(0, 0), a2, 0, last);
            PG8_BAR; PG8_WAIT_L(0); PG8_MMA(1, 0, At, B0); PG8_BAR; PG8_SCHED;
            PG8_STAGE(PG8_SB(0, 1), b2 + hstep, voffB);
            PG8_WAIT_V(6); PG8_BAR; PG8_MMA(1, 1, At, B1); PG8_BAR;
            PG8_LDB(B0, 1, 0); PG8_SCHED; PG8_LDA(At, 1, 0); PG8_STAGE_A(PG8_SA(0, 1), a2, 1, last);
            PG8_WAIT_L(8); PG8_BAR; PG8_WAIT_L(0); PG8_MMA(0, 0, At, B0); PG8_BAR; PG8_SCHED;
            PG8_LDB(B1, 1, 1); PG8_STAGE(PG8_SB(1, 0), b3, voffB);
            PG8_BAR; PG8_WAIT_L(0); PG8_MMA(0, 1, At, B1); PG8_BAR;
            PG8_LDA(At, 1, 1); PG8_STAGE_A(PG8_SA(1, 0), a3, 0, last);
            PG8_BAR; PG8_WAIT_L(0); PG8_MMA(1, 0, At, B0); PG8_BAR; PG8_SCHED;
            PG8_STAGE(PG8_SB(1, 1), b3 + hstep, voffB);
            PG8_WAIT_V(6); PG8_BAR; PG8_MMA(1, 1, At, B1); PG8_BAR;
            }
        }
        if constexpr (ALIGN_EPI) { if (wr == 0) PG8_BAR; }
        if constexpr (!Epi::AFTER_DRAIN) { E(acc, cur, wr, wc, fr, fq); S.done(cur); }
        if (!has_next) break;
#pragma unroll
        for (int a = 0; a < 2; ++a)
#pragma unroll
            for (int b = 0; b < 2; ++b)
#pragma unroll
                for (int m = 0; m < 4; ++m)
#pragma unroll
                    for (int n = 0; n < 2; ++n) acc[a][b][m][n] = (f32x4){0.f, 0.f, 0.f, 0.f};
        cur = nxt; cA = nA; cB = nB; ++ui;
        if (MODE == 0) { cvA[0][0] = nvA[0][0]; cvA[0][1] = nvA[0][1]; cvA[1][0] = nvA[1][0]; cvA[1][1] = nvA[1][1]; }
        if constexpr (ALIGN_EPI) { if (wr == 1) PG8_BAR; }
    }
    PG8_WAIT_V(0);
    if constexpr (!ALIGN_EPI) { if (wr == 0) PG8_BAR; }
    PG8_BAR;
    if constexpr (Epi::AFTER_DRAIN) { E.fused(acc, cur, wr, wc, fr, fq, lds, wid, lane); S.done(cur); }
#undef PG8_SA
#undef PG8_SB
#undef PG8_STAGE
#undef PG8_STAGE_A
#undef PG8_LDA
#undef PG8_LDB
#undef PG8_MMA
#undef PG8_WAIT_V
#undef PG8_WAIT_L
#undef PG8_BAR
#undef PG8_SCHED
}
}
namespace pg8 {
__device__ __forceinline__ float fast_sigmoid(float x) { return __builtin_amdgcn_rcpf(1.f + __expf(-x)); }
__device__ __forceinline__ float fast_gelu_tanh(float x) { const float t = 1.5957691216057308f * (x + 0.044715f * x * x * x); return x * __builtin_amdgcn_rcpf(1.f + __expf(-t)); }
__device__ __forceinline__ u32x4 pack8(const f32x4 a, const f32x4 b) { u32x4 w; w.x = cvt_pk_bf16(a[0], a[1]); w.y = cvt_pk_bf16(a[2], a[3]); w.z = cvt_pk_bf16(b[0], b[1]); w.w = cvt_pk_bf16(b[2], b[3]); return w; }

struct EpiProj {
    static constexpr bool PERM = true, AFTER_DRAIN = false;
    const float* rs1; const float* bg; const float* qg; const float* kg; const float* cosT; const float* sinT;
    bf16_t *QP, *KP, *VB, *LRX, *LRG, *GA, *GL;
    __device__ __forceinline__ void operator()(const f32x4 (&acc)[2][2][4][2], const Unit& u, int wr, int wc, int fr, int fq) const {
        const int type = u.pn >> 2;
        const int rowt = u.pm * BM + wr * 64 + fr;
        const int b = (u.pm * BM) >> 12;
        if (type <= 1) {
            const bool isq = (type == 0);
            const float* gsrc = isq ? qg : kg;
            f32x4 g[2][2];
#pragma unroll
            for (int bj = 0; bj < 2; ++bj)
#pragma unroll
                for (int n = 0; n < 2; ++n) g[bj][n] = *(const f32x4*)(gsrc + 32 * bj + 8 * fq + 4 * n);
            const int hc = (u.pn & 3) * 4 + wc;
            bf16_t* dstbase = (isq ? QP : KP) + ((size_t)(b * 16 + hc) * 4096) * 64 + 8 * fq;
            const float osc = isq ? (0.125f * 1.4426950408889634f) : 1.f;
#pragma unroll
            for (int ai = 0; ai < 2; ++ai)
#pragma unroll
                for (int m = 0; m < 4; ++m) {
                    const int row = rowt + ai * HALF + m * 16; const int pos = row & 4095; const float rsv = rs1[row];
                    f32x4 v[2][2]; float ss = 0.f;
#pragma unroll
                    for (int bj = 0; bj < 2; ++bj)
#pragma unroll
                        for (int n = 0; n < 2; ++n) { v[bj][n] = acc[ai][bj][m][n] * rsv; const f32x4 q = v[bj][n] * v[bj][n]; ss += (q[0] + q[1]) + (q[2] + q[3]); }
                    ss += __shfl_xor(ss, 16); ss += __shfl_xor(ss, 32);
                    const float rn = rsqrtf(ss * (1.f / 64.f) + 1e-6f);
                    f32x4 o0[2], o1[2];
#pragma unroll
                    for (int n = 0; n < 2; ++n) {
                        const f32x4 c = *(const f32x4*)(cosT + pos * 32 + 8 * fq + 4 * n), s = *(const f32x4*)(sinT + pos * 32 + 8 * fq + 4 * n);
                        const f32x4 y0 = v[0][n] * rn * g[0][n], y1 = v[1][n] * rn * g[1][n];
                        o0[n] = (y0 * c - y1 * s) * osc; o1[n] = (y0 * s + y1 * c) * osc;
                    }
                    bf16_t* dst = dstbase + (size_t)pos * 64;
                    *(u32x4*)dst = pack8(o0[0], o0[1]);
                    *(u32x4*)(dst + 32) = pack8(o1[0], o1[1]);
                }
        } else {
            const int colt = (u.pn & 3) * 256 + wc * 32 + 8 * fq;
#pragma unroll
            for (int ai = 0; ai < 2; ++ai)
#pragma unroll
                for (int m = 0; m < 4; ++m) {
                    const int row = rowt + ai * HALF + m * 16; const int pos = row & 4095; const float rsv = rs1[row];
#pragma unroll
                    for (int bj = 0; bj < 2; ++bj) {
                        const int col = colt + 128 * bj;
                        f32x4 v0 = acc[ai][bj][m][0] * rsv, v1 = acc[ai][bj][m][1] * rsv;
                        bf16_t* dst;
                        if (type == 2) { dst = VB + ((size_t)((b * 8 + (col >> 7)) * 4096 + pos)) * 128 + (col & 127); }
                        else if (type == 3) { dst = LRX + (size_t)row * 1024 + col; }
                        else if (type == 4) {
                            dst = LRG + (size_t)row * 1024 + col;
#pragma unroll
                            for (int j = 0; j < 4; ++j) { v0[j] = fast_gelu_tanh(v0[j]); v1[j] = fast_gelu_tanh(v1[j]); }
                        } else {
                            const float* bp = bg + (type == 6 ? 1024 : 0) + col;
                            const f32x4 b0 = *(const f32x4*)bp, b1 = *(const f32x4*)(bp + 4);
                            dst = (type == 5 ? GA : GL) + (size_t)row * 1024 + col;
#pragma unroll
                            for (int j = 0; j < 4; ++j) { v0[j] = fast_sigmoid(v0[j] + b0[j]); v1[j] = fast_sigmoid(v1[j] + b1[j]); }
                        }
                        *(u32x4*)dst = pack8(v0, v1);
                    }
                }
        }
    }
};
__device__ __forceinline__ void unpack8(const u32x4 w, f32x4& a, f32x4& b) {
    a[0] = __uint_as_float(w.x << 16); a[1] = __uint_as_float(w.x & 0xffff0000u); a[2] = __uint_as_float(w.y << 16); a[3] = __uint_as_float(w.y & 0xffff0000u);
    b[0] = __uint_as_float(w.z << 16); b[1] = __uint_as_float(w.z & 0xffff0000u); b[2] = __uint_as_float(w.w << 16); b[3] = __uint_as_float(w.w & 0xffff0000u);
}
template <int PASS> struct EpiMerge {
    static constexpr bool PERM = true, AFTER_DRAIN = false;
    bf16_t* M; const bf16_t* G;
    __device__ __forceinline__ void operator()(const f32x4 (&acc)[2][2][4][2], const Unit& u, int wr, int wc, int fr, int fq) const {
        const int row0 = u.pm * BM + wr * 64 + fr, col0 = u.pn * BM + wc * 32 + 8 * fq;
#pragma unroll
        for (int ai = 0; ai < 2; ++ai)
#pragma unroll
            for (int m = 0; m < 4; ++m)
#pragma unroll
                for (int bj = 0; bj < 2; ++bj) {
                    const size_t idx = (size_t)(row0 + ai * HALF + m * 16) * 1024 + col0 + bj * HALF;
                    f32x4 g0, g1; unpack8(*(const u32x4*)(G + idx), g0, g1);
                    f32x4 v0 = acc[ai][bj][m][0] * g0, v1 = acc[ai][bj][m][1] * g1;
                    if (PASS == 2) { f32x4 t0, t1; unpack8(*(const u32x4*)(M + idx), t0, t1); v0 += t0; v1 += t1; }
                    *(u32x4*)(M + idx) = pack8(v0, v1);
                }
    }
};
struct EpiResid {
    static constexpr bool PERM = false, AFTER_DRAIN = false;
    const float* X; float* O;
    __device__ __forceinline__ void operator()(const f32x4 (&acc)[2][2][4][2], const Unit& u, int wr, int wc, int fr, int fq) const {
        const int row0 = u.pm * BM + wr * 64 + fr, col0 = u.pn * BM + wc * 32 + 4 * fq;
#pragma unroll
        for (int ai = 0; ai < 2; ++ai)
#pragma unroll
            for (int m = 0; m < 4; ++m)
#pragma unroll
                for (int bj = 0; bj < 2; ++bj)
#pragma unroll
                    for (int n = 0; n < 2; ++n) {
                        const size_t idx = (size_t)(row0 + ai * HALF + m * 16) * 1024 + col0 + bj * HALF + n * 16;
                        *(f32x4*)(O + idx) = *(const f32x4*)(X + idx) + acc[ai][bj][m][n];
                    }
    }
};
}

constexpr int NWAVES = 8;
constexpr int RING_OFF = 0, RING_BYTES = 131072;
constexpr int LDSCTL_OFF = RING_BYTES, MISC_OFF = LDSCTL_OFF + 320;
constexpr int LDS_BYTES = 147456;
constexpr size_t WS_CTL = WS_S7, CTL_ZERO_BYTES = 1 * MiB;
constexpr size_t WS_SEL_E = WS_S7 + 1 * MiB, WS_SEL_W = WS_S7 + 2 * MiB;
constexpr size_t WS_RS1 = WS_S7 + 3 * MiB;
constexpr size_t WS_COS = WS_S7 + 3 * MiB + 512 * 1024, WS_SIN = WS_S7 + 4 * MiB;
constexpr size_t WS_WINT = WS_S7 + 5 * MiB;
constexpr size_t WS_WAT = WS_S7 + 19 * MiB, WS_WLT = WS_S7 + 21 * MiB, WS_WOT = WS_S7 + 23 * MiB;
constexpr size_t WS_LRUW = WS_S7 + 25 * MiB;
constexpr size_t WS_LRUS = WS_S7 + 26 * MiB;
constexpr size_t WS_LIST = WS_S7 + 30 * MiB;
constexpr int CW_BAR = 4096, CW_CNT = 8192;

#define GAS __attribute__((address_space(1)))
#define LAS __attribute__((address_space(3)))
typedef unsigned v4u __attribute__((ext_vector_type(4)));
typedef float f32x4 __attribute__((ext_vector_type(4)));
typedef GAS unsigned gu32;
typedef GAS unsigned long long gu64;
#define RLX_AGENT __ATOMIC_RELAXED, __HIP_MEMORY_SCOPE_AGENT
#define LDS_WAIT() asm volatile("s_waitcnt lgkmcnt(0)" ::: "memory")
#define VM_WAIT() asm volatile("s_waitcnt vmcnt(0)" ::: "memory")
__device__ __forceinline__ unsigned pk2(float lo, float hi) { return (unsigned)f2bf(lo) | ((unsigned)f2bf(hi) << 16); }
namespace pg8 {
struct GroupedOrder {
    const PG8_LAS int* tb;
    const int* listT;
    int G, c, nct;
    __device__ __forceinline__ bool next(int i, GUnit& u) const {
        const int L = i * G + c; const int Tn = __builtin_amdgcn_readfirstlane(tb[16]);
        if (L >= Tn * nct) return false;
        const int rt = L / nct; u.pn = L % nct; u.pm = rt;
        int e = 0;
#pragma unroll
        for (int k = 1; k < 16; ++k) e += (rt >= __builtin_amdgcn_readfirstlane(tb[k])) ? 1 : 0;
        u.e = e; u.pos0 = (rt - __builtin_amdgcn_readfirstlane(tb[e])) * 256; u.cnt = __builtin_amdgcn_readfirstlane(tb[32 + e]);
        return true;
    }
    __device__ __forceinline__ void rows(const GUnit& u, const unsigned (&voffA)[2], unsigned (&out)[2][2]) const {
#pragma unroll
        for (int h = 0; h < 2; ++h)
#pragma unroll
            for (int i = 0; i < 2; ++i) {
                const int R = (int)(voffA[i] >> 11) + 128 * h, pos = u.pos0 + R;
                const int tok = (pos < u.cnt) ? (listT[u.e * 16384 + pos] >> 1) : 0;
                out[h][i] = (unsigned)tok * 2048u + (voffA[i] & 2047u);
            }
    }
    __device__ __forceinline__ void a_ready(const GUnit&) const {}
    __device__ __forceinline__ void done(const GUnit&) const {}
};
struct EpiUp {
    static constexpr bool PERM = true, AFTER_DRAIN = false;
    bf16_t* HID; const float* listW;
    __device__ __forceinline__ void operator()(const f32x4 (&acc)[2][2][4][2], const GUnit& u, int wr, int wc, int fr, int fq) const {
        const int f0 = u.pn * 128 + wc * 32 + 8 * fq;
#pragma unroll
        for (int ai = 0; ai < 2; ++ai)
#pragma unroll
            for (int m = 0; m < 4; ++m) {
                const int r = ai * HALF + wr * 64 + m * 16 + fr, pos = u.pos0 + r;
                const float w = (pos < u.cnt) ? listW[u.e * 16384 + pos] : 0.f;
                f32x4 h0, h1;
#pragma unroll
                for (int j = 0; j < 4; ++j) {
                    const float g0 = acc[ai][0][m][0][j], g1 = acc[ai][0][m][1][j];
                    h0[j] = g0 * __builtin_amdgcn_rcpf(1.f + __expf(-g0)) * acc[ai][1][m][0][j] * w;
                    h1[j] = g1 * __builtin_amdgcn_rcpf(1.f + __expf(-g1)) * acc[ai][1][m][1][j] * w;
                }
                *(u32x4*)(HID + (size_t)(u.pm * BM + r) * 512 + f0) = pack8(h0, h1);
            }
    }
};
struct EpiDown {
    static constexpr bool PERM = true, AFTER_DRAIN = false;
    bf16_t* Y0; size_t ystride; const int* listT;
    __device__ __forceinline__ void operator()(const f32x4 (&acc)[2][2][4][2], const GUnit& u, int wr, int wc, int fr, int fq) const {
        const int col0 = u.pn * BM + wc * 32 + 8 * fq;
#pragma unroll
        for (int ai = 0; ai < 2; ++ai)
#pragma unroll
            for (int m = 0; m < 4; ++m) {
                const int r = ai * HALF + wr * 64 + m * 16 + fr, pos = u.pos0 + r;
                if (pos < u.cnt) {
                    const int ent = listT[u.e * 16384 + pos];
                    bf16_t* Y = Y0 + (size_t)(ent & 1) * ystride + (size_t)(ent >> 1) * 1024 + col0;
                    *(u32x4*)Y = pack8(acc[ai][0][m][0], acc[ai][0][m][1]);
                    *(u32x4*)(Y + HALF) = pack8(acc[ai][1][m][0], acc[ai][1][m][1]);
                }
            }
    }
};
}
namespace att {
using bf16x8 = __attribute__((ext_vector_type(8))) short;
using s16x4  = __attribute__((ext_vector_type(4))) short;
using f32x16 = __attribute__((ext_vector_type(16))) float;
using u32x4  = __attribute__((ext_vector_type(4))) unsigned;
constexpr int NW = 8, QBLK = 32, KVBLK = 64;
constexpr int SHM_K = KVBLK * 64 * 2, SHM_V = KVBLK * 128 * 2;
constexpr int LDS_V = 0, LDS_K = 2 * SHM_V, LDS_WS = LDS_K + 2 * SHM_K, LDS_OST = LDS_WS + NW * 256, LDS_END = LDS_OST + NW * 8192;
static_assert(LDS_END <= 131072, "attention LDS");
#define ATT_KSWZ(row, c16) ((row) * 128 + ((((c16) ^ ((row) >> 1)) & 7) << 4))
#define ATT_SBAR() __builtin_amdgcn_sched_barrier(0)
__device__ __forceinline__ int crow(int r, int hi) { return (r & 3) + 8 * (r >> 2) + 4 * hi; }
__device__ __forceinline__ unsigned cvtpk(float lo, float hi) { unsigned r; asm volatile("v_cvt_pk_bf16_f32 %0, %1, %2" : "=v"(r) : "v"(lo), "v"(hi)); return r; }

__device__ __forceinline__ void partialSM(f32x16& p0) {
#pragma unroll
  for (int r = 0; r < 16; ++r) p0[r] = __builtin_amdgcn_exp2f(p0[r]);
}
__device__ __forceinline__ void finishSM(f32x16& p0, f32x16& p1, float& l_reg, bf16x8& pa0, bf16x8& pa1, bf16x8& pa2, bf16x8& pa3) {
#pragma unroll
  for (int r = 0; r < 16; ++r) p1[r] = __builtin_amdgcn_exp2f(p1[r]);
  float ps = 0.f;
#pragma unroll
  for (int r = 0; r < 16; ++r) ps += p0[r];
#pragma unroll
  for (int r = 0; r < 16; ++r) ps += p1[r];
  l_reg += ps;
#define ATT_PK4(P, BASE, OUT) do { unsigned a0 = cvtpk(P[BASE + 0], P[BASE + 1]), a1 = cvtpk(P[BASE + 2], P[BASE + 3]);   \
    unsigned b0 = cvtpk(P[BASE + 4], P[BASE + 5]), b1 = cvtpk(P[BASE + 6], P[BASE + 7]);                              \
    auto r0 = __builtin_amdgcn_permlane32_swap(a0, b0, false, false); auto r1 = __builtin_amdgcn_permlane32_swap(a1, b1, false, false); \
    u32x4 w = {r0[0], r1[0], r0[1], r1[1]}; OUT = *reinterpret_cast<bf16x8*>(&w); } while (0)
  ATT_PK4(p0, 0, pa0); ATT_PK4(p0, 8, pa1); ATT_PK4(p1, 0, pa2); ATT_PK4(p1, 8, pa3);
#undef ATT_PK4
}
__device__ __forceinline__ void qkt(f32x16& p0, f32x16& p1, const char* Ks, const bf16x8* qr, int r32, int hi) {
  p0 = f32x16{}; p1 = f32x16{};
#pragma unroll
  for (int d0 = 0; d0 < 4; ++d0) { const int c16 = d0 * 2 + hi;
    const bf16x8 b0 = *reinterpret_cast<const bf16x8*>(Ks + ATT_KSWZ(r32, c16));
    const bf16x8 b1 = *reinterpret_cast<const bf16x8*>(Ks + ATT_KSWZ(32 + r32, c16));
    p0 = __builtin_amdgcn_mfma_f32_32x32x16_bf16(b0, qr[d0], p0, 0, 0, 0);
    p1 = __builtin_amdgcn_mfma_f32_32x32x16_bf16(b1, qr[d0], p1, 0, 0, 0); }
}
__device__ __forceinline__ int v_st(int k, int c) { const int kk = (k & ~0xC) | ((k & 4) << 1) | ((k & 8) >> 1); return ((kk >> 3) * 4 + (c >> 5)) * 512 + ((kk & 7) * 32 + (c & 31)) * 2; }
__device__ __forceinline__ int v_rd_base(int lane) { return ((lane & 3) << 3) | (((lane >> 2) & 3) << 6) | (((lane >> 4) & 1) << 5) | (((lane >> 5) & 1) << 8); }
constexpr int v_rd_off(int d0, int ks, int half) { return d0 * 512 + ks * 4096 + half * 2048; }
template <int OFF> __device__ __forceinline__ s16x4 tr_read(int vb) {
  s16x4 r; asm volatile("ds_read_b64_tr_b16 %0, %1 offset:%2" : "=&v"(r) : "v"(vb), "i"(OFF) : "memory"); return r;
}
template <int D0> __device__ __forceinline__ void pv_one(f32x16& od, int vb, bf16x8 pa0, bf16x8 pa1, bf16x8 pa2, bf16x8 pa3) {
  const s16x4 l0 = tr_read<v_rd_off(D0, 0, 0)>(vb), h0 = tr_read<v_rd_off(D0, 0, 1)>(vb), l1 = tr_read<v_rd_off(D0, 1, 0)>(vb), h1 = tr_read<v_rd_off(D0, 1, 1)>(vb);
  const s16x4 l2 = tr_read<v_rd_off(D0, 2, 0)>(vb), h2 = tr_read<v_rd_off(D0, 2, 1)>(vb), l3 = tr_read<v_rd_off(D0, 3, 0)>(vb), h3 = tr_read<v_rd_off(D0, 3, 1)>(vb);
  asm volatile("s_waitcnt lgkmcnt(0)" ::: "memory"); ATT_SBAR();
#define ATT_PK(L, H) (bf16x8){L[0], L[1], L[2], L[3], H[0], H[1], H[2], H[3]}
  od = __builtin_amdgcn_mfma_f32_32x32x16_bf16(pa0, ATT_PK(l0, h0), od, 0, 0, 0);
  od = __builtin_amdgcn_mfma_f32_32x32x16_bf16(pa1, ATT_PK(l1, h1), od, 0, 0, 0);
  od = __builtin_amdgcn_mfma_f32_32x32x16_bf16(pa2, ATT_PK(l2, h2), od, 0, 0, 0);
  od = __builtin_amdgcn_mfma_f32_32x32x16_bf16(pa3, ATT_PK(l3, h3), od, 0, 0, 0);
#undef ATT_PK
}
__device__ __forceinline__ void pv_d0(f32x16* o, int vb, bf16x8 pa0, bf16x8 pa1, bf16x8 pa2, bf16x8 pa3) {
  pv_one<0>(o[0], vb, pa0, pa1, pa2, pa3); pv_one<1>(o[1], vb, pa0, pa1, pa2, pa3); pv_one<2>(o[2], vb, pa0, pa1, pa2, pa3); pv_one<3>(o[3], vb, pa0, pa1, pa2, pa3);
}

__device__ __forceinline__ void attn_unit(const bf16_t* __restrict__ Qb, const bf16_t* __restrict__ Kh, const bf16_t* __restrict__ Vh, bf16_t* __restrict__ Ob, char* lds) {
  const int tid = threadIdx.x, wid = tid >> 6, lane = tid & 63, r32 = lane & 31, hi = lane >> 5;
  char* V_lds = lds + LDS_V; char* K_lds = lds + LDS_K;
  float* wsf = (float*)(lds + LDS_WS) + wid * 64;
  float l_reg = 0.f; f32x16 o[4] = {}; bf16x8 qr[4];
  const bf16_t* Qw = Qb + (size_t)(wid * QBLK + r32) * 64 + hi * 8;
#pragma unroll
  for (int d0 = 0; d0 < 4; ++d0) qr[d0] = *reinterpret_cast<const bf16x8*>(Qw + d0 * 16);
  const int kst = ATT_KSWZ(tid >> 3, tid & 7);
  const int vst0 = v_st(tid >> 4, (tid & 15) * 8), vst1 = v_st(32 + (tid >> 4), (tid & 15) * 8);
  const int vb0 = (int)(uintptr_t)V_lds + v_rd_base(lane);
  struct { bf16x8 ks, vs0, vs1; } sr_[1];
#define ATT_SLOAD(i, t) do { sr_[i].ks = *reinterpret_cast<const bf16x8*>(Kh + (size_t)(t) * (KVBLK * 64) + tid * 8); \
    sr_[i].vs0 = *reinterpret_cast<const bf16x8*>(Vh + (size_t)(t) * (KVBLK * 128) + tid * 8); \
    sr_[i].vs1 = *reinterpret_cast<const bf16x8*>(Vh + (size_t)(t) * (KVBLK * 128) + 4096 + tid * 8); } while (0)
#define ATT_SWRITE(b, i) do { *(bf16x8*)(K_lds + (b) * SHM_K + kst) = sr_[i].ks; \
    *(bf16x8*)(V_lds + (b) * SHM_V + vst0) = sr_[i].vs0; *(bf16x8*)(V_lds + (b) * SHM_V + vst1) = sr_[i].vs1; } while (0)
#define ATT_SWAIT() asm volatile("s_waitcnt vmcnt(0)" ::: "memory")
  f32x16 pA0, pA1, pB0, pB1; bf16x8 pa0, pa1, pa2, pa3; constexpr int NT = 4096 / KVBLK;
  constexpr int SE = 0, SO = 0;
  __syncthreads();
  ATT_SLOAD(SE, 0); asm volatile("s_waitcnt vmcnt(0)" ::: "memory"); ATT_SWRITE(0, SE); __syncthreads();
  qkt(pA0, pA1, K_lds, qr, r32, hi); partialSM(pA0);
  ATT_SLOAD(SO, 1);
  ATT_SWAIT(); ATT_SWRITE(1, SO); __syncthreads();
  for (int j = 1; j + 1 < NT; j += 2) {
    ATT_SBAR(); qkt(pB0, pB1, K_lds + SHM_K, qr, r32, hi);
    finishSM(pA0, pA1, l_reg, pa0, pa1, pa2, pa3); ATT_SBAR();
    ATT_SLOAD(SO, j + 1); ATT_SBAR();
    pv_d0(o, vb0, pa0, pa1, pa2, pa3); partialSM(pB0);
    __syncthreads(); ATT_SWAIT(); ATT_SWRITE(0, SE);
    __syncthreads();
    ATT_SBAR(); qkt(pA0, pA1, K_lds, qr, r32, hi);
    finishSM(pB0, pB1, l_reg, pa0, pa1, pa2, pa3); ATT_SBAR();
    ATT_SLOAD(SE, j + 2); ATT_SBAR();
    pv_d0(o, vb0 + SHM_V, pa0, pa1, pa2, pa3); partialSM(pA0);
    __syncthreads(); ATT_SWAIT(); ATT_SWRITE(1, SO);
    __syncthreads();
  }
  ATT_SBAR(); qkt(pB0, pB1, K_lds + SHM_K, qr, r32, hi);
  finishSM(pA0, pA1, l_reg, pa0, pa1, pa2, pa3); ATT_SBAR();
  pv_d0(o, vb0, pa0, pa1, pa2, pa3); partialSM(pB0);
  finishSM(pB0, pB1, l_reg, pa0, pa1, pa2, pa3); ATT_SBAR();
  pv_d0(o, vb0 + SHM_V, pa0, pa1, pa2, pa3);
  { auto rr = __builtin_amdgcn_permlane32_swap(__float_as_uint(l_reg), __float_as_uint(l_reg), false, false); l_reg = __uint_as_float(rr[0]) + __uint_as_float(rr[1]); }
  if (hi == 0) wsf[r32] = l_reg; asm volatile("s_waitcnt lgkmcnt(0)" ::: "memory");
  float rli[16];
#pragma unroll
  for (int r = 0; r < 16; ++r) rli[r] = __builtin_amdgcn_rcpf(wsf[crow(r, hi)]);
  bf16_t* stg = (bf16_t*)(lds + LDS_OST) + wid * 4096;
#pragma unroll
  for (int r = 0; r < 16; ++r) { const int orow = crow(r, hi);
#pragma unroll
    for (int d0 = 0; d0 < 4; ++d0) stg[orow * 128 + d0 * 32 + r32] = f2bf(o[d0][r] * rli[r]); }
  asm volatile("s_waitcnt lgkmcnt(0)" ::: "memory");
  bf16_t* Ow = Ob + (size_t)(wid * QBLK) * 1024;
#pragma unroll
  for (int i = 0; i < 8; ++i) { const int row = i * 4 + (lane >> 4), ch = lane & 15; const u32x4 v = *(const u32x4*)(stg + row * 128 + ch * 8); *(u32x4*)(Ow + (size_t)row * 1024 + ch * 8) = v; }
#undef ATT_SLOAD
#undef ATT_SWRITE
#undef ATT_SWAIT
}
}
namespace lru {
using bf16x8 = __attribute__((ext_vector_type(8))) short;
using f32x16 = __attribute__((ext_vector_type(16))) float;
using u32x4  = __attribute__((ext_vector_type(4))) unsigned;
typedef float f32x4_t __attribute__((ext_vector_type(4)));
constexpr int T = 64, NCH = 4096 / T;
constexpr int LDS_XR = 0, LDS_H = 16384, LDS_END = LDS_H + 2 * T * 128 * 4;
#define LRU_XSWZ(row, c16) ((row) * 256 + ((((c16) ^ (row)) & 15) << 4))
__device__ __forceinline__ int crow(int r, int hi) { return (r & 3) + 8 * (r >> 2) + 4 * hi; }
__device__ __forceinline__ float fsig(float x) { return __builtin_amdgcn_rcpf(1.f + __expf(-x)); }

template <int DIR, bool APPLY>
__device__ __forceinline__ void scan(f32x16 (&a)[2], f32x16 (&u)[2], float cin, int hi, float& Ptot, float& Hend) {
  float P[2][4], H[2][4], Pp[2][4], Hp[2][4];
#pragma unroll
  for (int rt = 0; rt < 2; ++rt)
#pragma unroll
    for (int q = 0; q < 4; ++q) {
      float p = 1.f, h = 0.f;
#pragma unroll
      for (int ii = 0; ii < 4; ++ii) { const int r = 4 * q + (DIR ? 3 - ii : ii); h = a[rt][r] * h + u[rt][r]; p *= a[rt][r]; }
      P[rt][q] = p; H[rt][q] = h;
      Pp[rt][q] = __shfl_xor(p, 32); Hp[rt][q] = __shfl_xor(h, 32);
    }
  float c = cin, pt = 1.f; float myc[2][4];
  const bool first = (hi == (DIR ? 1 : 0));
#pragma unroll
  for (int gg = 0; gg < 8; ++gg) {
    const int rt = DIR ? 1 - (gg >> 2) : (gg >> 2), q = DIR ? 3 - (gg & 3) : (gg & 3);
    const float Pf = first ? P[rt][q] : Pp[rt][q], Hf = first ? H[rt][q] : Hp[rt][q];
    const float Ps = first ? Pp[rt][q] : P[rt][q], Hs = first ? Hp[rt][q] : H[rt][q];
    const float c0 = c; c = Pf * c + Hf; const float c1 = c; c = Ps * c + Hs; pt *= Pf * Ps;
    myc[rt][q] = first ? c0 : c1;
  }
  Ptot = pt; Hend = c;
  if (APPLY) {
#pragma unroll
    for (int rt = 0; rt < 2; ++rt)
#pragma unroll
      for (int q = 0; q < 4; ++q) {
        float h = myc[rt][q];
#pragma unroll
        for (int ii = 0; ii < 4; ++ii) { const int r = 4 * q + (DIR ? 3 - ii : ii); h = a[rt][r] * h + u[rt][r]; u[rt][r] = h; }
      }
  }
}

struct Params {
  const bf16_t* LRX; const bf16_t* LRG; const bf16_t* Wt; const float* conv_w; const float* conv_b;
  const float* ba; const float* bi; const float* lam; float* SUM; bf16_t* YL;
};

template <int PASS>
__device__ __forceinline__ void lru_phase(const Params& p, char* lds, int vcu, int G) {
  const int tid = threadIdx.x, wid = tid >> 6, lane = tid & 63, r32 = lane & 31, hi = lane >> 5;
  const int dir = wid >> 2, cq = wid & 3;
  const int blk = vcu & 7, idx = vcu >> 3, nper = (NB * NCH) / (G >> 3);
  const int e = cq * 32 + r32, ch = blk * 128 + e;
  bf16x8 wb[2][8];
#pragma unroll
  for (int g = 0; g < 2; ++g)
#pragma unroll
    for (int ks = 0; ks < 8; ++ks) wb[g][ks] = *reinterpret_cast<const bf16x8*>(p.Wt + ((size_t)((dir * 2 + g) * 8 + blk) * 128 + e) * 128 + ks * 16 + hi * 8);
  const float bav = p.ba[dir * 1024 + ch], biv = p.bi[dir * 1024 + ch];
  const float c8 = -8.f * log1pf(__expf(-p.lam[dir * 1024 + ch]));
  for (int i = 0; i < nper; ++i) {
    const int un = idx * nper + i, b = un / NCH, chunk = un % NCH, t0 = chunk * T;
    const size_t rowb = (size_t)b * 4096;
    __syncthreads();
#pragma unroll
    for (int pp = 0; pp < 2; ++pp) {
      const int pc = tid + pp * 512, t = pc >> 4, c8i = pc & 15, cc = blk * 128 + c8i * 8;
      float acc8[8];
      { const f32x4_t b0 = *(const f32x4_t*)(p.conv_b + cc), b1 = *(const f32x4_t*)(p.conv_b + cc + 4);
        acc8[0] = b0[0]; acc8[1] = b0[1]; acc8[2] = b0[2]; acc8[3] = b0[3]; acc8[4] = b1[0]; acc8[5] = b1[1]; acc8[6] = b1[2]; acc8[7] = b1[3]; }
#pragma unroll
      for (int j = 0; j < 4; ++j) {
        const int ta = t0 + t - 1 + j;
        if (ta >= 0 && ta < 4096) {
          const bf16x8 xv = *reinterpret_cast<const bf16x8*>(p.LRX + (rowb + ta) * 1024 + cc);
          const f32x4_t w0 = *(const f32x4_t*)(p.conv_w + j * 1024 + cc), w1 = *(const f32x4_t*)(p.conv_w + j * 1024 + cc + 4);
#pragma unroll
          for (int k = 0; k < 4; ++k) { acc8[k] += w0[k] * bf2f((bf16_t)xv[k]); acc8[4 + k] += w1[k] * bf2f((bf16_t)xv[4 + k]); }
        }
      }
      u32x4 w; w.x = pk2(acc8[0], acc8[1]); w.y = pk2(acc8[2], acc8[3]); w.z = pk2(acc8[4], acc8[5]); w.w = pk2(acc8[6], acc8[7]);
      *(u32x4*)(lds + LDS_XR + LRU_XSWZ(t, c8i)) = w;
    }
    __syncthreads();
    f32x16 aA[2], aI[2];
    aA[0] = f32x16{}; aA[1] = f32x16{}; aI[0] = f32x16{}; aI[1] = f32x16{};
#pragma unroll
    for (int ks = 0; ks < 8; ++ks) {
      const int c16 = ks * 2 + hi;
      const bf16x8 x0 = *reinterpret_cast<const bf16x8*>(lds + LDS_XR + LRU_XSWZ(r32, c16));
      const bf16x8 x1 = *reinterpret_cast<const bf16x8*>(lds + LDS_XR + LRU_XSWZ(32 + r32, c16));
      aA[0] = __builtin_amdgcn_mfma_f32_32x32x16_bf16(x0, wb[0][ks], aA[0], 0, 0, 0);
      aA[1] = __builtin_amdgcn_mfma_f32_32x32x16_bf16(x1, wb[0][ks], aA[1], 0, 0, 0);
      aI[0] = __builtin_amdgcn_mfma_f32_32x32x16_bf16(x0, wb[1][ks], aI[0], 0, 0, 0);
      aI[1] = __builtin_amdgcn_mfma_f32_32x32x16_bf16(x1, wb[1][ks], aI[1], 0, 0, 0);
    }
#pragma unroll
    for (int rt = 0; rt < 2; ++rt)
#pragma unroll
      for (int r = 0; r < 16; ++r) {
        const int t = 32 * rt + crow(r, hi);
        const float xv = bf2f(*(const bf16_t*)(lds + LDS_XR + LRU_XSWZ(t, e >> 3) + (e & 7) * 2));
        const float rg = fsig(aA[rt][r] + bav), ig = fsig(aI[rt][r] + biv);
        const float a = __expf(c8 * rg);
        aA[rt][r] = a; aI[rt][r] = __builtin_amdgcn_sqrtf(1.f - a * a) * ig * xv;
      }
    float Ptot, Hend;
    if (PASS == 1) {
      if (dir == 0) scan<0, false>(aA, aI, 0.f, hi, Ptot, Hend); else scan<1, false>(aA, aI, 0.f, hi, Ptot, Hend);
      if (hi == 0) { float* s = p.SUM + ((size_t)((b * NCH + chunk) * 2 + dir) * 1024 + ch) * 2; s[0] = Ptot; s[1] = Hend; }
    } else {
      float cin = 0.f;
      if (dir == 0) { for (int j = 0; j < chunk; ++j) { const float* s = p.SUM + ((size_t)((b * NCH + j) * 2 + 0) * 1024 + ch) * 2; cin = s[0] * cin + s[1]; } }
      else { for (int j = NCH - 1; j > chunk; --j) { const float* s = p.SUM + ((size_t)((b * NCH + j) * 2 + 1) * 1024 + ch) * 2; cin = s[0] * cin + s[1]; } }
      if (dir == 0) scan<0, true>(aA, aI, cin, hi, Ptot, Hend); else scan<1, true>(aA, aI, cin, hi, Ptot, Hend);
      float* Hs = (float*)(lds + LDS_H) + dir * (T * 128);
#pragma unroll
      for (int rt = 0; rt < 2; ++rt)
#pragma unroll
        for (int r = 0; r < 16; ++r) Hs[(32 * rt + crow(r, hi)) * 128 + e] = aI[rt][r];
      __syncthreads();
#pragma unroll
      for (int pp = 0; pp < 2; ++pp) {
        const int pc = tid + pp * 512, t = pc >> 4, c8i = pc & 15;
        const float* hf = (const float*)(lds + LDS_H) + t * 128 + c8i * 8; const float* hb = hf + T * 128;
        const f32x4_t f0 = *(const f32x4_t*)hf, f1 = *(const f32x4_t*)(hf + 4), b0 = *(const f32x4_t*)hb, b1 = *(const f32x4_t*)(hb + 4);
        const size_t gi = (rowb + t0 + t) * 1024 + blk * 128 + c8i * 8;
        const bf16x8 gv = *reinterpret_cast<const bf16x8*>(p.LRG + gi);
        u32x4 w;
        w.x = pk2((f0[0] + b0[0]) * bf2f((bf16_t)gv[0]), (f0[1] + b0[1]) * bf2f((bf16_t)gv[1]));
        w.y = pk2((f0[2] + b0[2]) * bf2f((bf16_t)gv[2]), (f0[3] + b0[3]) * bf2f((bf16_t)gv[3]));
        w.z = pk2((f1[0] + b1[0]) * bf2f((bf16_t)gv[4]), (f1[1] + b1[1]) * bf2f((bf16_t)gv[5]));
        w.w = pk2((f1[2] + b1[2]) * bf2f((bf16_t)gv[6]), (f1[3] + b1[3]) * bf2f((bf16_t)gv[7]));
        *(u32x4*)(p.YL + gi) = w;
      }
    }
  }
}
}
#define XB_TMO      128
#define XB_XCNT(j)  (256  + 64 * (j))
#define XB_XSUB(j)  (1280 + 64 * (j))
#define XB_XGEN(j)  (2304 + 64 * (j))
#define XB_TOP      3328
#define XB_TOPGEN   3392
#define XCD_BAR_WORDS 3456
#define XB_SPIN_CAP (1u << 18)

__device__ __forceinline__ unsigned xb_ld(unsigned* p)              { return __hip_atomic_load(p, __ATOMIC_RELAXED, __HIP_MEMORY_SCOPE_AGENT); }
__device__ __forceinline__ unsigned xb_add(unsigned* p, unsigned v) { return __hip_atomic_fetch_add(p, v, __ATOMIC_RELAXED, __HIP_MEMORY_SCOPE_AGENT); }
__device__ __forceinline__ unsigned xb_xcc_id() { return (unsigned)__builtin_amdgcn_s_getreg((3 << 11) | 20) & 0xFu; }
#define XB_SPIN(cond, bar) do { unsigned _sp = 0; while (cond) { __builtin_amdgcn_s_sleep(1); \
    if ((++_sp & 255u) == 0u) { if (xb_ld(&(bar)[XB_TMO])) break; if (_sp > XB_SPIN_CAP) { atomicAdd(&(bar)[XB_TMO], 1u); break; } } } } while (0)

struct XcdBarrier {
    unsigned* bar; unsigned x;
    volatile LAS unsigned* st;
};

__device__ __forceinline__ XcdBarrier xcd_barrier_post(unsigned* bar, volatile LAS unsigned* st) {
    XcdBarrier b; b.bar = bar; b.x = xb_xcc_id(); b.st = st;
    if (threadIdx.x == 0) (void)xb_add(&bar[XB_XCNT(b.x)], 1u);
    return b;
}
__device__ __forceinline__ void xcd_barrier_complete(unsigned* bar, unsigned x, unsigned& nloc, unsigned& nx) {
    const unsigned G = gridDim.x * gridDim.y * gridDim.z;
    unsigned sum, cnt, mine, sp = 0u;
    for (;;) {
        sum = 0u; cnt = 0u; mine = 0u;
#pragma unroll
        for (unsigned j = 0; j < 16; ++j) { const unsigned c = xb_ld(&bar[XB_XCNT(j)]); sum += c; cnt += (c > 0u) ? 1u : 0u; mine = (j == x) ? c : mine; }
        if (sum == G) break;
        __builtin_amdgcn_s_sleep(1);
        if ((++sp & 255u) == 0u) { if (xb_ld(&bar[XB_TMO])) break; if (sp > XB_SPIN_CAP) { atomicAdd(&bar[XB_TMO], 1u); break; } }
    }
    nloc = mine > 0u ? mine : 1u; nx = cnt > 0u ? cnt : 1u;
}

__device__ __forceinline__ void xcd_barrier(const XcdBarrier& b) {
    asm volatile("s_waitcnt vmcnt(0)" ::: "memory");
    __syncthreads();
    if (threadIdx.x == 0) {
        unsigned* bar = b.bar;
        __builtin_amdgcn_s_waitcnt(0);
        unsigned nloc = b.st[0], nx = b.st[1];
        if (nloc == 0u) { xcd_barrier_complete(bar, b.x, nloc, nx); b.st[0] = nloc; b.st[1] = nx; }
        const unsigned old = xb_add(&bar[XB_XSUB(b.x)], 1u);
        const unsigned gen = old / nloc;
        if (old + 1u == (gen + 1u) * nloc) {
            __builtin_amdgcn_fence(__ATOMIC_RELEASE, "agent");
            asm volatile("s_waitcnt vmcnt(0)" ::: "memory");
            const unsigned og = xb_add(&bar[XB_TOP], 1u);
            const unsigned tg = og / nx;
            if (og + 1u == (tg + 1u) * nx) xb_add(&bar[XB_TOPGEN], 1u);
            else XB_SPIN(xb_ld(&bar[XB_TOPGEN]) == tg, bar);
            __builtin_amdgcn_fence(__ATOMIC_ACQUIRE, "agent");
            xb_add(&bar[XB_XGEN(b.x)], 1u);
            asm volatile("s_waitcnt vmcnt(0)" ::: "memory");
        } else {
            XB_SPIN(xb_ld(&bar[XB_XGEN(b.x)]) == gen, bar);
            __builtin_amdgcn_fence(__ATOMIC_ACQUIRE, "agent");
            asm volatile("s_waitcnt vmcnt(0)" ::: "memory");
        }
    }
    __syncthreads();
}
struct MkArgs { const float* in[29]; float* out; unsigned char* ws; int ph_lo, ph_hi; };
struct Frame {
    LAS unsigned char* lds;
    volatile LAS unsigned* MISC;
    gu32* ctl;
    int tid, lane, wave;
    int vcu, G;
};

__device__ __forceinline__ void p0_transpose_item(const float* W, int K, int N, bf16_t* WT, LAS float* scr, int item, int lane, const float* kscale, int mode) {
    const int nblk = N / 32, kb = item / nblk, nb = item % nblk, k0 = 64 * kb, n0 = 32 * nb;
#pragma unroll 8
    for (int i = 0; i < 32; ++i) { const int kk = 2 * i + (lane >> 5); float w = W[(size_t)(k0 + kk) * N + n0 + (lane & 31)]; if (kscale) w *= kscale[k0 + kk]; scr[kk * 33 + (lane & 31)] = w; }
    LDS_WAIT(); asm volatile("" ::: "memory");
    const int r0 = (mode == 1 && n0 < 2048) ? ((n0 & ~255) + 128 * ((n0 >> 5) & 1) + 32 * ((n0 >> 6) & 3)) : (mode >= 2) ? (256 * (n0 >> 7) + 128 * (mode - 2) + (n0 & 127)) : n0;
    const int c = lane & 7;
#pragma unroll
    for (int j = 0; j < 4; ++j) { const int n = (lane >> 3) + 8 * j; const LAS float* s = scr + (8 * c) * 33 + n;
        v4u o; o.x = pk2(s[0 * 33], s[1 * 33]); o.y = pk2(s[2 * 33], s[3 * 33]); o.z = pk2(s[4 * 33], s[5 * 33]); o.w = pk2(s[6 * 33], s[7 * 33]);
        *(GAS v4u*)(WT + (size_t)(r0 + n) * K + k0 + 8 * c) = o; }
    LDS_WAIT(); asm volatile("" ::: "memory");
}
__device__ __forceinline__ void p0_row(const float* xrow, bf16_t* orow, float* rs, int lane) {
    const GAS f32x4* xr = (const GAS f32x4*)xrow + lane;
    f32x4 v[4]; float s = 0.f;
#pragma unroll
    for (int j = 0; j < 4; ++j) { v[j] = xr[64 * j]; s += (v[j].x * v[j].x + v[j].y * v[j].y) + (v[j].z * v[j].z + v[j].w * v[j].w); }
    s = wave_sum(s);
    if (lane == 0) *rs = rsqrtf(s * (1.f / 1024.f) + 1e-6f);
    GAS unsigned long long* o8 = (GAS unsigned long long*)orow + lane;
#pragma unroll
    for (int j = 0; j < 4; ++j) o8[64 * j] = (unsigned long long)pk2(v[j].x, v[j].y) | ((unsigned long long)pk2(v[j].z, v[j].w) << 32);
}

__global__ void __launch_bounds__(NWAVES * 64, 2) persist(MkArgs args) {
    extern __shared__ __attribute__((aligned(16))) unsigned char lds[];
    Frame F;
    F.lds = (LAS unsigned char*)lds;
    F.MISC = (volatile LAS unsigned*)(F.lds + MISC_OFF);
    F.tid = threadIdx.x; F.lane = F.tid & 63; F.wave = __builtin_amdgcn_readfirstlane(F.tid >> 6);
    F.G = gridDim.x; { const int bx = blockIdx.x; F.vcu = (F.G % 8 == 0) ? (bx % 8) * (F.G / 8) + bx / 8 : bx; }
    unsigned char* ws = args.ws;
    F.ctl = (gu32*)(ws + WS_CTL);
    for (int u = F.tid; u < (LDS_BYTES - LDSCTL_OFF) / 4; u += NWAVES * 64) ((LAS unsigned*)(F.lds + LDSCTL_OFF))[u] = 0u;
    __syncthreads();
    const int lo = args.ph_lo, hi = args.ph_hi;
    XcdBarrier bar; bar.bar = (unsigned*)(F.ctl + CW_BAR); bar.x = 0; bar.st = nullptr;
    if (hi - lo > 1) bar = xcd_barrier_post((unsigned*)(F.ctl + CW_BAR), F.MISC + 8);
#define IN(k) (lo <= (k) && (k) < hi)
#define BOTH(k) (IN(k) && IN((k) + 1))
#define GRID_BAR() xcd_barrier(bar)

    const float* x = args.in[0];
    bf16_t* XB = (bf16_t*)args.out;
    float* RS1 = (float*)(ws + WS_RS1); float* COST = (float*)(ws + WS_COS); float* SINT = (float*)(ws + WS_SIN);
    bf16_t* WINT = (bf16_t*)(ws + WS_WINT); bf16_t* WAT = (bf16_t*)(ws + WS_WAT); bf16_t* WLT = (bf16_t*)(ws + WS_WLT); bf16_t* WOT = (bf16_t*)(ws + WS_WOT);
    bf16_t* LRUW = (bf16_t*)(ws + WS_LRUW); float* LRUS = (float*)(ws + WS_LRUS);
    bf16_t* QP = (bf16_t*)(ws + WS_S0); bf16_t* KP = (bf16_t*)(ws + WS_S1); bf16_t* VB = (bf16_t*)(ws + WS_S2);
    bf16_t* LRX = (bf16_t*)(ws + WS_S3); bf16_t* LRG = (bf16_t*)(ws + WS_S4); bf16_t* GA = (bf16_t*)(ws + WS_S5); bf16_t* GL = (bf16_t*)(ws + WS_S6);

    if (IN(0)) REPEAT(0) {
        LAS float* scr = (LAS float*)(F.lds + RING_OFF + F.wave * 16384);
        const int gw = F.vcu * NWAVES + F.wave, NGW = F.G * NWAVES;
        constexpr int I_IN = (1024 / 64) * (PROJ / 32), I_SQ = (1024 / 64) * (1024 / 32);
        constexpr int I_LRU = 32 * 8;
        constexpr int NITEMS = I_IN + 3 * I_SQ + I_LRU;
        for (int it = gw; it < NITEMS; it += NGW) {
            int r = it;
            if (r < I_IN) { p0_transpose_item(args.in[2], 1024, PROJ, WINT, scr, r, F.lane, args.in[1], 1); continue; } r -= I_IN;
            if (r < I_SQ) { p0_transpose_item(args.in[11], 1024, 1024, WAT, scr, r, F.lane, nullptr, 0); continue; } r -= I_SQ;
            if (r < I_SQ) { p0_transpose_item(args.in[19], 1024, 1024, WLT, scr, r, F.lane, nullptr, 0); continue; } r -= I_SQ;
            if (r < I_SQ) { p0_transpose_item(args.in[20], 1024, 1024, WOT, scr, r, F.lane, nullptr, 0); continue; } r -= I_SQ;
            { const int mat = r >> 3, gate = mat >> 4, dirblk = mat & 15, dir = dirblk >> 3, blk = dirblk & 7;
              p0_transpose_item((gate ? args.in[16] : args.in[14]) + (size_t)dirblk * 16384, 128, 128, LRUW + (size_t)((dir * 2 + gate) * 8 + blk) * 16384, scr, r & 7, F.lane, nullptr, 0); }
        }
        for (int m = gw; m < NTOK; m += NGW) p0_row(x + (size_t)m * 1024, XB + (size_t)m * 1024, RS1 + m, F.lane);
        {
            for (int e = blockIdx.x * (NWAVES * 64) + F.tid; e < 4096 * 32; e += F.G * NWAVES * 64) {
                const int pos = e >> 5, i = e & 31;
                const float inv_freq = expf(-9.210340371976184f * (float)i * (1.f / 32.f));
                float sn, cs; sincosf((float)pos * inv_freq, &sn, &cs);
                COST[e] = cs; SINT[e] = sn;
            }
        }
    }
    if (BOTH(0)) GRID_BAR();
    if (IN(1)) REPEAT(1) {
        pg8::Gemm g{XB, WINT, NTOK, PROJ, 1024}; pg8::StaticOrder S; S.init(NTOK, PROJ, F.G, (int)blockIdx.x);
        pg8::EpiProj E{RS1, args.in[3], args.in[4], args.in[5], COST, SINT, QP, KP, VB, LRX, LRG, GA, GL};
        pg8::gemm_phase<pg8::EpiProj, pg8::StaticOrder, true, true>(F.lds + RING_OFF, g, S, E);
    }
    if (BOTH(1)) GRID_BAR();
    bf16_t* O1N = (bf16_t*)args.out; bf16_t* O2N = O1N + (size_t)NTOK * 1024;
    if (IN(2)) {
        const int per = 1024 / F.G;
        REPEAT(2) for (int i = 0; i < per; ++i) {
            const int unit = F.vcu * per + i;
            const int bhc = unit >> 4, qb = unit & 15, b = bhc >> 4, hc = bhc & 15, h = hc >> 1, c = hc & 1;
            att::attn_unit(QP + ((size_t)bhc * 4096 + qb * 256) * 64, KP + (size_t)bhc * 4096 * 64, VB + ((size_t)(b * 8 + h) * 4096) * 128,
                           (c ? O2N : O1N) + ((size_t)b * 4096 + qb * 256) * 1024 + h * 128, (char*)lds + RING_OFF);
        }
        REPEAT(10) { const lru::Params lp{LRX, LRG, LRUW, args.in[12], args.in[13], args.in[15], args.in[17], args.in[18], LRUS, nullptr};
          lru::lru_phase<1>(lp, (char*)lds + RING_OFF, F.vcu, F.G); }
        if (BOTH(2)) GRID_BAR();
    }
    bf16_t* ON = (bf16_t*)(ws + WS_S0); bf16_t* YL = (bf16_t*)(ws + WS_S1);
    if (IN(3)) REPEAT(3) {
        {
            const float s1 = wave_sum(args.in[6][F.lane] * args.in[7][F.lane]), s2 = wave_sum(args.in[8][F.lane] * args.in[9][F.lane]);
            const float lam = expf(s1) - expf(s2) + 0.2f;
            const float g0 = args.in[10][F.lane] * 0.8f, g1 = args.in[10][64 + F.lane] * 0.8f;
            const int gw = F.vcu * NWAVES + F.wave, NGW = F.G * NWAVES;
            for (int it = gw; it < NTOK * 8; it += NGW) {
                const size_t base = (size_t)it * 128;
                const float a0 = bf2f(O1N[base + F.lane]) - lam * bf2f(O2N[base + F.lane]);
                const float a1 = bf2f(O1N[base + 64 + F.lane]) - lam * bf2f(O2N[base + 64 + F.lane]);
                const float ss = wave_sum(a0 * a0 + a1 * a1);
                const float rs = rsqrtf(ss * (1.f / 128.f) + 1e-6f);
                ON[base + F.lane] = f2bf(a0 * rs * g0); ON[base + 64 + F.lane] = f2bf(a1 * rs * g1);
            }
        }
        { const lru::Params lp{LRX, LRG, LRUW, args.in[12], args.in[13], args.in[15], args.in[17], args.in[18], LRUS, YL};
          lru::lru_phase<2>(lp, (char*)lds + RING_OFF, F.vcu, F.G); }
    }
    if (BOTH(3)) GRID_BAR();
    bf16_t* MERGED = (bf16_t*)(ws + WS_S2);
    if (IN(4)) REPEAT(4) {
        { pg8::Gemm g{ON, WAT, NTOK, 1024, 1024}; pg8::StaticOrder S; S.init(NTOK, 1024, F.G, (int)blockIdx.x);
          pg8::EpiMerge<1> E{MERGED, GA};
          pg8::gemm_phase<pg8::EpiMerge<1>, pg8::StaticOrder, false, true>(F.lds + RING_OFF, g, S, E); }
        { pg8::Gemm g{YL, WLT, NTOK, 1024, 1024}; pg8::StaticOrder S; S.init(NTOK, 1024, F.G, (int)blockIdx.x);
          pg8::EpiMerge<2> E{MERGED, GL};
          pg8::gemm_phase<pg8::EpiMerge<2>, pg8::StaticOrder, false, true>(F.lds + RING_OFF, g, S, E); }
    }
    if (BOTH(4)) GRID_BAR();
    if (IN(5)) REPEAT(5) {
        pg8::Gemm g{MERGED, WOT, NTOK, 1024, 1024}; pg8::StaticOrder S; S.init(NTOK, 1024, F.G, (int)blockIdx.x);
        pg8::EpiResid E{x, args.out};
        pg8::gemm_phase<pg8::EpiResid, pg8::StaticOrder, false, true>(F.lds + RING_OFF, g, S, E);
    }
    if (BOTH(5)) GRID_BAR();
    bf16_t* H2 = (bf16_t*)(ws + WS_S0); bf16_t* HID = (bf16_t*)(ws + WS_S3);
    bf16_t* WGU = (bf16_t*)(ws + WS_S5); bf16_t* WDN = (bf16_t*)(ws + WS_S6 + 2 * MiB);
    bf16_t* Y0 = (bf16_t*)(ws + WS_S1); bf16_t* Y1 = (bf16_t*)(ws + WS_S2);
    int* LISTT = (int*)(ws + WS_LIST); float* LISTW = (float*)(ws + WS_LIST + 1 * MiB);
    gu32* GCNT = F.ctl + CW_CNT;
    LAS int* TB = (LAS int*)(F.lds + LDSCTL_OFF + 1024);
    if (IN(6)) {
        const float* x1 = args.out;
        const int tpc = NTOK / F.G, tpw = tpc / NWAVES;
        LAS int* LE = (LAS int*)(F.lds + RING_OFF + 12288); LAS float* LW = (LAS float*)(F.lds + RING_OFF + 12288 + 1024);
        LAS int* LRK = (LAS int*)(F.lds + RING_OFF + 12288 + 2048); LAS int* LCNT = (LAS int*)(F.lds + RING_OFF + 12288 + 3072); LAS int* LBASE = LCNT + 16;
        LAS float* WR = (LAS float*)(F.lds + RING_OFF + 16384);
        __syncthreads();
        if (F.tid < 32) LCNT[F.tid] = 0;
        const float* gain2 = args.in[21]; const float* wg = args.in[22]; const float* bg = args.in[23]; const float* wer = args.in[24]; const float* ber = args.in[25];
        for (int i = F.tid; i < 1024 * 5; i += NWAVES * 64) {
            const int d = i / 5, q = i % 5;
            const f32x4 w4 = (q == 0) ? *(const f32x4*)&wg[d * 4] : *(const f32x4*)&wer[d * 16 + (q - 1) * 4];
            *(LAS f32x4*)&WR[d * 20 + q * 4] = w4;
        }
        __syncthreads();
        for (int k = 0; k < tpw; ++k) {
            const int tl = F.wave * tpw + k; const size_t tok = (size_t)F.vcu * tpc + tl;
            const float* xr = x1 + tok * 1024 + F.lane; const float* gp = gain2 + F.lane; bf16_t* hp = H2 + tok * 1024 + F.lane;
            float v[16]; float ss = 0.f;
#pragma unroll
            for (int j = 0; j < 16; ++j) { v[j] = xr[j * 64]; ss += v[j] * v[j]; }
            ss = wave_sum(ss);
            const float rs = rsqrtf(ss * (1.f / 1024.f) + 1e-6f);
            float lg[20];
#pragma unroll
            for (int q = 0; q < 20; ++q) lg[q] = 0.f;
            const LAS float* wl = WR + F.lane * 20;
#pragma unroll
            for (int j = 0; j < 16; ++j) {
                const float hv = v[j] * rs * gp[j * 64];
                hp[j * 64] = f2bf(hv);
#pragma unroll
                for (int q = 0; q < 5; ++q) { const f32x4 w4 = *(const LAS f32x4*)&wl[j * 64 * 20 + q * 4]; lg[q * 4 + 0] += hv * w4.x; lg[q * 4 + 1] += hv * w4.y; lg[q * 4 + 2] += hv * w4.z; lg[q * 4 + 3] += hv * w4.w; }
            }
#pragma unroll
            for (int q = 0; q < 20; ++q) lg[q] = wave_sum(lg[q]);
            const float gl0 = lg[0] + bg[0], gl1 = lg[1] + bg[1], gl2 = lg[2] + bg[2], gl3 = lg[3] + bg[3];
            int gs = 0; float gm = gl0;
            if (gl1 > gm) { gm = gl1; gs = 1; } if (gl2 > gm) { gm = gl2; gs = 2; } if (gl3 > gm) { gm = gl3; gs = 3; }
            const float gw = 1.f / (expf(gl0 - gm) + expf(gl1 - gm) + expf(gl2 - gm) + expf(gl3 - gm));
            float el[4];
#pragma unroll
            for (int j = 0; j < 4; ++j) { const float s0 = lg[4 + j], s1 = lg[8 + j], s2 = lg[12 + j], s3 = lg[16 + j]; el[j] = (gs == 0 ? s0 : gs == 1 ? s1 : gs == 2 ? s2 : s3) + ber[gs * 4 + j]; }
            int i0 = 0; float v0 = el[0];
            if (el[1] > v0) { v0 = el[1]; i0 = 1; } if (el[2] > v0) { v0 = el[2]; i0 = 2; } if (el[3] > v0) { v0 = el[3]; i0 = 3; }
            int i1 = (i0 == 0) ? 1 : 0; float v1 = -3.0e38f;
#pragma unroll
            for (int j = 0; j < 4; ++j) { if (j != i0 && el[j] > v1) { v1 = el[j]; i1 = j; } }
            const float ex = expf(v1 - v0);
            if (F.lane == 0) { LE[tl * 2] = gs * 4 + i0; LE[tl * 2 + 1] = gs * 4 + i1; LW[tl * 2] = gw / (1.f + ex); LW[tl * 2 + 1] = gw * ex / (1.f + ex); }
        }
        __syncthreads();
        const int npair = tpc * 2;
        int me = 0;
        if (F.tid < npair) { me = LE[F.tid]; LRK[F.tid] = __hip_atomic_fetch_add(&LCNT[me], 1, __ATOMIC_RELAXED, __HIP_MEMORY_SCOPE_WORKGROUP); }
        __syncthreads();
        if (F.tid < 16) LBASE[F.tid] = (int)__hip_atomic_fetch_add(GCNT + F.tid, (unsigned)LCNT[F.tid], RLX_AGENT);
        __syncthreads();
        if (F.tid < npair) { const int pos = LBASE[me] + LRK[F.tid]; LISTT[me * 16384 + pos] = (F.vcu * tpc + (F.tid >> 1)) * 2 + (F.tid & 1); LISTW[me * 16384 + pos] = LW[F.tid]; }
        __syncthreads();
        REPEAT(11) {
            LAS float* scr = (LAS float*)(F.lds + RING_OFF + F.wave * 16384);
            const int gw_ = F.vcu * NWAVES + F.wave, NGW = F.G * NWAVES;
            constexpr int I_GU = (1024 / 64) * (512 / 32), I_DN = (512 / 64) * (1024 / 32);
            for (int it = gw_; it < 16 * (2 * I_GU + I_DN); it += NGW) {
                const int e = it / (2 * I_GU + I_DN); int r = it % (2 * I_GU + I_DN);
                if (r < 2 * I_GU) {
                    const int isup = r >= I_GU; if (isup) r -= I_GU;
                    p0_transpose_item((isup ? args.in[27] : args.in[26]) + (size_t)e * 1024 * 512, 1024, 512, WGU + (size_t)e * 1024 * 1024, scr, r, F.lane, nullptr, 2 + isup);
                } else {
                    p0_transpose_item(args.in[28] + (size_t)e * 512 * 1024, 512, 1024, WDN + (size_t)e * 1024 * 512, scr, r - 2 * I_GU, F.lane, nullptr, 0);
                }
            }
        }
        if (BOTH(6)) GRID_BAR();
    }
    if (IN(7) || IN(8)) {
        __syncthreads();
        if (F.tid < 16) TB[32 + F.tid] = (int)__hip_atomic_load(GCNT + F.tid, RLX_AGENT);
        __syncthreads();
        if (F.tid == 0) { int accn = 0; for (int e = 0; e < 16; ++e) { TB[e] = accn; accn += (TB[32 + e] + 255) >> 8; } TB[16] = accn; }
        __syncthreads();
    }
    if (IN(7)) REPEAT(7) {
        pg8::Gemm g{H2, WGU, 0, 1024, 1024}; pg8::GroupedOrder S{TB, LISTT, F.G, F.vcu, 4};
        pg8::EpiUp E{HID, LISTW};
        pg8::gemm_grouped<pg8::EpiUp, pg8::GroupedOrder, 0, true>(F.lds + RING_OFF, g, S, E);
    }
    if (BOTH(7)) GRID_BAR();
    if (IN(8)) REPEAT(8) {
        pg8::Gemm g{HID, WDN, 0, 1024, 512}; pg8::GroupedOrder S{TB, LISTT, F.G, F.vcu, 4};
        pg8::EpiDown E{Y0, (size_t)(Y1 - Y0), LISTT};
        pg8::gemm_grouped<pg8::EpiDown, pg8::GroupedOrder, 1, true>(F.lds + RING_OFF, g, S, E);
    }
    if (BOTH(8)) GRID_BAR();
    if (IN(9)) {
        typedef unsigned u32x2_t __attribute__((ext_vector_type(2)));
        f32x4* o4 = (f32x4*)args.out; const u32x2_t* a2 = (const u32x2_t*)Y0; const u32x2_t* b2 = (const u32x2_t*)Y1;
        for (size_t i = (size_t)blockIdx.x * (NWAVES * 64) + F.tid; i < (size_t)NTOK * 256; i += (size_t)F.G * NWAVES * 64) {
            f32x4 v = o4[i]; const u32x2_t a = a2[i], b = b2[i];
            v[0] += __uint_as_float(a.x << 16) + __uint_as_float(b.x << 16); v[1] += __uint_as_float(a.x & 0xffff0000u) + __uint_as_float(b.x & 0xffff0000u);
            v[2] += __uint_as_float(a.y << 16) + __uint_as_float(b.y << 16); v[3] += __uint_as_float(a.y & 0xffff0000u) + __uint_as_float(b.y & 0xffff0000u);
            o4[i] = v;
        }
    }
#undef IN
#undef BOTH
}
extern "C" void kernel_launch(void* const* d_in, const int* in_sizes, int n_in, void* d_out, int out_size, void* d_ws, size_t ws_size, hipStream_t stream) {
  static int once = 0;
  if (!once) {
    once = 1;
    if (ws_size < 8 * SLOT || n_in != 29) fprintf(stderr, "kernel_launch: unexpected ws %zu n_in %d\n", ws_size, n_in);
    (void)hipFuncSetAttribute((const void*)persist, hipFuncAttributeMaxDynamicSharedMemorySize, LDS_BYTES);
  }
  char* ws = (char*)d_ws;
  (void)hipMemsetAsync(ws + WS_CTL, 0, CTL_ZERO_BYTES, stream);
  MkArgs a{};
  for (int i = 0; i < 29; ++i) a.in[i] = (const float*)d_in[i];
  a.out = (float*)d_out; a.ws = (unsigned char*)d_ws;
  const int GRID = 256;
  a.ph_lo = 0; a.ph_hi = 10; hipLaunchKernelGGL(persist, dim3(GRID), dim3(NWAVES * 64), LDS_BYTES, stream, a);
}
```

```cpp
#include <hip/hip_runtime.h>
#include <cstdint>
#include <cstdio>

typedef unsigned short bf16_t;
__device__ __forceinline__ float bf2f(bf16_t v) { return __uint_as_float(((unsigned)v) << 16); }
__device__ __forceinline__ bf16_t f2bf(float f) { unsigned u = __float_as_uint(f); return (bf16_t)((u + 0x7fffu + ((u >> 16) & 1u)) >> 16); }
__device__ __forceinline__ float toF(float v) { return v; }
__device__ __forceinline__ float toF(bf16_t v) { return bf2f(v); }

constexpr int NTOK = 16384, DM = 1024, SEQ = 4096, NB = 4, PROJ = 7168;
constexpr size_t MiB = 1u << 20;
constexpr size_t SLOT = 32 * MiB;
constexpr size_t WS_S0 = 0, WS_S1 = SLOT, WS_S2 = 2 * SLOT, WS_S3 = 3 * SLOT, WS_S4 = 4 * SLOT, WS_S5 = 5 * SLOT, WS_S6 = 6 * SLOT, WS_S7 = 7 * SLOT;

__device__ __forceinline__ float wave_sum(float v) {
#pragma unroll
  for (int o = 1; o < 64; o <<= 1) v += __shfl_xor(v, o);
  return v;
}
__device__ __forceinline__ float sigmoidf_(float x) { return 1.f / (1.f + __expf(-x)); }
__device__ __forceinline__ float gelu_tanh(float x) {
  const float k0 = 0.7978845608028654f, k1 = 0.044715f;
  float t = k0 * (x + k1 * x * x * x);
  return 0.5f * x * (1.f + tanhf(t));
}

#ifndef PROBE_PHASE
#define PROBE_PHASE -1
#endif
#define REPEAT(k) for (int _rep = 0; _rep < ((PROBE_PHASE == (k)) ? 2 : 1); ++_rep)
namespace pg8 {
#define PG8_LAS __attribute__((address_space(3)))
typedef unsigned short bf16_t;
typedef short bf16x8 __attribute__((ext_vector_type(8)));
typedef float f32x4 __attribute__((ext_vector_type(4)));
typedef unsigned u32x4 __attribute__((ext_vector_type(4)));
constexpr int BM = 256, BK = 64, HALF = 128, HTB = HALF * BK * 2  , STAGE_BYTES = 8 * HTB, NXCD = 8, WGM = 8;

__host__ __device__ __forceinline__ int lds_byte(int r, int c) { const int st = (r >> 4) * 2 + (c >> 5), rr = r & 15, cc = c & 31, ob = rr * 64 + cc * 2; return st * 1024 + (ob ^ (((ob >> 9) & 1) << 5)); }
__host__ __device__ __forceinline__ void stage_rc(int b, int& R, int& C) { const int st = b / 1024, sb = b % 1024, swz = sb ^ (((sb >> 9) & 1) << 5); R = (st >> 1) * 16 + swz / 64; C = (st & 1) * 32 + (swz % 64) / 2; }
__host__ __device__ __forceinline__ int perm32(int rho) { const int n = rho >> 4, i = rho & 15; return 8 * (i >> 2) + 4 * n + (i & 3); }

struct Unit { int pm, pn; };
struct GUnit { int pm, pn, e, pos0, cnt; };
struct Gemm { const bf16_t* A; const bf16_t* Bt; int M, N, K; };

struct StaticOrder {
    int nM, nN, nwg, G, c, rep;
    __host__ __device__ void init(int M, int N, int G_, int c_, int rep_ = 1) { nM = M / BM; nN = N / BM; nwg = nM * nN; G = G_; c = c_; rep = rep_; }
    __host__ __device__ bool next(int i, Unit& u) const {
        const long L = (long)i * G + c; if (L >= (long)nwg * rep) return false;
        int wgid = (int)(L % nwg); { const int q = nwg / NXCD, r = nwg % NXCD, xcd = wgid % NXCD, off = wgid / NXCD; wgid = (xcd < r ? xcd * (q + 1) : r * (q + 1) + (xcd - r) * q) + off; }
        const int nig = WGM * nN, gid = wgid / nig, fm = gid * WGM, gsz = (nM - fm) < WGM ? (nM - fm) : WGM;
        u.pm = fm + ((wgid % nig) % gsz); u.pn = (wgid % nig) / gsz; return true;
    }
    __device__ __forceinline__ void a_ready(const Unit&) const {}
    __device__ __forceinline__ void done(const Unit&) const {}
};

__device__ __forceinline__ unsigned cvt_pk_bf16(float lo, float hi) { unsigned r; asm volatile("v_cvt_pk_bf16_f32 %0, %1, %2" : "=v"(r) : "v"(lo), "v"(hi)); return r; }
typedef float f32x2 __attribute__((ext_vector_type(2)));
template <class Epi, class Sched, bool ALIGN_EPI = false, bool SP2 = false>
__device__ __forceinline__ void gemm_phase(PG8_LAS unsigned char* lds, const Gemm g, const Sched& S, const Epi& E) {
    const int tid = threadIdx.x, wid = __builtin_amdgcn_readfirstlane(tid >> 6), lane = tid & 63, wr = wid >> 2, wc = wid & 3, fr = lane & 15, fq = lane >> 4;
    const int K = g.K, nt = K / BK;
    unsigned voffA[2], voffB[2];
#pragma unroll
    for (int i = 0; i < 2; ++i) { int R, C; stage_rc(tid * 16 + i * 8192, R, C); const int Rb = Epi::PERM ? ((R & ~31) + perm32(R & 31)) : R;
        voffA[i] = (unsigned)(R * K + C) * 2u; voffB[i] = (unsigned)(Rb * K + C) * 2u; }
    const size_t kstep = (size_t)(BK * 2);
    const size_t hstep = (size_t)HALF * K * 2;
    const size_t tstep = 2 * hstep;
    const unsigned ldsw = (unsigned)wid * 1024u;
    const int aoff = lds_byte(wr * 64 + fr, fq * 8), boff = lds_byte(wc * 32 + fr, fq * 8);
#define PG8_SA(b, h) (((b) * 2 + (h)) * HTB)
#define PG8_SB(b, h) ((4 + (b) * 2 + (h)) * HTB)
#define PG8_STAGE(bufoff, gbase, voff) do { _Pragma("unroll") for (int _i = 0; _i < 2; ++_i) \
        __builtin_amdgcn_global_load_lds((const unsigned*)((const char*)(gbase) + (voff)[_i]), (PG8_LAS unsigned*)(lds + (bufoff) + ldsw + _i * 8192), 16, 0, 0); } while (0)
#define PG8_LDA(dst, b, h) do { _Pragma("unroll") for (int m = 0; m < 4; ++m) _Pragma("unroll") for (int k = 0; k < 2; ++k) dst[m][k] = *(const PG8_LAS bf16x8*)(lds + PG8_SA(b, h) + aoff + m * 2048 + k * 1024); } while (0)
#define PG8_LDB(dst, b, h) do { _Pragma("unroll") for (int n = 0; n < 2; ++n) _Pragma("unroll") for (int k = 0; k < 2; ++k) dst[n][k] = *(const PG8_LAS bf16x8*)(lds + PG8_SB(b, h) + boff + n * 2048 + k * 1024); } while (0)
#define PG8_MMA(ai, bj, At, Bt) do { __builtin_amdgcn_s_setprio(1); _Pragma("unroll") for (int m = 0; m < 4; ++m) _Pragma("unroll") for (int n = 0; n < 2; ++n) _Pragma("unroll") for (int k = 0; k < 2; ++k) \
        acc[ai][bj][m][n] = __builtin_amdgcn_mfma_f32_16x16x32_bf16(Bt[n][k], At[m][k], acc[ai][bj][m][n], 0, 0, 0); __builtin_amdgcn_s_setprio(0); } while (0)
#define PG8_WAIT_V(n) asm volatile("s_waitcnt vmcnt(" #n ")" ::: "memory")
#define PG8_WAIT_L(n) asm volatile("s_waitcnt lgkmcnt(" #n ")" ::: "memory")
#define PG8_BAR __builtin_amdgcn_s_barrier()
#define PG8_SCHED __builtin_amdgcn_sched_barrier(0)
    Unit cur, nxt; int ui = 0;
    if (!S.next(0, cur)) return;
    f32x4 acc[2][2][4][2];
#pragma unroll
    for (int a = 0; a < 2; ++a)
#pragma unroll
        for (int b = 0; b < 2; ++b)
#pragma unroll
            for (int m = 0; m < 4; ++m)
#pragma unroll
                for (int n = 0; n < 2; ++n) acc[a][b][m][n] = (f32x4){0.f, 0.f, 0.f, 0.f};
    bf16x8 At[4][2], B0[2][2], B1[2][2];
    const char* cA = (const char*)g.A + (size_t)cur.pm * tstep; const char* cB = (const char*)g.Bt + (size_t)cur.pn * tstep;
    S.a_ready(cur);
    if constexpr (SP2) {
        PG8_STAGE(PG8_SB(0, 0), cB, voffB); PG8_STAGE(PG8_SB(0, 1), cB + hstep, voffB); PG8_STAGE(PG8_SA(0, 0), cA, voffA); PG8_STAGE(PG8_SA(0, 1), cA + hstep, voffA);
        if (wr == 1) PG8_BAR;
        PG8_WAIT_V(2); PG8_BAR;
        PG8_STAGE(PG8_SB(1, 0), cB + kstep, voffB); PG8_STAGE(PG8_SA(1, 0), cA + kstep, voffA); PG8_STAGE(PG8_SB(1, 1), cB + hstep + kstep, voffB);
        PG8_WAIT_V(6); PG8_BAR;
    } else {
        PG8_STAGE(PG8_SB(0, 0), cB, voffB); PG8_STAGE(PG8_SA(0, 0), cA, voffA); PG8_STAGE(PG8_SB(0, 1), cB + hstep, voffB); PG8_STAGE(PG8_SA(0, 1), cA + hstep, voffA);
        if (wr == 1) PG8_BAR;
        PG8_WAIT_V(4); PG8_BAR;
        PG8_STAGE(PG8_SB(1, 0), cB + kstep, voffB); PG8_STAGE(PG8_SA(1, 0), cA + kstep, voffA); PG8_STAGE(PG8_SB(1, 1), cB + hstep + kstep, voffB);
        PG8_WAIT_V(6); PG8_BAR;
    }
    for (;;) {
        const bool has_next = S.next(ui + 1, nxt);
        const char* nA = has_next ? (const char*)g.A + (size_t)nxt.pm * tstep : cA; const char* nB = has_next ? (const char*)g.Bt + (size_t)nxt.pn * tstep : cB;
        for (int t = 0; t < nt; t += 2) {
            const bool last = (t == nt - 2);
            const char* a1 = cA + (size_t)(t + 1) * kstep;
            const char* a2 = last ? nA : cA + (size_t)(t + 2) * kstep; const char* b2 = last ? nB : cB + (size_t)(t + 2) * kstep;
            const char* a3 = a2 + kstep; const char* b3 = b2 + kstep;
            if (last && has_next) S.a_ready(nxt);
            if constexpr (SP2) {
            PG8_LDB(B0, 0, 0); PG8_LDB(B1, 0, 1); PG8_SCHED; PG8_LDA(At, 0, 0); PG8_STAGE(PG8_SA(1, 1), a1 + hstep, voffA);
            PG8_WAIT_V(8); PG8_WAIT_L(0); PG8_BAR; PG8_MMA(0, 0, At, B0); PG8_MMA(0, 1, At, B1); PG8_BAR; PG8_SCHED;
            PG8_LDA(At, 0, 1); PG8_STAGE(PG8_SB(0, 0), b2, voffB); PG8_STAGE(PG8_SB(0, 1), b2 + hstep, voffB); PG8_STAGE(PG8_SA(0, 0), a2, voffA);
            PG8_WAIT_V(8); PG8_WAIT_L(0); PG8_BAR; PG8_MMA(1, 0, At, B0); PG8_MMA(1, 1, At, B1); PG8_BAR; PG8_SCHED;
            PG8_LDB(B0, 1, 0); PG8_LDB(B1, 1, 1); PG8_SCHED; PG8_LDA(At, 1, 0); PG8_STAGE(PG8_SA(0, 1), a2 + hstep, voffA);
            PG8_WAIT_V(8); PG8_WAIT_L(0); PG8_BAR; PG8_MMA(0, 0, At, B0); PG8_MMA(0, 1, At, B1); PG8_BAR; PG8_SCHED;
            PG8_LDA(At, 1, 1); PG8_STAGE(PG8_SB(1, 0), b3, voffB); PG8_STAGE(PG8_SB(1, 1), b3 + hstep, voffB); PG8_STAGE(PG8_SA(1, 0), a3, voffA);
            PG8_WAIT_V(8); PG8_WAIT_L(0); PG8_BAR; PG8_MMA(1, 0, At, B0); PG8_MMA(1, 1, At, B1); PG8_BAR; PG8_SCHED;
            } else {
            PG8_LDB(B0, 0, 0); PG8_SCHED; PG8_LDA(At, 0, 0); PG8_STAGE(PG8_SA(1, 1), a1 + hstep, voffA);
            PG8_WAIT_L(8); PG8_BAR; PG8_WAIT_L(0); PG8_MMA(0, 0, At, B0); PG8_BAR; PG8_SCHED;
            PG8_LDB(B1, 0, 1); PG8_STAGE(PG8_SB(0, 0), b2, voffB);
            PG8_BAR; PG8_WAIT_L(0); PG8_MMA(0, 1, At, B1); PG8_BAR;
            PG8_LDA(At, 0, 1); PG8_STAGE(PG8_SA(0, 0), a2, voffA);
            PG8_BAR; PG8_WAIT_L(0); PG8_MMA(1, 0, At, B0); PG8_BAR; PG8_SCHED;
            PG8_STAGE(PG8_SB(0, 1), b2 + hstep, voffB);
            PG8_WAIT_V(6); PG8_BAR; PG8_MMA(1, 1, At, B1); PG8_BAR;
            PG8_LDB(B0, 1, 0); PG8_SCHED; PG8_LDA(At, 1, 0); PG8_STAGE(PG8_SA(0, 1), a2 + hstep, voffA);
            PG8_WAIT_L(8); PG8_BAR; PG8_WAIT_L(0); PG8_MMA(0, 0, At, B0); PG8_BAR; PG8_SCHED;
            PG8_LDB(B1, 1, 1); PG8_STAGE(PG8_SB(1, 0), b3, voffB);
            PG8_BAR; PG8_WAIT_L(0); PG8_MMA(0, 1, At, B1); PG8_BAR;
            PG8_LDA(At, 1, 1); PG8_STAGE(PG8_SA(1, 0), a3, voffA);
            PG8_BAR; PG8_WAIT_L(0); PG8_MMA(1, 0, At, B0); PG8_BAR; PG8_SCHED;
            PG8_STAGE(PG8_SB(1, 1), b3 + hstep, voffB);
            PG8_WAIT_V(6); PG8_BAR; PG8_MMA(1, 1, At, B1); PG8_BAR;
            }
        }
        if constexpr (ALIGN_EPI) { if (wr == 0) PG8_BAR; }
        if constexpr (!Epi::AFTER_DRAIN) { E(acc, cur, wr, wc, fr, fq); S.done(cur); }
        if (!has_next) break;
#pragma unroll
        for (int a = 0; a < 2; ++a)
#pragma unroll
            for (int b = 0; b < 2; ++b)
#pragma unroll
                for (int m = 0; m < 4; ++m)
#pragma unroll
                    for (int n = 0; n < 2; ++n) acc[a][b][m][n] = (f32x4){0.f, 0.f, 0.f, 0.f};
        cur = nxt; cA = nA; cB = nB; ++ui;
        if constexpr (ALIGN_EPI) { if (wr == 1) PG8_BAR; }
    }
    PG8_WAIT_V(0);
    if constexpr (!ALIGN_EPI) { if (wr == 0) PG8_BAR; }
    PG8_BAR;
    if constexpr (Epi::AFTER_DRAIN) { E.fused(acc, cur, wr, wc, fr, fq, lds, wid, lane); S.done(cur); }
#undef PG8_SA
#undef PG8_SB
#undef PG8_STAGE
#undef PG8_LDA
#undef PG8_LDB
#undef PG8_MMA
#undef PG8_WAIT_V
#undef PG8_WAIT_L
#undef PG8_BAR
#undef PG8_SCHED
}
}
namespace pg8 {
template <class Epi, class Sched, int MODE, bool ALIGN_EPI = true>
__device__ __forceinline__ void gemm_grouped(PG8_LAS unsigned char* lds, const Gemm g, const Sched& S, const Epi& E) {
    constexpr bool SP2 = true;
    const int tid = threadIdx.x, wid = __builtin_amdgcn_readfirstlane(tid >> 6), lane = tid & 63, wr = wid >> 2, wc = wid & 3, fr = lane & 15, fq = lane >> 4;
    const int K = g.K, nt = K / BK;
    unsigned voffA[2], voffB[2];
#pragma unroll
    for (int i = 0; i < 2; ++i) { int R, C; stage_rc(tid * 16 + i * 8192, R, C); const int Rb = Epi::PERM ? ((R & ~31) + perm32(R & 31)) : R;
        voffA[i] = (unsigned)(R * K + C) * 2u; voffB[i] = (unsigned)(Rb * K + C) * 2u; }
    const size_t kstep = (size_t)(BK * 2);
    const size_t hstep = (size_t)HALF * K * 2;
    const size_t tstep = 2 * hstep;
    const unsigned ldsw = (unsigned)wid * 1024u;
    const int aoff = lds_byte(wr * 64 + fr, fq * 8), boff = lds_byte(wc * 32 + fr, fq * 8);
#define PG8_SA(b, h) (((b) * 2 + (h)) * HTB)
#define PG8_SB(b, h) ((4 + (b) * 2 + (h)) * HTB)
#define PG8_STAGE(bufoff, gbase, voff) do { _Pragma("unroll") for (int _i = 0; _i < 2; ++_i) \
        __builtin_amdgcn_global_load_lds((const unsigned*)((const char*)(gbase) + (voff)[_i]), (PG8_LAS unsigned*)(lds + (bufoff) + ldsw + _i * 8192), 16, 0, 0); } while (0)
#define PG8_STAGE_A(bufoff, kptr, h, nx) do { if (MODE == 0) { unsigned _v[2]; _v[0] = (nx) ? nvA[h][0] : cvA[h][0]; _v[1] = (nx) ? nvA[h][1] : cvA[h][1]; PG8_STAGE(bufoff, kptr, _v); } else { PG8_STAGE(bufoff, (kptr) + (h) * hstep, voffA); } } while (0)
#define PG8_LDA(dst, b, h) do { _Pragma("unroll") for (int m = 0; m < 4; ++m) _Pragma("unroll") for (int k = 0; k < 2; ++k) dst[m][k] = *(const PG8_LAS bf16x8*)(lds + PG8_SA(b, h) + aoff + m * 2048 + k * 1024); } while (0)
#define PG8_LDB(dst, b, h) do { _Pragma("unroll") for (int n = 0; n < 2; ++n) _Pragma("unroll") for (int k = 0; k < 2; ++k) dst[n][k] = *(const PG8_LAS bf16x8*)(lds + PG8_SB(b, h) + boff + n * 2048 + k * 1024); } while (0)
#define PG8_MMA(ai, bj, At, Bt) do { __builtin_amdgcn_s_setprio(1); _Pragma("unroll") for (int m = 0; m < 4; ++m) _Pragma("unroll") for (int n = 0; n < 2; ++n) _Pragma("unroll") for (int k = 0; k < 2; ++k) \
        acc[ai][bj][m][n] = __builtin_amdgcn_mfma_f32_16x16x32_bf16(Bt[n][k], At[m][k], acc[ai][bj][m][n], 0, 0, 0); __builtin_amdgcn_s_setprio(0); } while (0)
#define PG8_WAIT_V(n) asm volatile("s_waitcnt vmcnt(" #n ")" ::: "memory")
#define PG8_WAIT_L(n) asm volatile("s_waitcnt lgkmcnt(" #n ")" ::: "memory")
#define PG8_BAR __builtin_amdgcn_s_barrier()
#define PG8_SCHED __builtin_amdgcn_sched_barrier(0)
    GUnit cur, nxt; int ui = 0;
    if (!S.next(0, cur)) return;
    unsigned cvA[2][2], nvA[2][2];
    if (MODE == 0) S.rows(cur, voffA, cvA);
    f32x4 acc[2][2][4][2];
#pragma unroll
    for (int a = 0; a < 2; ++a)
#pragma unroll
        for (int b = 0; b < 2; ++b)
#pragma unroll
            for (int m = 0; m < 4; ++m)
#pragma unroll
                for (int n = 0; n < 2; ++n) acc[a][b][m][n] = (f32x4){0.f, 0.f, 0.f, 0.f};
    bf16x8 At[4][2], B0[2][2], B1[2][2];
    const size_t estep = (size_t)g.N * K * 2;
    const char* cA = (const char*)g.A + (MODE == 0 ? (size_t)0 : (size_t)cur.pm * tstep); const char* cB = (const char*)g.Bt + (size_t)cur.e * estep + (size_t)cur.pn * tstep;
    S.a_ready(cur);
    if constexpr (SP2) {
        PG8_STAGE(PG8_SB(0, 0), cB, voffB); PG8_STAGE(PG8_SB(0, 1), cB + hstep, voffB); PG8_STAGE_A(PG8_SA(0, 0), cA, 0, false); PG8_STAGE_A(PG8_SA(0, 1), cA, 1, false);
        if (wr == 1) PG8_BAR;
        PG8_WAIT_V(2); PG8_BAR;
        PG8_STAGE(PG8_SB(1, 0), cB + kstep, voffB); PG8_STAGE_A(PG8_SA(1, 0), cA + kstep, 0, false); PG8_STAGE(PG8_SB(1, 1), cB + hstep + kstep, voffB);
        PG8_WAIT_V(6); PG8_BAR;
    } else {
        PG8_STAGE(PG8_SB(0, 0), cB, voffB); PG8_STAGE(PG8_SA(0, 0), cA, voffA); PG8_STAGE(PG8_SB(0, 1), cB + hstep, voffB); PG8_STAGE(PG8_SA(0, 1), cA + hstep, voffA);
        if (wr == 1) PG8_BAR;
        PG8_WAIT_V(4); PG8_BAR;
        PG8_STAGE(PG8_SB(1, 0), cB + kstep, voffB); PG8_STAGE_A(PG8_SA(1, 0), cA + kstep, 0, false); PG8_STAGE(PG8_SB(1, 1), cB + hstep + kstep, voffB);
        PG8_WAIT_V(6); PG8_BAR;
    }
    for (;;) {
        const bool has_next = S.next(ui + 1, nxt);
        const char* nA = (MODE == 0) ? cA : (has_next ? (const char*)g.A + (size_t)nxt.pm * tstep : cA); const char* nB = has_next ? (const char*)g.Bt + (size_t)nxt.e * estep + (size_t)nxt.pn * tstep : cB;
        if (MODE == 0) { if (has_next) S.rows(nxt, voffA, nvA); else { nvA[0][0] = cvA[0][0]; nvA[0][1] = cvA[0][1]; nvA[1][0] = cvA[1][0]; nvA[1][1] = cvA[1][1]; } }
        for (int t = 0; t < nt; t += 2) {
            const bool last = (t == nt - 2);
            const char* a1 = cA + (size_t)(t + 1) * kstep;
            const char* a2 = last ? nA : cA + (size_t)(t + 2) * kstep; const char* b2 = last ? nB : cB + (size_t)(t + 2) * kstep;
            const char* a3 = a2 + kstep; const char* b3 = b2 + kstep;
            if (last && has_next) S.a_ready(nxt);
            if constexpr (SP2) {
            PG8_LDB(B0, 0, 0); PG8_LDB(B1, 0, 1); PG8_SCHED; PG8_LDA(At, 0, 0); PG8_STAGE_A(PG8_SA(1, 1), a1, 1, false);
            PG8_WAIT_V(8); PG8_WAIT_L(0); PG8_BAR; PG8_MMA(0, 0, At, B0); PG8_MMA(0, 1, At, B1); PG8_BAR; PG8_SCHED;
            PG8_LDA(At, 0, 1); PG8_STAGE(PG8_SB(0, 0), b2, voffB); PG8_STAGE(PG8_SB(0, 1), b2 + hstep, voffB); PG8_STAGE_A(PG8_SA(0, 0), a2, 0, last);
            PG8_WAIT_V(8); PG8_WAIT_L(0); PG8_BAR; PG8_MMA(1, 0, At, B0); PG8_MMA(1, 1, At, B1); PG8_BAR; PG8_SCHED;
            PG8_LDB(B0, 1, 0); PG8_LDB(B1, 1, 1); PG8_SCHED; PG8_LDA(At, 1, 0); PG8_STAGE_A(PG8_SA(0, 1), a2, 1, last);
            PG8_WAIT_V(8); PG8_WAIT_L(0); PG8_BAR; PG8_MMA(0, 0, At, B0); PG8_MMA(0, 1, At, B1); PG8_BAR; PG8_SCHED;
            PG8_LDA(At, 1, 1); PG8_STAGE(PG8_SB(1, 0), b3, voffB); PG8_STAGE(PG8_SB(1, 1), b3 + hstep, voffB); PG8_STAGE_A(PG8_SA(1, 0), a3, 0, last);
            PG8_WAIT_V(8); PG8_WAIT_L(0); PG8_BAR; PG8_MMA(1, 0, At, B0); PG8_MMA(1, 1, At, B1); PG8_BAR; PG8_SCHED;
            } else {
            PG8_LDB(B0, 0, 0); PG8_SCHED; PG8_LDA(At, 0, 0); PG8_STAGE_A(PG8_SA(1, 1), a1, 1, false);
            PG8_WAIT_L(8); PG8_BAR; PG8_WAIT_L(0); PG8_MMA(0, 0, At, B0); PG8_BAR; PG8_SCHED;
            PG8_LDB(B1, 0, 1); PG8_STAGE(PG8_SB(0, 0), b2, voffB);
            PG8_BAR; PG8_WAIT_L(0); PG8_MMA(0, 1, At, B1); PG8_BAR;
            PG8_LDA(At, 0, 1); PG8_STAGE_A(PG8_SA(0, 0), a2, 0, last);
            PG8_BAR; PG8_WAIT_L(0); PG8_MMA(1, 0, At, B0); PG8_BAR; PG8_SCHED;
            PG8_STAGE(PG8_SB(0, 1), b2 + hstep, voffB);
            PG8_WAIT_V(6); PG8_BAR; PG8_MMA(1, 1, At, B1); PG8_BAR;
            PG8_LDB(B0, 1, 0); PG8_SCHED; PG8_LDA(At, 1, 0); PG8_STAGE_A(PG8_SA(0, 1), a2, 1, last);
            PG8_WAIT_L(8); PG8_BAR; PG8_WAIT_L(0); PG8_MMA(0, 0, At, B0); PG8_BAR; PG8_SCHED;
            PG8_LDB(B1, 1, 1); PG8_STAGE(PG8_SB(1, 0), b3, voffB);
            PG8_BAR; PG8_WAIT_L(0); PG8_MMA(0, 1, At, B1); PG8_BAR;
            PG8_LDA(At, 1, 1); PG8_STAGE_A(PG8_SA(1, 0), a3, 0, last);
            PG8_BAR; PG8_WAIT_L(0); PG8_MMA(1, 0, At, B0); PG8_BAR; PG8_SCHED;
            PG8_STAGE(PG8_SB(1, 1), b3 + hstep, voffB);
            PG8_WAIT_V(6); PG8_BAR; PG8_MMA(1, 1, At, B1); PG8_BAR;
            }
        }
        if constexpr (ALIGN_EPI) { if (wr == 0) PG8_BAR; }
        if constexpr (!Epi::AFTER_DRAIN) { E(acc, cur, wr, wc, fr, fq); S.done(cur); }
        if (!has_next) break;
#pragma unroll
        for (int a = 0; a < 2; ++a)
#pragma unroll
            for (int b = 0; b < 2; ++b)
#pragma unroll
                for (int m = 0; m < 4; ++m)
#pragma unroll
                    for (int n = 0; n < 2; ++n) acc[a][b][m][n] = (f32x4){0.f, 0.f, 0.f, 0.f};
        cur = nxt; cA = nA; cB = nB; ++ui;
        if (MODE == 0) { cvA[0][0] = nvA[0][0]; cvA[0][1] = nvA[0][1]; cvA[1][0] = nvA[1][0]; cvA[1][1] = nvA[1][1]; }
        if constexpr (ALIGN_EPI) { if (wr == 1) PG8_BAR; }
    }
    PG8_WAIT_V(0);
    if constexpr (!ALIGN_EPI) { if (wr == 0) PG8_BAR; }
    PG8_BAR;
    if constexpr (Epi::AFTER_DRAIN) { E.fused(acc, cur, wr, wc, fr, fq, lds, wid, lane); S.done(cur); }
#undef PG8_SA
#undef PG8_SB
#undef PG8_STAGE
#undef PG8_STAGE_A
#undef PG8_LDA
#undef PG8_LDB
#undef PG8_MMA
#undef PG8_WAIT_V
#undef PG8_WAIT_L
#undef PG8_BAR
#undef PG8_SCHED
}
}
namespace pg8 {
__device__ __forceinline__ float fast_sigmoid(float x) { return __builtin_amdgcn_rcpf(1.f + __expf(-x)); }
__device__ __forceinline__ float fast_gelu_tanh(float x) { const float t = 1.5957691216057308f * (x + 0.044715f * x * x * x); return x * __builtin_amdgcn_rcpf(1.f + __expf(-t)); }
__device__ __forceinline__ u32x4 pack8(const f32x4 a, const f32x4 b) { u32x4 w; w.x = cvt_pk_bf16(a[0], a[1]); w.y = cvt_pk_bf16(a[2], a[3]); w.z = cvt_pk_bf16(b[0], b[1]); w.w = cvt_pk_bf16(b[2], b[3]); return w; }

struct EpiProj {
    static constexpr bool PERM = true, AFTER_DRAIN = false;
    const float* rs1; const float* bg; const float* qg; const float* kg; const float* cosT; const float* sinT;
    bf16_t *QP, *KP, *VB, *LRX, *LRG, *GA, *GL;
    __device__ __forceinline__ void operator()(const f32x4 (&acc)[2][2][4][2], const Unit& u, int wr, int wc, int fr, int fq) const {
        const int type = u.pn >> 2;
        const int rowt = u.pm * BM + wr * 64 + fr;
        const int b = (u.pm * BM) >> 12;
        if (type <= 1) {
            const bool isq = (type == 0);
            const float* gsrc = isq ? qg : kg;
            f32x4 g[2][2];
#pragma unroll
            for (int bj = 0; bj < 2; ++bj)
#pragma unroll
                for (int n = 0; n < 2; ++n) g[bj][n] = *(const f32x4*)(gsrc + 32 * bj + 8 * fq + 4 * n);
            const int hc = (u.pn & 3) * 4 + wc;
            bf16_t* dstbase = (isq ? QP : KP) + ((size_t)(b * 16 + hc) * 4096) * 64 + 8 * fq;
            const float osc = isq ? (0.125f * 1.4426950408889634f) : 1.f;
#pragma unroll
            for (int ai = 0; ai < 2; ++ai)
#pragma unroll
                for (int m = 0; m < 4; ++m) {
                    const int row = rowt + ai * HALF + m * 16; const int pos = row & 4095; const float rsv = rs1[row];
                    f32x4 v[2][2]; float ss = 0.f;
#pragma unroll
                    for (int bj = 0; bj < 2; ++bj)
#pragma unroll
                        for (int n = 0; n < 2; ++n) { v[bj][n] = acc[ai][bj][m][n] * rsv; const f32x4 q = v[bj][n] * v[bj][n]; ss += (q[0] + q[1]) + (q[2] + q[3]); }
                    ss += __shfl_xor(ss, 16); ss += __shfl_xor(ss, 32);
                    const float rn = rsqrtf(ss * (1.f / 64.f) + 1e-6f);
                    f32x4 o0[2], o1[2];
#pragma unroll
                    for (int n = 0; n < 2; ++n) {
                        const f32x4 c = *(const f32x4*)(cosT + pos * 32 + 8 * fq + 4 * n), s = *(const f32x4*)(sinT + pos * 32 + 8 * fq + 4 * n);
                        const f32x4 y0 = v[0][n] * rn * g[0][n], y1 = v[1][n] * rn * g[1][n];
                        o0[n] = (y0 * c - y1 * s) * osc; o1[n] = (y0 * s + y1 * c) * osc;
                    }
                    bf16_t* dst = dstbase + (size_t)pos * 64;
                    *(u32x4*)dst = pack8(o0[0], o0[1]);
                    *(u32x4*)(dst + 32) = pack8(o1[0], o1[1]);
                }
        } else {
            const int colt = (u.pn & 3) * 256 + wc * 32 + 8 * fq;
#pragma unroll
            for (int ai = 0; ai < 2; ++ai)
#pragma unroll
                for (int m = 0; m < 4; ++m) {
                    const int row = rowt + ai * HALF + m * 16; const int pos = row & 4095; const float rsv = rs1[row];
#pragma unroll
                    for (int bj = 0; bj < 2; ++bj) {
                        const int col = colt + 128 * bj;
                        f32x4 v0 = acc[ai][bj][m][0] * rsv, v1 = acc[ai][bj][m][1] * rsv;
                        bf16_t* dst;
                        if (type == 2) { dst = VB + ((size_t)((b * 8 + (col >> 7)) * 4096 + pos)) * 128 + (col & 127); }
                        else if (type == 3) { dst = LRX + (size_t)row * 1024 + col; }
                        else if (type == 4) {
                            dst = LRG + (size_t)row * 1024 + col;
#pragma unroll
                            for (int j = 0; j < 4; ++j) { v0[j] = fast_gelu_tanh(v0[j]); v1[j] = fast_gelu_tanh(v1[j]); }
                        } else {
                            const float* bp = bg + (type == 6 ? 1024 : 0) + col;
                            const f32x4 b0 = *(const f32x4*)bp, b1 = *(const f32x4*)(bp + 4);
                            dst = (type == 5 ? GA : GL) + (size_t)row * 1024 + col;
#pragma unroll
                            for (int j = 0; j < 4; ++j) { v0[j] = fast_sigmoid(v0[j] + b0[j]); v1[j] = fast_sigmoid(v1[j] + b1[j]); }
                        }
                        *(u32x4*)dst = pack8(v0, v1);
                    }
                }
        }
    }
};
__device__ __forceinline__ void unpack8(const u32x4 w, f32x4& a, f32x4& b) {
    a[0] = __uint_as_float(w.x << 16); a[1] = __uint_as_float(w.x & 0xffff0000u); a[2] = __uint_as_float(w.y << 16); a[3] = __uint_as_float(w.y & 0xffff0000u);
    b[0] = __uint_as_float(w.z << 16); b[1] = __uint_as_float(w.z & 0xffff0000u); b[2] = __uint_as_float(w.w << 16); b[3] = __uint_as_float(w.w & 0xffff0000u);
}
template <int PASS> struct EpiMerge {
    static constexpr bool PERM = true, AFTER_DRAIN = false;
    bf16_t* M; const bf16_t* G;
    __device__ __forceinline__ void operator()(const f32x4 (&acc)[2][2][4][2], const Unit& u, int wr, int wc, int fr, int fq) const {
        const int row0 = u.pm * BM + wr * 64 + fr, col0 = u.pn * BM + wc * 32 + 8 * fq;
#pragma unroll
        for (int ai = 0; ai < 2; ++ai)
#pragma unroll
            for (int m = 0; m < 4; ++m)
#pragma unroll
                for (int bj = 0; bj < 2; ++bj) {
                    const size_t idx = (size_t)(row0 + ai * HALF + m * 16) * 1024 + col0 + bj * HALF;
                    f32x4 g0, g1; unpack8(*(const u32x4*)(G + idx), g0, g1);
                    f32x4 v0 = acc[ai][bj][m][0] * g0, v1 = acc[ai][bj][m][1] * g1;
                    if (PASS == 2) { f32x4 t0, t1; unpack8(*(const u32x4*)(M + idx), t0, t1); v0 += t0; v1 += t1; }
                    *(u32x4*)(M + idx) = pack8(v0, v1);
                }
    }
};
struct EpiResid {
    static constexpr bool PERM = false, AFTER_DRAIN = false;
    const float* X; float* O;
    __device__ __forceinline__ void operator()(const f32x4 (&acc)[2][2][4][2], const Unit& u, int wr, int wc, int fr, int fq) const {
        const int row0 = u.pm * BM + wr * 64 + fr, col0 = u.pn * BM + wc * 32 + 4 * fq;
#pragma unroll
        for (int ai = 0; ai < 2; ++ai)
#pragma unroll
            for (int m = 0; m < 4; ++m)
#pragma unroll
                for (int bj = 0; bj < 2; ++bj)
#pragma unroll
                    for (int n = 0; n < 2; ++n) {
                        const size_t idx = (size_t)(row0 + ai * HALF + m * 16) * 1024 + col0 + bj * HALF + n * 16;
                        *(f32x4*)(O + idx) = *(const f32x4*)(X + idx) + acc[ai][bj][m][n];
                    }
    }
};
}

constexpr int NWAVES = 8;
constexpr int RING_OFF = 0, RING_BYTES = 131072;
constexpr int LDSCTL_OFF = RING_BYTES, MISC_OFF = LDSCTL_OFF + 320;
constexpr int LDS_BYTES = 147456;
constexpr size_t WS_CTL = WS_S7, CTL_ZERO_BYTES = 1 * MiB;
constexpr size_t WS_SEL_E = WS_S7 + 1 * MiB, WS_SEL_W = WS_S7 + 2 * MiB;
constexpr size_t WS_RS1 = WS_S7 + 3 * MiB;
constexpr size_t WS_COS = WS_S7 + 3 * MiB + 512 * 1024, WS_SIN = WS_S7 + 4 * MiB;
constexpr size_t WS_WINT = WS_S7 + 5 * MiB;
constexpr size_t WS_WAT = WS_S7 + 19 * MiB, WS_WLT = WS_S7 + 21 * MiB, WS_WOT = WS_S7 + 23 * MiB;
constexpr size_t WS_LRUW = WS_S7 + 25 * MiB;
constexpr size_t WS_LRUS = WS_S7 + 26 * MiB;
constexpr size_t WS_LIST = WS_S7 + 30 * MiB;
constexpr int CW_BAR = 4096, CW_CNT = 8192;

#define GAS __attribute__((address_space(1)))
#define LAS __attribute__((address_space(3)))
typedef unsigned v4u __attribute__((ext_vector_type(4)));
typedef float f32x4 __attribute__((ext_vector_type(4)));
typedef GAS unsigned gu32;
typedef GAS unsigned long long gu64;
#define RLX_AGENT __ATOMIC_RELAXED, __HIP_MEMORY_SCOPE_AGENT
#define LDS_WAIT() asm volatile("s_waitcnt lgkmcnt(0)" ::: "memory")
#define VM_WAIT() asm volatile("s_waitcnt vmcnt(0)" ::: "memory")
__device__ __forceinline__ unsigned pk2(float lo, float hi) { return (unsigned)f2bf(lo) | ((unsigned)f2bf(hi) << 16); }
namespace pg8 {
struct GroupedOrder {
    const PG8_LAS int* tb;
    const int* listT;
    int G, c, nct;
    __device__ __forceinline__ bool next(int i, GUnit& u) const {
        const int L = i * G + c; const int Tn = __builtin_amdgcn_readfirstlane(tb[16]);
        if (L >= Tn * nct) return false;
        const int rt = L / nct; u.pn = L % nct; u.pm = rt;
        int e = 0;
#pragma unroll
        for (int k = 1; k < 16; ++k) e += (rt >= __builtin_amdgcn_readfirstlane(tb[k])) ? 1 : 0;
        u.e = e; u.pos0 = (rt - __builtin_amdgcn_readfirstlane(tb[e])) * 256; u.cnt = __builtin_amdgcn_readfirstlane(tb[32 + e]);
        return true;
    }
    __device__ __forceinline__ void rows(const GUnit& u, const unsigned (&voffA)[2], unsigned (&out)[2][2]) const {
#pragma unroll
        for (int h = 0; h < 2; ++h)
#pragma unroll
            for (int i = 0; i < 2; ++i) {
                const int R = (int)(voffA[i] >> 11) + 128 * h, pos = u.pos0 + R;
                const int tok = (pos < u.cnt) ? (listT[u.e * 16384 + pos] >> 1) : 0;
                out[h][i] = (unsigned)tok * 2048u + (voffA[i] & 2047u);
            }
    }
    __device__ __forceinline__ void a_ready(const GUnit&) const {}
    __device__ __forceinline__ void done(const GUnit&) const {}
};
struct EpiUp {
    static constexpr bool PERM = true, AFTER_DRAIN = false;
    bf16_t* HID; const float* listW;
    __device__ __forceinline__ void operator()(const f32x4 (&acc)[2][2][4][2], const GUnit& u, int wr, int wc, int fr, int fq) const {
        const int f0 = u.pn * 128 + wc * 32 + 8 * fq;
#pragma unroll
        for (int ai = 0; ai < 2; ++ai)
#pragma unroll
            for (int m = 0; m < 4; ++m) {
                const int r = ai * HALF + wr * 64 + m * 16 + fr, pos = u.pos0 + r;
                const float w = (pos < u.cnt) ? listW[u.e * 16384 + pos] : 0.f;
                f32x4 h0, h1;
#pragma unroll
                for (int j = 0; j < 4; ++j) {
                    const float g0 = acc[ai][0][m][0][j], g1 = acc[ai][0][m][1][j];
                    h0[j] = g0 * __builtin_amdgcn_rcpf(1.f + __expf(-g0)) * acc[ai][1][m][0][j] * w;
                    h1[j] = g1 * __builtin_amdgcn_rcpf(1.f + __expf(-g1)) * acc[ai][1][m][1][j] * w;
                }
                *(u32x4*)(HID + (size_t)(u.pm * BM + r) * 512 + f0) = pack8(h0, h1);
            }
    }
};
struct EpiDown {
    static constexpr bool PERM = true, AFTER_DRAIN = false;
    bf16_t* Y0; size_t ystride; const int* listT;
    __device__ __forceinline__ void operator()(const f32x4 (&acc)[2][2][4][2], const GUnit& u, int wr, int wc, int fr, int fq) const {
        const int col0 = u.pn * BM + wc * 32 + 8 * fq;
#pragma unroll
        for (int ai = 0; ai < 2; ++ai)
#pragma unroll
            for (int m = 0; m < 4; ++m) {
                const int r = ai * HALF + wr * 64 + m * 16 + fr, pos = u.pos0 + r;
                if (pos < u.cnt) {
                    const int ent = listT[u.e * 16384 + pos];
                    bf16_t* Y = Y0 + (size_t)(ent & 1) * ystride + (size_t)(ent >> 1) * 1024 + col0;
                    *(u32x4*)Y = pack8(acc[ai][0][m][0], acc[ai][0][m][1]);
                    *(u32x4*)(Y + HALF) = pack8(acc[ai][1][m][0], acc[ai][1][m][1]);
                }
            }
    }
};
}
namespace att {
using bf16x8 = __attribute__((ext_vector_type(8))) short;
using s16x4  = __attribute__((ext_vector_type(4))) short;
using f32x16 = __attribute__((ext_vector_type(16))) float;
using u32x4  = __attribute__((ext_vector_type(4))) unsigned;
constexpr int NW = 8, QBLK = 32, KVBLK = 64;
constexpr int SHM_K = KVBLK * 64 * 2, SHM_V = KVBLK * 128 * 2;
constexpr int LDS_V = 0, LDS_K = 2 * SHM_V, LDS_WS = LDS_K + 2 * SHM_K, LDS_OST = LDS_WS + NW * 256, LDS_END = LDS_OST + NW * 8192;
static_assert(LDS_END <= 131072, "attention LDS");
#define ATT_KSWZ(row, c16) ((row) * 128 + ((((c16) ^ ((row) >> 1)) & 7) << 4))
#define ATT_SBAR() __builtin_amdgcn_sched_barrier(0)
__device__ __forceinline__ int crow(int r, int hi) { return (r & 3) + 8 * (r >> 2) + 4 * hi; }
__device__ __forceinline__ unsigned cvtpk(float lo, float hi) { unsigned r; asm volatile("v_cvt_pk_bf16_f32 %0, %1, %2" : "=v"(r) : "v"(lo), "v"(hi)); return r; }

__device__ __forceinline__ void partialSM(f32x16& p0) {
#pragma unroll
  for (int r = 0; r < 16; ++r) p0[r] = __builtin_amdgcn_exp2f(p0[r]);
}
__device__ __forceinline__ void finishSM(f32x16& p0, f32x16& p1, float& l_reg, bf16x8& pa0, bf16x8& pa1, bf16x8& pa2, bf16x8& pa3) {
#pragma unroll
  for (int r = 0; r < 16; ++r) p1[r] = __builtin_amdgcn_exp2f(p1[r]);
  float ps = 0.f;
#pragma unroll
  for (int r = 0; r < 16; ++r) ps += p0[r];
#pragma unroll
  for (int r = 0; r < 16; ++r) ps += p1[r];
  l_reg += ps;
#define ATT_PK4(P, BASE, OUT) do { unsigned a0 = cvtpk(P[BASE + 0], P[BASE + 1]), a1 = cvtpk(P[BASE + 2], P[BASE + 3]);   \
    unsigned b0 = cvtpk(P[BASE + 4], P[BASE + 5]), b1 = cvtpk(P[BASE + 6], P[BASE + 7]);                              \
    auto r0 = __builtin_amdgcn_permlane32_swap(a0, b0, false, false); auto r1 = __builtin_amdgcn_permlane32_swap(a1, b1, false, false); \
    u32x4 w = {r0[0], r1[0], r0[1], r1[1]}; OUT = *reinterpret_cast<bf16x8*>(&w); } while (0)
  ATT_PK4(p0, 0, pa0); ATT_PK4(p0, 8, pa1); ATT_PK4(p1, 0, pa2); ATT_PK4(p1, 8, pa3);
#undef ATT_PK4
}
__device__ __forceinline__ void qkt(f32x16& p0, f32x16& p1, const char* Ks, const bf16x8* qr, int r32, int hi) {
  p0 = f32x16{}; p1 = f32x16{};
#pragma unroll
  for (int d0 = 0; d0 < 4; ++d0) { const int c16 = d0 * 2 + hi;
    const bf16x8 b0 = *reinterpret_cast<const bf16x8*>(Ks + ATT_KSWZ(r32, c16));
    const bf16x8 b1 = *reinterpret_cast<const bf16x8*>(Ks + ATT_KSWZ(32 + r32, c16));
    p0 = __builtin_amdgcn_mfma_f32_32x32x16_bf16(b0, qr[d0], p0, 0, 0, 0);
    p1 = __builtin_amdgcn_mfma_f32_32x32x16_bf16(b1, qr[d0], p1, 0, 0, 0); }
}
__device__ __forceinline__ int v_st(int k, int c) { const int kk = (k & ~0xC) | ((k & 4) << 1) | ((k & 8) >> 1); return ((kk >> 3) * 4 + (c >> 5)) * 512 + ((kk & 7) * 32 + (c & 31)) * 2; }
__device__ __forceinline__ int v_rd_base(int lane) { return ((lane & 3) << 3) | (((lane >> 2) & 3) << 6) | (((lane >> 4) & 1) << 5) | (((lane >> 5) & 1) << 8); }
constexpr int v_rd_off(int d0, int ks, int half) { return d0 * 512 + ks * 4096 + half * 2048; }
template <int OFF> __device__ __forceinline__ s16x4 tr_read(int vb) {
  s16x4 r; asm volatile("ds_read_b64_tr_b16 %0, %1 offset:%2" : "=&v"(r) : "v"(vb), "i"(OFF) : "memory"); return r;
}
template <int D0> __device__ __forceinline__ void pv_one(f32x16& od, int vb, bf16x8 pa0, bf16x8 pa1, bf16x8 pa2, bf16x8 pa3) {
  const s16x4 l0 = tr_read<v_rd_off(D0, 0, 0)>(vb), h0 = tr_read<v_rd_off(D0, 0, 1)>(vb), l1 = tr_read<v_rd_off(D0, 1, 0)>(vb), h1 = tr_read<v_rd_off(D0, 1, 1)>(vb);
  const s16x4 l2 = tr_read<v_rd_off(D0, 2, 0)>(vb), h2 = tr_read<v_rd_off(D0, 2, 1)>(vb), l3 = tr_read<v_rd_off(D0, 3, 0)>(vb), h3 = tr_read<v_rd_off(D0, 3, 1)>(vb);
  asm volatile("s_waitcnt lgkmcnt(0)" ::: "memory"); ATT_SBAR();
#define ATT_PK(L, H) (bf16x8){L[0], L[1], L[2], L[3], H[0], H[1], H[2], H[3]}
  od = __builtin_amdgcn_mfma_f32_32x32x16_bf16(pa0, ATT_PK(l0, h0), od, 0, 0, 0);
  od = __builtin_amdgcn_mfma_f32_32x32x16_bf16(pa1, ATT_PK(l1, h1), od, 0, 0, 0);
  od = __builtin_amdgcn_mfma_f32_32x32x16_bf16(pa2, ATT_PK(l2, h2), od, 0, 0, 0);
  od = __builtin_amdgcn_mfma_f32_32x32x16_bf16(pa3, ATT_PK(l3, h3), od, 0, 0, 0);
#undef ATT_PK
}
__device__ __forceinline__ void pv_d0(f32x16* o, int vb, bf16x8 pa0, bf16x8 pa1, bf16x8 pa2, bf16x8 pa3) {
  pv_one<0>(o[0], vb, pa0, pa1, pa2, pa3); pv_one<1>(o[1], vb, pa0, pa1, pa2, pa3); pv_one<2>(o[2], vb, pa0, pa1, pa2, pa3); pv_one<3>(o[3], vb, pa0, pa1, pa2, pa3);
}

__device__ __forceinline__ void attn_unit(const bf16_t* __restrict__ Qb, const bf16_t* __restrict__ Kh, const bf16_t* __restrict__ Vh, bf16_t* __restrict__ Ob, char* lds) {
  const int tid = threadIdx.x, wid = tid >> 6, lane = tid & 63, r32 = lane & 31, hi = lane >> 5;
  char* V_lds = lds + LDS_V; char* K_lds = lds + LDS_K;
  float* wsf = (float*)(lds + LDS_WS) + wid * 64;
  float l_reg = 0.f; f32x16 o[4] = {}; bf16x8 qr[4];
  const bf16_t* Qw = Qb + (size_t)(wid * QBLK + r32) * 64 + hi * 8;
#pragma unroll
  for (int d0 = 0; d0 < 4; ++d0) qr[d0] = *reinterpret_cast<const bf16x8*>(Qw + d0 * 16);
  const int kst = ATT_KSWZ(tid >> 3, tid & 7);
  const int vst0 = v_st(tid >> 4, (tid & 15) * 8), vst1 = v_st(32 + (tid >> 4), (tid & 15) * 8);
  const int vb0 = (int)(uintptr_t)V_lds + v_rd_base(lane);
  struct { bf16x8 ks, vs0, vs1; } sr_[1];
#define ATT_SLOAD(i, t) do { sr_[i].ks = *reinterpret_cast<const bf16x8*>(Kh + (size_t)(t) * (KVBLK * 64) + tid * 8); \
    sr_[i].vs0 = *reinterpret_cast<const bf16x8*>(Vh + (size_t)(t) * (KVBLK * 128) + tid * 8); \
    sr_[i].vs1 = *reinterpret_cast<const bf16x8*>(Vh + (size_t)(t) * (KVBLK * 128) + 4096 + tid * 8); } while (0)
#define ATT_SWRITE(b, i) do { *(bf16x8*)(K_lds + (b) * SHM_K + kst) = sr_[i].ks; \
    *(bf16x8*)(V_lds + (b) * SHM_V + vst0) = sr_[i].vs0; *(bf16x8*)(V_lds + (b) * SHM_V + vst1) = sr_[i].vs1; } while (0)
#define ATT_SWAIT() asm volatile("s_waitcnt vmcnt(0)" ::: "memory")
  f32x16 pA0, pA1, pB0, pB1; bf16x8 pa0, pa1, pa2, pa3; constexpr int NT = 4096 / KVBLK;
  constexpr int SE = 0, SO = 0;
  __syncthreads();
  ATT_SLOAD(SE, 0); asm volatile("s_waitcnt vmcnt(0)" ::: "memory"); ATT_SWRITE(0, SE); __syncthreads();
  qkt(pA0, pA1, K_lds, qr, r32, hi); partialSM(pA0);
  ATT_SLOAD(SO, 1);
  ATT_SWAIT(); ATT_SWRITE(1, SO); __syncthreads();
  for (int j = 1; j + 1 < NT; j += 2) {
    ATT_SBAR(); qkt(pB0, pB1, K_lds + SHM_K, qr, r32, hi);
    finishSM(pA0, pA1, l_reg, pa0, pa1, pa2, pa3); ATT_SBAR();
    ATT_SLOAD(SO, j + 1); ATT_SBAR();
    pv_d0(o, vb0, pa0, pa1, pa2, pa3); partialSM(pB0);
    __syncthreads(); ATT_SWAIT(); ATT_SWRITE(0, SE);
    __syncthreads();
    ATT_SBAR(); qkt(pA0, pA1, K_lds, qr, r32, hi);
    finishSM(pB0, pB1, l_reg, pa0, pa1, pa2, pa3); ATT_SBAR();
    ATT_SLOAD(SE, j + 2); ATT_SBAR();
    pv_d0(o, vb0 + SHM_V, pa0, pa1, pa2, pa3); partialSM(pA0);
    __syncthreads(); ATT_SWAIT(); ATT_SWRITE(1, SO);
    __syncthreads();
  }
  ATT_SBAR(); qkt(pB0, pB1, K_lds + SHM_K, qr, r32, hi);
  finishSM(pA0, pA1, l_reg, pa0, pa1, pa2, pa3); ATT_SBAR();
  pv_d0(o, vb0, pa0, pa1, pa2, pa3); partialSM(pB0);
  finishSM(pB0, pB1, l_reg, pa0, pa1, pa2, pa3); ATT_SBAR();
  pv_d0(o, vb0 + SHM_V, pa0, pa1, pa2, pa3);
  { auto rr = __builtin_amdgcn_permlane32_swap(__float_as_uint(l_reg), __float_as_uint(l_reg), false, false); l_reg = __uint_as_float(rr[0]) + __uint_as_float(rr[1]); }
  if (hi == 0) wsf[r32] = l_reg; asm volatile("s_waitcnt lgkmcnt(0)" ::: "memory");
  float rli[16];
#pragma unroll
  for (int r = 0; r < 16; ++r) rli[r] = __builtin_amdgcn_rcpf(wsf[crow(r, hi)]);
  bf16_t* stg = (bf16_t*)(lds + LDS_OST) + wid * 4096;
#pragma unroll
  for (int r = 0; r < 16; ++r) { const int orow = crow(r, hi);
#pragma unroll
    for (int d0 = 0; d0 < 4; ++d0) stg[orow * 128 + d0 * 32 + r32] = f2bf(o[d0][r] * rli[r]); }
  asm volatile("s_waitcnt lgkmcnt(0)" ::: "memory");
  bf16_t* Ow = Ob + (size_t)(wid * QBLK) * 1024;
#pragma unroll
  for (int i = 0; i < 8; ++i) { const int row = i * 4 + (lane >> 4), ch = lane & 15; const u32x4 v = *(const u32x4*)(stg + row * 128 + ch * 8); *(u32x4*)(Ow + (size_t)row * 1024 + ch * 8) = v; }
#undef ATT_SLOAD
#undef ATT_SWRITE
#undef ATT_SWAIT
}
}
namespace lru {
using bf16x8 = __attribute__((ext_vector_type(8))) short;
using f32x16 = __attribute__((ext_vector_type(16))) float;
using u32x4  = __attribute__((ext_vector_type(4))) unsigned;
typedef float f32x4_t __attribute__((ext_vector_type(4)));
constexpr int T = 64, NCH = 4096 / T;
constexpr int LDS_XR = 0, LDS_H = 16384, LDS_CAR = LDS_H + 2 * T * 128 * 4, LDS_CW = LDS_CAR + 2 * 16 * 128 * 4, LDS_END = LDS_CW + 640 * 4;
#define LRU_XSWZ(row, c16) ((row) * 256 + ((((c16) ^ (row)) & 15) << 4))
__device__ __forceinline__ int crow(int r, int hi) { return (r & 3) + 8 * (r >> 2) + 4 * hi; }
__device__ __forceinline__ float fsig(float x) { return __builtin_amdgcn_rcpf(1.f + __expf(-x)); }

template <int DIR, bool APPLY>
__device__ __forceinline__ void scan(f32x16 (&a)[2], f32x16 (&u)[2], float cin, int hi, float& Ptot, float& Hend) {
  float P[2][4], H[2][4], Pp[2][4], Hp[2][4];
#pragma unroll
  for (int rt = 0; rt < 2; ++rt)
#pragma unroll
    for (int q = 0; q < 4; ++q) {
      float p = 1.f, h = 0.f;
#pragma unroll
      for (int ii = 0; ii < 4; ++ii) { const int r = 4 * q + (DIR ? 3 - ii : ii); h = a[rt][r] * h + u[rt][r]; p *= a[rt][r]; }
      P[rt][q] = p; H[rt][q] = h;
      Pp[rt][q] = __shfl_xor(p, 32); Hp[rt][q] = __shfl_xor(h, 32);
    }
  float c = cin, pt = 1.f; float myc[2][4];
  const bool first = (hi == (DIR ? 1 : 0));
#pragma unroll
  for (int gg = 0; gg < 8; ++gg) {
    const int rt = DIR ? 1 - (gg >> 2) : (gg >> 2), q = DIR ? 3 - (gg & 3) : (gg & 3);
    const float Pf = first ? P[rt][q] : Pp[rt][q], Hf = first ? H[rt][q] : Hp[rt][q];
    const float Ps = first ? Pp[rt][q] : P[rt][q], Hs = first ? Hp[rt][q] : H[rt][q];
    const float c0 = c; c = Pf * c + Hf; const float c1 = c; c = Ps * c + Hs; pt *= Pf * Ps;
    myc[rt][q] = first ? c0 : c1;
  }
  Ptot = pt; Hend = c;
  if (APPLY) {
#pragma unroll
    for (int rt = 0; rt < 2; ++rt)
#pragma unroll
      for (int q = 0; q < 4; ++q) {
        float h = myc[rt][q];
#pragma unroll
        for (int ii = 0; ii < 4; ++ii) { const int r = 4 * q + (DIR ? 3 - ii : ii); h = a[rt][r] * h + u[rt][r]; u[rt][r] = h; }
      }
  }
}

struct Params {
  const bf16_t* LRX; const bf16_t* LRG; const bf16_t* Wt; const float* conv_w; const float* conv_b;
  const float* ba; const float* bi; const float* lam; float* SUM; bf16_t* YL;
};

template <int PASS>
__device__ __forceinline__ void lru_phase(const Params& p, char* lds, int vcu, int G) {
  const int tid = threadIdx.x, wid = tid >> 6, lane = tid & 63, r32 = lane & 31, hi = lane >> 5;
  const int dir = wid >> 2, cq = wid & 3;
  const int blk = vcu & 7, idx = vcu >> 3, nper = (NB * NCH) / (G >> 3);
  const int e = cq * 32 + r32, ch = blk * 128 + e;
  const int un0 = idx * nper, b = un0 / NCH, chunk0 = un0 % NCH;
  const size_t rowb = (size_t)b * 4096;
  bf16x8 wb[2][8];
#pragma unroll
  for (int g = 0; g < 2; ++g)
#pragma unroll
    for (int ks = 0; ks < 8; ++ks) wb[g][ks] = *reinterpret_cast<const bf16x8*>(p.Wt + ((size_t)((dir * 2 + g) * 8 + blk) * 128 + e) * 128 + ks * 16 + hi * 8);
  const float bav = p.ba[dir * 1024 + ch], biv = p.bi[dir * 1024 + ch];
  const float c8 = -8.f * log1pf(__expf(-p.lam[dir * 1024 + ch]));
  const int c8i = tid & 15, cc = blk * 128 + c8i * 8, trow = tid >> 4;
  float* CWL = (float*)(lds + LDS_CW);
  float* CAR = (float*)(lds + LDS_CAR);
  __syncthreads();
  for (int q = tid; q < 640; q += 512) CWL[q] = (q < 512) ? p.conv_w[(q >> 7) * 1024 + blk * 128 + (q & 127)] : p.conv_b[blk * 128 + (q & 127)];
  if (PASS == 2 && tid < 256) {
    const int d2 = tid >> 7, e2 = tid & 127; float c = 0.f;
    const float* sp = p.SUM + ((size_t)(b * NCH * 2 + d2) * 1024 + blk * 128 + e2) * 2;
    if (d2 == 0) {
#pragma unroll 8
      for (int j = 0; j < chunk0 + nper; ++j) { const float a_ = sp[(size_t)j * 4096], h_ = sp[(size_t)j * 4096 + 1]; if (j >= chunk0) CAR[(j - chunk0) * 128 + e2] = c; c = a_ * c + h_; }
    } else {
#pragma unroll 8
      for (int j = NCH - 1; j >= chunk0; --j) { const float a_ = sp[(size_t)j * 4096], h_ = sp[(size_t)j * 4096 + 1]; if (j < chunk0 + nper) CAR[(nper + j - chunk0) * 128 + e2] = c; c = a_ * c + h_; }
    }
  }
  bf16x8 xq[2][4];
#define LRU_LOADROWS(t0_) do { _Pragma("unroll") for (int pp = 0; pp < 2; ++pp) _Pragma("unroll") for (int j = 0; j < 4; ++j) { \
      const int ta = (t0_) + trow + 32 * pp - 1 + j; \
      xq[pp][j] = (ta >= 0 && ta < 4096) ? *reinterpret_cast<const bf16x8*>(p.LRX + (rowb + ta) * 1024 + cc) : bf16x8{0, 0, 0, 0, 0, 0, 0, 0}; } } while (0)
  LRU_LOADROWS(chunk0 * T);
  for (int i = 0; i < nper; ++i) {
    const int chunk = chunk0 + i, t0 = chunk * T;
    __syncthreads();
#pragma unroll
    for (int pp = 0; pp < 2; ++pp) {
      f32x4_t a0 = *(const f32x4_t*)(CWL + 512 + c8i * 8), a1 = *(const f32x4_t*)(CWL + 512 + c8i * 8 + 4);
#pragma unroll
      for (int j = 0; j < 4; ++j) {
        f32x4_t x0, x1;
#pragma unroll
        for (int k = 0; k < 4; ++k) { x0[k] = bf2f((bf16_t)xq[pp][j][k]); x1[k] = bf2f((bf16_t)xq[pp][j][4 + k]); }
        a0 += *(const f32x4_t*)(CWL + j * 128 + c8i * 8) * x0; a1 += *(const f32x4_t*)(CWL + j * 128 + c8i * 8 + 4) * x1;
      }
      u32x4 w; w.x = pk2(a0[0], a0[1]); w.y = pk2(a0[2], a0[3]); w.z = pk2(a1[0], a1[1]); w.w = pk2(a1[2], a1[3]);
      *(u32x4*)(lds + LDS_XR + LRU_XSWZ(trow + 32 * pp, c8i)) = w;
    }
    if (i + 1 < nper) LRU_LOADROWS(t0 + T);
    __syncthreads();
    f32x16 aA[2], aI[2];
    aA[0] = f32x16{}; aA[1] = f32x16{}; aI[0] = f32x16{}; aI[1] = f32x16{};
#pragma unroll
    for (int ks = 0; ks < 8; ++ks) {
      const int c16 = ks * 2 + hi;
      const bf16x8 x0 = *reinterpret_cast<const bf16x8*>(lds + LDS_XR + LRU_XSWZ(r32, c16));
      const bf16x8 x1 = *reinterpret_cast<const bf16x8*>(lds + LDS_XR + LRU_XSWZ(32 + r32, c16));
      aA[0] = __builtin_amdgcn_mfma_f32_32x32x16_bf16(x0, wb[0][ks], aA[0], 0, 0, 0);
      aA[1] = __builtin_amdgcn_mfma_f32_32x32x16_bf16(x1, wb[0][ks], aA[1], 0, 0, 0);
      aI[0] = __builtin_amdgcn_mfma_f32_32x32x16_bf16(x0, wb[1][ks], aI[0], 0, 0, 0);
      aI[1] = __builtin_amdgcn_mfma_f32_32x32x16_bf16(x1, wb[1][ks], aI[1], 0, 0, 0);
    }
#pragma unroll
    for (int rt = 0; rt < 2; ++rt)
#pragma unroll
      for (int r = 0; r < 16; ++r) {
        const int t = 32 * rt + crow(r, hi);
        const float xv = bf2f(*(const bf16_t*)(lds + LDS_XR + LRU_XSWZ(t, e >> 3) + (e & 7) * 2));
        const float rg = fsig(aA[rt][r] + bav), ig = fsig(aI[rt][r] + biv);
        const float a = __expf(c8 * rg);
        aA[rt][r] = a; aI[rt][r] = __builtin_amdgcn_sqrtf(1.f - a * a) * ig * xv;
      }
    float Ptot, Hend;
    if (PASS == 1) {
      if (dir == 0) scan<0, false>(aA, aI, 0.f, hi, Ptot, Hend); else scan<1, false>(aA, aI, 0.f, hi, Ptot, Hend);
      if (hi == 0) { float* s = p.SUM + ((size_t)((b * NCH + chunk) * 2 + dir) * 1024 + ch) * 2; s[0] = Ptot; s[1] = Hend; }
    } else {
      const float cin = CAR[(dir * nper + i) * 128 + e];
      if (dir == 0) scan<0, true>(aA, aI, cin, hi, Ptot, Hend); else scan<1, true>(aA, aI, cin, hi, Ptot, Hend);
      float* Hs = (float*)(lds + LDS_H) + dir * (T * 128);
#pragma unroll
      for (int rt = 0; rt < 2; ++rt)
#pragma unroll
        for (int r = 0; r < 16; ++r) Hs[(32 * rt + crow(r, hi)) * 128 + e] = aI[rt][r];
      __syncthreads();
#pragma unroll
      for (int pp = 0; pp < 2; ++pp) {
        const int t = trow + 32 * pp;
        const float* hf = (const float*)(lds + LDS_H) + t * 128 + c8i * 8; const float* hb = hf + T * 128;
        const f32x4_t f0 = *(const f32x4_t*)hf, f1 = *(const f32x4_t*)(hf + 4), b0 = *(const f32x4_t*)hb, b1 = *(const f32x4_t*)(hb + 4);
        const size_t gi = (rowb + t0 + t) * 1024 + cc;
        const bf16x8 gv = *reinterpret_cast<const bf16x8*>(p.LRG + gi);
        u32x4 w;
        w.x = pk2((f0[0] + b0[0]) * bf2f((bf16_t)gv[0]), (f0[1] + b0[1]) * bf2f((bf16_t)gv[1]));
        w.y = pk2((f0[2] + b0[2]) * bf2f((bf16_t)gv[2]), (f0[3] + b0[3]) * bf2f((bf16_t)gv[3]));
        w.z = pk2((f1[0] + b1[0]) * bf2f((bf16_t)gv[4]), (f1[1] + b1[1]) * bf2f((bf16_t)gv[5]));
        w.w = pk2((f1[2] + b1[2]) * bf2f((bf16_t)gv[6]), (f1[3] + b1[3]) * bf2f((bf16_t)gv[7]));
        *(u32x4*)(p.YL + gi) = w;
      }
    }
  }
#undef LRU_LOADROWS
}
}
#define XB_TMO      128
#define XB_XCNT(j)  (256  + 64 * (j))
#define XB_XSUB(j)  (1280 + 64 * (j))
#define XB_XGEN(j)  (2304 + 64 * (j))
#define XB_TOP      3328
#define XB_TOPGEN   3392
#define XCD_BAR_WORDS 3456
#define XB_SPIN_CAP (1u << 18)

__device__ __forceinline__ unsigned xb_ld(unsigned* p)              { return __hip_atomic_load(p, __ATOMIC_RELAXED, __HIP_MEMORY_SCOPE_AGENT); }
__device__ __forceinline__ unsigned xb_add(unsigned* p, unsigned v) { return __hip_atomic_fetch_add(p, v, __ATOMIC_RELAXED, __HIP_MEMORY_SCOPE_AGENT); }
__device__ __forceinline__ unsigned xb_xcc_id() { return (unsigned)__builtin_amdgcn_s_getreg((3 << 11) | 20) & 0xFu; }
#define XB_SPIN(cond, bar) do { unsigned _sp = 0; while (cond) { __builtin_amdgcn_s_sleep(1); \
    if ((++_sp & 255u) == 0u) { if (xb_ld(&(bar)[XB_TMO])) break; if (_sp > XB_SPIN_CAP) { atomicAdd(&(bar)[XB_TMO], 1u); break; } } } } while (0)

struct XcdBarrier {
    unsigned* bar; unsigned x;
    volatile LAS unsigned* st;
};

__device__ __forceinline__ XcdBarrier xcd_barrier_post(unsigned* bar, volatile LAS unsigned* st) {
    XcdBarrier b; b.bar = bar; b.x = xb_xcc_id(); b.st = st;
    if (threadIdx.x == 0) (void)xb_add(&bar[XB_XCNT(b.x)], 1u);
    return b;
}
__device__ __forceinline__ void xcd_barrier_complete(unsigned* bar, unsigned x, unsigned& nloc, unsigned& nx) {
    const unsigned G = gridDim.x * gridDim.y * gridDim.z;
    unsigned sum, cnt, mine, sp = 0u;
    for (;;) {
        sum = 0u; cnt = 0u; mine = 0u;
#pragma unroll
        for (unsigned j = 0; j < 16; ++j) { const unsigned c = xb_ld(&bar[XB_XCNT(j)]); sum += c; cnt += (c > 0u) ? 1u : 0u; mine = (j == x) ? c : mine; }
        if (sum == G) break;
        __builtin_amdgcn_s_sleep(1);
        if ((++sp & 255u) == 0u) { if (xb_ld(&bar[XB_TMO])) break; if (sp > XB_SPIN_CAP) { atomicAdd(&bar[XB_TMO], 1u); break; } }
    }
    nloc = mine > 0u ? mine : 1u; nx = cnt > 0u ? cnt : 1u;
}

__device__ __forceinline__ void xcd_barrier(const XcdBarrier& b) {
    asm volatile("s_waitcnt vmcnt(0)" ::: "memory");
    __syncthreads();
    if (threadIdx.x == 0) {
        unsigned* bar = b.bar;
        __builtin_amdgcn_s_waitcnt(0);
        unsigned nloc = b.st[0], nx = b.st[1];
        if (nloc == 0u) { xcd_barrier_complete(bar, b.x, nloc, nx); b.st[0] = nloc; b.st[1] = nx; }
        const unsigned old = xb_add(&bar[XB_XSUB(b.x)], 1u);
        const unsigned gen = old / nloc;
        if (old + 1u == (gen + 1u) * nloc) {
            __builtin_amdgcn_fence(__ATOMIC_RELEASE, "agent");
            asm volatile("s_waitcnt vmcnt(0)" ::: "memory");
            const unsigned og = xb_add(&bar[XB_TOP], 1u);
            const unsigned tg = og / nx;
            if (og + 1u == (tg + 1u) * nx) xb_add(&bar[XB_TOPGEN], 1u);
            else XB_SPIN(xb_ld(&bar[XB_TOPGEN]) == tg, bar);
            __builtin_amdgcn_fence(__ATOMIC_ACQUIRE, "agent");
            xb_add(&bar[XB_XGEN(b.x)], 1u);
            asm volatile("s_waitcnt vmcnt(0)" ::: "memory");
        } else {
            XB_SPIN(xb_ld(&bar[XB_XGEN(b.x)]) == gen, bar);
            __builtin_amdgcn_fence(__ATOMIC_ACQUIRE, "agent");
            asm volatile("s_waitcnt vmcnt(0)" ::: "memory");
        }
    }
    __syncthreads();
}
struct MkArgs { const float* in[29]; float* out; unsigned char* ws; int ph_lo, ph_hi; };
struct Frame {
    LAS unsigned char* lds;
    volatile LAS unsigned* MISC;
    gu32* ctl;
    int tid, lane, wave;
    int vcu, G;
};

__device__ __forceinline__ void p0_transpose_item(const float* W, int K, int N, bf16_t* WT, LAS float* scr, int item, int lane, const float* kscale, int mode) {
    const int nblk = N / 32, kb = item / nblk, nb = item % nblk, k0 = 64 * kb, n0 = 32 * nb;
#pragma unroll 8
    for (int i = 0; i < 32; ++i) { const int kk = 2 * i + (lane >> 5); float w = W[(size_t)(k0 + kk) * N + n0 + (lane & 31)]; if (kscale) w *= kscale[k0 + kk]; scr[kk * 33 + (lane & 31)] = w; }
    LDS_WAIT(); asm volatile("" ::: "memory");
    const int r0 = (mode == 1 && n0 < 2048) ? ((n0 & ~255) + 128 * ((n0 >> 5) & 1) + 32 * ((n0 >> 6) & 3)) : (mode >= 2) ? (256 * (n0 >> 7) + 128 * (mode - 2) + (n0 & 127)) : n0;
    const int c = lane & 7;
#pragma unroll
    for (int j = 0; j < 4; ++j) { const int n = (lane >> 3) + 8 * j; const LAS float* s = scr + (8 * c) * 33 + n;
        v4u o; o.x = pk2(s[0 * 33], s[1 * 33]); o.y = pk2(s[2 * 33], s[3 * 33]); o.z = pk2(s[4 * 33], s[5 * 33]); o.w = pk2(s[6 * 33], s[7 * 33]);
        *(GAS v4u*)(WT + (size_t)(r0 + n) * K + k0 + 8 * c) = o; }
    LDS_WAIT(); asm volatile("" ::: "memory");
}
__device__ __forceinline__ void p0_row(const float* xrow, bf16_t* orow, float* rs, int lane) {
    const GAS f32x4* xr = (const GAS f32x4*)xrow + lane;
    f32x4 v[4]; float s = 0.f;
#pragma unroll
    for (int j = 0; j < 4; ++j) { v[j] = xr[64 * j]; s += (v[j].x * v[j].x + v[j].y * v[j].y) + (v[j].z * v[j].z + v[j].w * v[j].w); }
    s = wave_sum(s);
    if (lane == 0) *rs = rsqrtf(s * (1.f / 1024.f) + 1e-6f);
    GAS unsigned long long* o8 = (GAS unsigned long long*)orow + lane;
#pragma unroll
    for (int j = 0; j < 4; ++j) o8[64 * j] = (unsigned long long)pk2(v[j].x, v[j].y) | ((unsigned long long)pk2(v[j].z, v[j].w) << 32);
}

__global__ void __launch_bounds__(NWAVES * 64, 2) persist(MkArgs args) {
    extern __shared__ __attribute__((aligned(16))) unsigned char lds[];
    Frame F;
    F.lds = (LAS unsigned char*)lds;
    F.MISC = (volatile LAS unsigned*)(F.lds + MISC_OFF);
    F.tid = threadIdx.x; F.lane = F.tid & 63; F.wave = __builtin_amdgcn_readfirstlane(F.tid >> 6);
    F.G = gridDim.x; { const int bx = blockIdx.x; F.vcu = (F.G % 8 == 0) ? (bx % 8) * (F.G / 8) + bx / 8 : bx; }
    unsigned char* ws = args.ws;
    F.ctl = (gu32*)(ws + WS_CTL);
    for (int u = F.tid; u < (LDS_BYTES - LDSCTL_OFF) / 4; u += NWAVES * 64) ((LAS unsigned*)(F.lds + LDSCTL_OFF))[u] = 0u;
    __syncthreads();
    const int lo = args.ph_lo, hi = args.ph_hi;
    XcdBarrier bar; bar.bar = (unsigned*)(F.ctl + CW_BAR); bar.x = 0; bar.st = nullptr;
    if (hi - lo > 1) bar = xcd_barrier_post((unsigned*)(F.ctl + CW_BAR), F.MISC + 8);
#define IN(k) (lo <= (k) && (k) < hi)
#define BOTH(k) (IN(k) && IN((k) + 1))
#define GRID_BAR() xcd_barrier(bar)

    const float* x = args.in[0];
    bf16_t* XB = (bf16_t*)args.out;
    float* RS1 = (float*)(ws + WS_RS1); float* COST = (float*)(ws + WS_COS); float* SINT = (float*)(ws + WS_SIN);
    bf16_t* WINT = (bf16_t*)(ws + WS_WINT); bf16_t* WAT = (bf16_t*)(ws + WS_WAT); bf16_t* WLT = (bf16_t*)(ws + WS_WLT); bf16_t* WOT = (bf16_t*)(ws + WS_WOT);
    bf16_t* LRUW = (bf16_t*)(ws + WS_LRUW); float* LRUS = (float*)(ws + WS_LRUS);
    bf16_t* QP = (bf16_t*)(ws + WS_S0); bf16_t* KP = (bf16_t*)(ws + WS_S1); bf16_t* VB = (bf16_t*)(ws + WS_S2);
    bf16_t* LRX = (bf16_t*)(ws + WS_S3); bf16_t* LRG = (bf16_t*)(ws + WS_S4); bf16_t* GA = (bf16_t*)(ws + WS_S5); bf16_t* GL = (bf16_t*)(ws + WS_S6);

    if (IN(0)) REPEAT(0) {
        LAS float* scr = (LAS float*)(F.lds + RING_OFF + F.wave * 16384);
        const int gw = F.vcu * NWAVES + F.wave, NGW = F.G * NWAVES;
        constexpr int I_IN = (1024 / 64) * (PROJ / 32), I_SQ = (1024 / 64) * (1024 / 32);
        constexpr int I_LRU = 32 * 8;
        constexpr int NITEMS = I_IN + 3 * I_SQ + I_LRU;
        for (int it = gw; it < NITEMS; it += NGW) {
            int r = it;
            if (r < I_IN) { p0_transpose_item(args.in[2], 1024, PROJ, WINT, scr, r, F.lane, args.in[1], 1); continue; } r -= I_IN;
            if (r < I_SQ) { p0_transpose_item(args.in[11], 1024, 1024, WAT, scr, r, F.lane, nullptr, 0); continue; } r -= I_SQ;
            if (r < I_SQ) { p0_transpose_item(args.in[19], 1024, 1024, WLT, scr, r, F.lane, nullptr, 0); continue; } r -= I_SQ;
            if (r < I_SQ) { p0_transpose_item(args.in[20], 1024, 1024, WOT, scr, r, F.lane, nullptr, 0); continue; } r -= I_SQ;
            { const int mat = r >> 3, gate = mat >> 4, dirblk = mat & 15, dir = dirblk >> 3, blk = dirblk & 7;
              p0_transpose_item((gate ? args.in[16] : args.in[14]) + (size_t)dirblk * 16384, 128, 128, LRUW + (size_t)((dir * 2 + gate) * 8 + blk) * 16384, scr, r & 7, F.lane, nullptr, 0); }
        }
        for (int m = gw; m < NTOK; m += NGW) p0_row(x + (size_t)m * 1024, XB + (size_t)m * 1024, RS1 + m, F.lane);
        {
            for (int e = blockIdx.x * (NWAVES * 64) + F.tid; e < 4096 * 32; e += F.G * NWAVES * 64) {
                const int pos = e >> 5, i = e & 31;
                const float inv_freq = expf(-9.210340371976184f * (float)i * (1.f / 32.f));
                float sn, cs; sincosf((float)pos * inv_freq, &sn, &cs);
                COST[e] = cs; SINT[e] = sn;
            }
        }
    }
    if (BOTH(0)) GRID_BAR();
    if (IN(1)) {
        pg8::Gemm g{XB, WINT, NTOK, PROJ, 1024}; pg8::StaticOrder S; S.init(NTOK, PROJ, F.G, (int)blockIdx.x, PROBE_PHASE == 1 ? 2 : 1);
        pg8::EpiProj E{RS1, args.in[3], args.in[4], args.in[5], COST, SINT, QP, KP, VB, LRX, LRG, GA, GL};
        pg8::gemm_phase<pg8::EpiProj, pg8::StaticOrder, true, true>(F.lds + RING_OFF, g, S, E);
    }
    if (BOTH(1)) GRID_BAR();
    bf16_t* O1N = (bf16_t*)args.out; bf16_t* O2N = O1N + (size_t)NTOK * 1024;
    if (IN(2)) {
        const int per = 1024 / F.G;
        REPEAT(2) for (int i = 0; i < per; ++i) {
            const int unit = F.vcu * per + i;
            const int bhc = unit >> 4, qb = unit & 15, b = bhc >> 4, hc = bhc & 15, h = hc >> 1, c = hc & 1;
            att::attn_unit(QP + ((size_t)bhc * 4096 + qb * 256) * 64, KP + (size_t)bhc * 4096 * 64, VB + ((size_t)(b * 8 + h) * 4096) * 128,
                           (c ? O2N : O1N) + ((size_t)b * 4096 + qb * 256) * 1024 + h * 128, (char*)lds + RING_OFF);
        }
        REPEAT(10) { const lru::Params lp{LRX, LRG, LRUW, args.in[12], args.in[13], args.in[15], args.in[17], args.in[18], LRUS, nullptr};
          lru::lru_phase<1>(lp, (char*)lds + RING_OFF, F.vcu, F.G); }
        if (BOTH(2)) GRID_BAR();
    }
    bf16_t* ON = (bf16_t*)(ws + WS_S0); bf16_t* YL = (bf16_t*)(ws + WS_S1);
    if (IN(3)) REPEAT(3) {
        {
            const float s1 = wave_sum(args.in[6][F.lane] * args.in[7][F.lane]), s2 = wave_sum(args.in[8][F.lane] * args.in[9][F.lane]);
            const float lam = expf(s1) - expf(s2) + 0.2f;
            const float g0 = args.in[10][F.lane] * 0.8f, g1 = args.in[10][64 + F.lane] * 0.8f;
            const int gw = F.vcu * NWAVES + F.wave, NGW = F.G * NWAVES;
            for (int it = gw; it < NTOK * 8; it += NGW) {
                const size_t base = (size_t)it * 128;
                const float a0 = bf2f(O1N[base + F.lane]) - lam * bf2f(O2N[base + F.lane]);
                const float a1 = bf2f(O1N[base + 64 + F.lane]) - lam * bf2f(O2N[base + 64 + F.lane]);
                const float ss = wave_sum(a0 * a0 + a1 * a1);
                const float rs = rsqrtf(ss * (1.f / 128.f) + 1e-6f);
                ON[base + F.lane] = f2bf(a0 * rs * g0); ON[base + 64 + F.lane] = f2bf(a1 * rs * g1);
            }
        }
        { const lru::Params lp{LRX, LRG, LRUW, args.in[12], args.in[13], args.in[15], args.in[17], args.in[18], LRUS, YL};
          lru::lru_phase<2>(lp, (char*)lds + RING_OFF, F.vcu, F.G); }
    }
    if (BOTH(3)) GRID_BAR();
    bf16_t* MERGED = (bf16_t*)(ws + WS_S2);
    if (IN(4)) {
        { pg8::Gemm g{ON, WAT, NTOK, 1024, 1024}; pg8::StaticOrder S; S.init(NTOK, 1024, F.G, (int)blockIdx.x, PROBE_PHASE == 4 ? 2 : 1);
          pg8::EpiMerge<1> E{MERGED, GA};
          pg8::gemm_phase<pg8::EpiMerge<1>, pg8::StaticOrder, false, true>(F.lds + RING_OFF, g, S, E); }
        { pg8::Gemm g{YL, WLT, NTOK, 1024, 1024}; pg8::StaticOrder S; S.init(NTOK, 1024, F.G, (int)blockIdx.x, PROBE_PHASE == 4 ? 2 : 1);
          pg8::EpiMerge<2> E{MERGED, GL};
          pg8::gemm_phase<pg8::EpiMerge<2>, pg8::StaticOrder, false, true>(F.lds + RING_OFF, g, S, E); }
    }
    if (BOTH(4)) GRID_BAR();
    if (IN(5)) {
        pg8::Gemm g{MERGED, WOT, NTOK, 1024, 1024}; pg8::StaticOrder S; S.init(NTOK, 1024, F.G, (int)blockIdx.x, PROBE_PHASE == 5 ? 2 : 1);
        pg8::EpiResid E{x, args.out};
        pg8::gemm_phase<pg8::EpiResid, pg8::StaticOrder, false, true>(F.lds + RING_OFF, g, S, E);
    }
    if (BOTH(5)) GRID_BAR();
    bf16_t* H2 = (bf16_t*)(ws + WS_S0); bf16_t* HID = (bf16_t*)(ws + WS_S3);
    bf16_t* WGU = (bf16_t*)(ws + WS_S5); bf16_t* WDN = (bf16_t*)(ws + WS_S6 + 2 * MiB);
    bf16_t* Y0 = (bf16_t*)(ws + WS_S1); bf16_t* Y1 = (bf16_t*)(ws + WS_S2);
    int* LISTT = (int*)(ws + WS_LIST); float* LISTW = (float*)(ws + WS_LIST + 1 * MiB);
    gu32* GCNT = F.ctl + CW_CNT;
    LAS int* TB = (LAS int*)(F.lds + LDSCTL_OFF + 1024);
    if (IN(6)) {
        const float* x1 = args.out;
        const int tpc = NTOK / F.G, tpw = tpc / NWAVES;
        LAS int* LE = (LAS int*)(F.lds + RING_OFF + 12288); LAS float* LW = (LAS float*)(F.lds + RING_OFF + 12288 + 1024);
        LAS int* LRK = (LAS int*)(F.lds + RING_OFF + 12288 + 2048); LAS int* LCNT = (LAS int*)(F.lds + RING_OFF + 12288 + 3072); LAS int* LBASE = LCNT + 16;
        LAS float* WR = (LAS float*)(F.lds + RING_OFF + 16384);
        __syncthreads();
        if (F.tid < 32) LCNT[F.tid] = 0;
        const float* gain2 = args.in[21]; const float* wg = args.in[22]; const float* bg = args.in[23]; const float* wer = args.in[24]; const float* ber = args.in[25];
        for (int i = F.tid; i < 1024 * 5; i += NWAVES * 64) {
            const int d = i / 5, q = i % 5;
            const f32x4 w4 = (q == 0) ? *(const f32x4*)&wg[d * 4] : *(const f32x4*)&wer[d * 16 + (q - 1) * 4];
            *(LAS f32x4*)&WR[d * 20 + q * 4] = w4;
        }
        __syncthreads();
        for (int k = 0; k < tpw; ++k) {
            const int tl = F.wave * tpw + k; const size_t tok = (size_t)F.vcu * tpc + tl;
            const float* xr = x1 + tok * 1024 + F.lane; const float* gp = gain2 + F.lane; bf16_t* hp = H2 + tok * 1024 + F.lane;
            float v[16]; float ss = 0.f;
#pragma unroll
            for (int j = 0; j < 16; ++j) { v[j] = xr[j * 64]; ss += v[j] * v[j]; }
            ss = wave_sum(ss);
            const float rs = rsqrtf(ss * (1.f / 1024.f) + 1e-6f);
            float lg[20];
#pragma unroll
            for (int q = 0; q < 20; ++q) lg[q] = 0.f;
            const LAS float* wl = WR + F.lane * 20;
#pragma unroll
            for (int j = 0; j < 16; ++j) {
                const float hv = v[j] * rs * gp[j * 64];
                hp[j * 64] = f2bf(hv);
#pragma unroll
                for (int q = 0; q < 5; ++q) { const f32x4 w4 = *(const LAS f32x4*)&wl[j * 64 * 20 + q * 4]; lg[q * 4 + 0] += hv * w4.x; lg[q * 4 + 1] += hv * w4.y; lg[q * 4 + 2] += hv * w4.z; lg[q * 4 + 3] += hv * w4.w; }
            }
#pragma unroll
            for (int q = 0; q < 20; ++q) lg[q] = wave_sum(lg[q]);
            const float gl0 = lg[0] + bg[0], gl1 = lg[1] + bg[1], gl2 = lg[2] + bg[2], gl3 = lg[3] + bg[3];
            int gs = 0; float gm = gl0;
            if (gl1 > gm) { gm = gl1; gs = 1; } if (gl2 > gm) { gm = gl2; gs = 2; } if (gl3 > gm) { gm = gl3; gs = 3; }
            const float gw = 1.f / (expf(gl0 - gm) + expf(gl1 - gm) + expf(gl2 - gm) + expf(gl3 - gm));
            float el[4];
#pragma unroll
            for (int j = 0; j < 4; ++j) { const float s0 = lg[4 + j], s1 = lg[8 + j], s2 = lg[12 + j], s3 = lg[16 + j]; el[j] = (gs == 0 ? s0 : gs == 1 ? s1 : gs == 2 ? s2 : s3) + ber[gs * 4 + j]; }
            int i0 = 0; float v0 = el[0];
            if (el[1] > v0) { v0 = el[1]; i0 = 1; } if (el[2] > v0) { v0 = el[2]; i0 = 2; } if (el[3] > v0) { v0 = el[3]; i0 = 3; }
            int i1 = (i0 == 0) ? 1 : 0; float v1 = -3.0e38f;
#pragma unroll
            for (int j = 0; j < 4; ++j) { if (j != i0 && el[j] > v1) { v1 = el[j]; i1 = j; } }
            const float ex = expf(v1 - v0);
            if (F.lane == 0) { LE[tl * 2] = gs * 4 + i0; LE[tl * 2 + 1] = gs * 4 + i1; LW[tl * 2] = gw / (1.f + ex); LW[tl * 2 + 1] = gw * ex / (1.f + ex); }
        }
        __syncthreads();
        const int npair = tpc * 2;
        int me = 0;
        if (F.tid < npair) { me = LE[F.tid]; LRK[F.tid] = __hip_atomic_fetch_add(&LCNT[me], 1, __ATOMIC_RELAXED, __HIP_MEMORY_SCOPE_WORKGROUP); }
        __syncthreads();
        if (F.tid < 16) LBASE[F.tid] = (int)__hip_atomic_fetch_add(GCNT + F.tid, (unsigned)LCNT[F.tid], RLX_AGENT);
        __syncthreads();
        if (F.tid < npair) { const int pos = LBASE[me] + LRK[F.tid]; LISTT[me * 16384 + pos] = (F.vcu * tpc + (F.tid >> 1)) * 2 + (F.tid & 1); LISTW[me * 16384 + pos] = LW[F.tid]; }
        __syncthreads();
        REPEAT(11) {
            LAS float* scr = (LAS float*)(F.lds + RING_OFF + F.wave * 16384);
            const int gw_ = F.vcu * NWAVES + F.wave, NGW = F.G * NWAVES;
            constexpr int I_GU = (1024 / 64) * (512 / 32), I_DN = (512 / 64) * (1024 / 32);
            for (int it = gw_; it < 16 * (2 * I_GU + I_DN); it += NGW) {
                const int e = it / (2 * I_GU + I_DN); int r = it % (2 * I_GU + I_DN);
                if (r < 2 * I_GU) {
                    const int isup = r >= I_GU; if (isup) r -= I_GU;
                    p0_transpose_item((isup ? args.in[27] : args.in[26]) + (size_t)e * 1024 * 512, 1024, 512, WGU + (size_t)e * 1024 * 1024, scr, r, F.lane, nullptr, 2 + isup);
                } else {
                    p0_transpose_item(args.in[28] + (size_t)e * 512 * 1024, 512, 1024, WDN + (size_t)e * 1024 * 512, scr, r - 2 * I_GU, F.lane, nullptr, 0);
                }
            }
        }
        if (BOTH(6)) GRID_BAR();
    }
    if (IN(7) || IN(8)) {
        __syncthreads();
        if (F.tid < 16) TB[32 + F.tid] = (int)__hip_atomic_load(GCNT + F.tid, RLX_AGENT);
        __syncthreads();
        if (F.tid == 0) { int accn = 0; for (int e = 0; e < 16; ++e) { TB[e] = accn; accn += (TB[32 + e] + 255) >> 8; } TB[16] = accn; }
        __syncthreads();
    }
    if (IN(7)) REPEAT(7) {
        pg8::Gemm g{H2, WGU, 0, 1024, 1024}; pg8::GroupedOrder S{TB, LISTT, F.G, F.vcu, 4};
        pg8::EpiUp E{HID, LISTW};
        pg8::gemm_grouped<pg8::EpiUp, pg8::GroupedOrder, 0, true>(F.lds + RING_OFF, g, S, E);
    }
    if (BOTH(7)) GRID_BAR();
    if (IN(8)) REPEAT(8) {
        pg8::Gemm g{HID, WDN, 0, 1024, 512}; pg8::GroupedOrder S{TB, LISTT, F.G, F.vcu, 4};
        pg8::EpiDown E{Y0, (size_t)(Y1 - Y0), LISTT};
        pg8::gemm_grouped<pg8::EpiDown, pg8::GroupedOrder, 1, true>(F.lds + RING_OFF, g, S, E);
    }
    if (BOTH(8)) GRID_BAR();
    if (IN(9)) {
        typedef unsigned u32x2_t __attribute__((ext_vector_type(2)));
        f32x4* o4 = (f32x4*)args.out; const u32x2_t* a2 = (const u32x2_t*)Y0; const u32x2_t* b2 = (const u32x2_t*)Y1;
        for (size_t i = (size_t)blockIdx.x * (NWAVES * 64) + F.tid; i < (size_t)NTOK * 256; i += (size_t)F.G * NWAVES * 64) {
            f32x4 v = o4[i]; const u32x2_t a = a2[i], b = b2[i];
            v[0] += __uint_as_float(a.x << 16) + __uint_as_float(b.x << 16); v[1] += __uint_as_float(a.x & 0xffff0000u) + __uint_as_float(b.x & 0xffff0000u);
            v[2] += __uint_as_float(a.y << 16) + __uint_as_float(b.y << 16); v[3] += __uint_as_float(a.y & 0xffff0000u) + __uint_as_float(b.y & 0xffff0000u);
            o4[i] = v;
        }
    }
#undef IN
#undef BOTH
}
extern "C" void kernel_launch(void* const* d_in, const int* in_sizes, int n_in, void* d_out, int out_size, void* d_ws, size_t ws_size, hipStream_t stream) {
  static int once = 0;
  if (!once) {
    once = 1;
    if (ws_size < 8 * SLOT || n_in != 29) fprintf(stderr, "kernel_launch: unexpected ws %zu n_in %d\n", ws_size, n_in);
    (void)hipFuncSetAttribute((const void*)persist, hipFuncAttributeMaxDynamicSharedMemorySize, LDS_BYTES);
  }
  char* ws = (char*)d_ws;
  (void)hipMemsetAsync(ws + WS_CTL, 0, CTL_ZERO_BYTES, stream);
  MkArgs a{};
  for (int i = 0; i < 29; ++i) a.in[i] = (const float*)d_in[i];
  a.out = (float*)d_out; a.ws = (unsigned char*)d_ws;
  const int GRID = 256;
  a.ph_lo = 0; a.ph_hi = 10; hipLaunchKernelGGL(persist, dim3(GRID), dim3(NWAVES * 64), LDS_BYTES, stream, a);
}
```

```cpp
#include <hip/hip_runtime.h>
#include <cstdint>
#include <cstdio>

typedef unsigned short bf16_t;
__device__ __forceinline__ float bf2f(bf16_t v) { return __uint_as_float(((unsigned)v) << 16); }
__device__ __forceinline__ bf16_t f2bf(float f) { unsigned u = __float_as_uint(f); return (bf16_t)((u + 0x7fffu + ((u >> 16) & 1u)) >> 16); }
__device__ __forceinline__ float toF(float v) { return v; }
__device__ __forceinline__ float toF(bf16_t v) { return bf2f(v); }

constexpr int NTOK = 16384, DM = 1024, SEQ = 4096, NB = 4, PROJ = 7168;
constexpr size_t MiB = 1u << 20;
constexpr size_t SLOT = 32 * MiB;
constexpr size_t WS_S0 = 0, WS_S1 = SLOT, WS_S2 = 2 * SLOT, WS_S3 = 3 * SLOT, WS_S4 = 4 * SLOT, WS_S5 = 5 * SLOT, WS_S6 = 6 * SLOT, WS_S7 = 7 * SLOT;

__device__ __forceinline__ float wave_sum(float v) {
#pragma unroll
  for (int o = 1; o < 64; o <<= 1) v += __shfl_xor(v, o);
  return v;
}
__device__ __forceinline__ float sigmoidf_(float x) { return 1.f / (1.f + __expf(-x)); }
__device__ __forceinline__ float gelu_tanh(float x) {
  const float k0 = 0.7978845608028654f, k1 = 0.044715f;
  float t = k0 * (x + k1 * x * x * x);
  return 0.5f * x * (1.f + tanhf(t));
}

#ifndef PROBE_PHASE
#define PROBE_PHASE -1
#endif
#define REPEAT(k) for (int _rep = 0; _rep < ((PROBE_PHASE == (k)) ? 2 : 1); ++_rep)
namespace pg8 {
#define PG8_LAS __attribute__((address_space(3)))
typedef unsigned short bf16_t;
typedef short bf16x8 __attribute__((ext_vector_type(8)));
typedef float f32x4 __attribute__((ext_vector_type(4)));
typedef unsigned u32x4 __attribute__((ext_vector_type(4)));
constexpr int BM = 256, BK = 64, HALF = 128, HTB = HALF * BK * 2  , STAGE_BYTES = 8 * HTB, NXCD = 8, WGM = 8;

__host__ __device__ __forceinline__ int lds_byte(int r, int c) { const int st = (r >> 4) * 2 + (c >> 5), rr = r & 15, cc = c & 31, ob = rr * 64 + cc * 2; return st * 1024 + (ob ^ (((ob >> 9) & 1) << 5)); }
__host__ __device__ __forceinline__ void stage_rc(int b, int& R, int& C) { const int st = b / 1024, sb = b % 1024, swz = sb ^ (((sb >> 9) & 1) << 5); R = (st >> 1) * 16 + swz / 64; C = (st & 1) * 32 + (swz % 64) / 2; }
__host__ __device__ __forceinline__ int perm32(int rho) { const int n = rho >> 4, i = rho & 15; return 8 * (i >> 2) + 4 * n + (i & 3); }

struct Unit { int pm, pn; };
struct GUnit { int pm, pn, e, pos0, cnt; };
struct Gemm { const bf16_t* A; const bf16_t* Bt; int M, N, K; };

struct StaticOrder {
    int nM, nN, nwg, G, c, rep;
    __host__ __device__ void init(int M, int N, int G_, int c_, int rep_ = 1) { nM = M / BM; nN = N / BM; nwg = nM * nN; G = G_; c = c_; rep = rep_; }
    __host__ __device__ bool next(int i, Unit& u) const {
        const long L = (long)i * G + c; if (L >= (long)nwg * rep) return false;
        int wgid = (int)(L % nwg); { const int q = nwg / NXCD, r = nwg % NXCD, xcd = wgid % NXCD, off = wgid / NXCD; wgid = (xcd < r ? xcd * (q + 1) : r * (q + 1) + (xcd - r) * q) + off; }
        const int nig = WGM * nN, gid = wgid / nig, fm = gid * WGM, gsz = (nM - fm) < WGM ? (nM - fm) : WGM;
        u.pm = fm + ((wgid % nig) % gsz); u.pn = (wgid % nig) / gsz; return true;
    }
    __device__ __forceinline__ void a_ready(const Unit&) const {}
    __device__ __forceinline__ void done(const Unit&) const {}
};

__device__ __forceinline__ unsigned cvt_pk_bf16(float lo, float hi) { unsigned r; asm volatile("v_cvt_pk_bf16_f32 %0, %1, %2" : "=v"(r) : "v"(lo), "v"(hi)); return r; }
typedef float f32x2 __attribute__((ext_vector_type(2)));
template <class Epi, class Sched, bool ALIGN_EPI = false, bool SP2 = false>
__device__ __forceinline__ void gemm_phase(PG8_LAS unsigned char* lds, const Gemm g, const Sched& S, const Epi& E) {
    const int tid = threadIdx.x, wid = __builtin_amdgcn_readfirstlane(tid >> 6), lane = tid & 63, wr = wid >> 2, wc = wid & 3, fr = lane & 15, fq = lane >> 4;
    const int K = g.K, nt = K / BK;
    unsigned voffA[2], voffB[2];
#pragma unroll
    for (int i = 0; i < 2; ++i) { int R, C; stage_rc(tid * 16 + i * 8192, R, C); const int Rb = Epi::PERM ? ((R & ~31) + perm32(R & 31)) : R;
        voffA[i] = (unsigned)(R * K + C) * 2u; voffB[i] = (unsigned)(Rb * K + C) * 2u; }
    const size_t kstep = (size_t)(BK * 2);
    const size_t hstep = (size_t)HALF * K * 2;
    const size_t tstep = 2 * hstep;
    const unsigned ldsw = (unsigned)wid * 1024u;
    const int aoff = lds_byte(wr * 64 + fr, fq * 8), boff = lds_byte(wc * 32 + fr, fq * 8);
#define PG8_SA(b, h) (((b) * 2 + (h)) * HTB)
#define PG8_SB(b, h) ((4 + (b) * 2 + (h)) * HTB)
#define PG8_STAGE(bufoff, gbase, voff) do { _Pragma("unroll") for (int _i = 0; _i < 2; ++_i) \
        __builtin_amdgcn_global_load_lds((const unsigned*)((const char*)(gbase) + (voff)[_i]), (PG8_LAS unsigned*)(lds + (bufoff) + ldsw + _i * 8192), 16, 0, 0); } while (0)
#define PG8_LDA(dst, b, h) do { _Pragma("unroll") for (int m = 0; m < 4; ++m) _Pragma("unroll") for (int k = 0; k < 2; ++k) dst[m][k] = *(const PG8_LAS bf16x8*)(lds + PG8_SA(b, h) + aoff + m * 2048 + k * 1024); } while (0)
#define PG8_LDB(dst, b, h) do { _Pragma("unroll") for (int n = 0; n < 2; ++n) _Pragma("unroll") for (int k = 0; k < 2; ++k) dst[n][k] = *(const PG8_LAS bf16x8*)(lds + PG8_SB(b, h) + boff + n * 2048 + k * 1024); } while (0)
#define PG8_MMA(ai, bj, At, Bt) do { __builtin_amdgcn_s_setprio(1); _Pragma("unroll") for (int m = 0; m < 4; ++m) _Pragma("unroll") for (int n = 0; n < 2; ++n) _Pragma("unroll") for (int k = 0; k < 2; ++k) \
        acc[ai][bj][m][n] = __builtin_amdgcn_mfma_f32_16x16x32_bf16(Bt[n][k], At[m][k], acc[ai][bj][m][n], 0, 0, 0); __builtin_amdgcn_s_setprio(0); } while (0)
#define PG8_WAIT_V(n) asm volatile("s_waitcnt vmcnt(" #n ")" ::: "memory")
#define PG8_WAIT_L(n) asm volatile("s_waitcnt lgkmcnt(" #n ")" ::: "memory")
#define PG8_BAR __builtin_amdgcn_s_barrier()
#define PG8_SCHED __builtin_amdgcn_sched_barrier(0)
    Unit cur, nxt; int ui = 0;
    if (!S.next(0, cur)) return;
    f32x4 acc[2][2][4][2];
#pragma unroll
    for (int a = 0; a < 2; ++a)
#pragma unroll
        for (int b = 0; b < 2; ++b)
#pragma unroll
            for (int m = 0; m < 4; ++m)
#pragma unroll
                for (int n = 0; n < 2; ++n) acc[a][b][m][n] = (f32x4){0.f, 0.f, 0.f, 0.f};
    bf16x8 At[4][2], B0[2][2], B1[2][2];
    const char* cA = (const char*)g.A + (size_t)cur.pm * tstep; const char* cB = (const char*)g.Bt + (size_t)cur.pn * tstep;
    S.a_ready(cur);
    if constexpr (SP2) {
        PG8_STAGE(PG8_SB(0, 0), cB, voffB); PG8_STAGE(PG8_SB(0, 1), cB + hstep, voffB); PG8_STAGE(PG8_SA(0, 0), cA, voffA); PG8_STAGE(PG8_SA(0, 1), cA + hstep, voffA);
        if (wr == 1) PG8_BAR;
        PG8_WAIT_V(2); PG8_BAR;
        PG8_STAGE(PG8_SB(1, 0), cB + kstep, voffB); PG8_STAGE(PG8_SA(1, 0), cA + kstep, voffA); PG8_STAGE(PG8_SB(1, 1), cB + hstep + kstep, voffB);
        PG8_WAIT_V(6); PG8_BAR;
    } else {
        PG8_STAGE(PG8_SB(0, 0), cB, voffB); PG8_STAGE(PG8_SA(0, 0), cA, voffA); PG8_STAGE(PG8_SB(0, 1), cB + hstep, voffB); PG8_STAGE(PG8_SA(0, 1), cA + hstep, voffA);
        if (wr == 1) PG8_BAR;
        PG8_WAIT_V(4); PG8_BAR;
        PG8_STAGE(PG8_SB(1, 0), cB + kstep, voffB); PG8_STAGE(PG8_SA(1, 0), cA + kstep, voffA); PG8_STAGE(PG8_SB(1, 1), cB + hstep + kstep, voffB);
        PG8_WAIT_V(6); PG8_BAR;
    }
    for (;;) {
        const bool has_next = S.next(ui + 1, nxt);
        const char* nA = has_next ? (const char*)g.A + (size_t)nxt.pm * tstep : cA; const char* nB = has_next ? (const char*)g.Bt + (size_t)nxt.pn * tstep : cB;
        for (int t = 0; t < nt; t += 2) {
            const bool last = (t == nt - 2);
            const char* a1 = cA + (size_t)(t + 1) * kstep;
            const char* a2 = last ? nA : cA + (size_t)(t + 2) * kstep; const char* b2 = last ? nB : cB + (size_t)(t + 2) * kstep;
            const char* a3 = a2 + kstep; const char* b3 = b2 + kstep;
            if (last && has_next) S.a_ready(nxt);
            if constexpr (SP2) {
            PG8_LDB(B0, 0, 0); PG8_LDB(B1, 0, 1); PG8_SCHED; PG8_LDA(At, 0, 0); PG8_STAGE(PG8_SA(1, 1), a1 + hstep, voffA);
            PG8_WAIT_V(8); PG8_WAIT_L(0); PG8_BAR; PG8_MMA(0, 0, At, B0); PG8_MMA(0, 1, At, B1); PG8_BAR; PG8_SCHED;
            PG8_LDA(At, 0, 1); PG8_STAGE(PG8_SB(0, 0), b2, voffB); PG8_STAGE(PG8_SB(0, 1), b2 + hstep, voffB); PG8_STAGE(PG8_SA(0, 0), a2, voffA);
            PG8_WAIT_V(8); PG8_WAIT_L(0); PG8_BAR; PG8_MMA(1, 0, At, B0); PG8_MMA(1, 1, At, B1); PG8_BAR; PG8_SCHED;
            PG8_LDB(B0, 1, 0); PG8_LDB(B1, 1, 1); PG8_SCHED; PG8_LDA(At, 1, 0); PG8_STAGE(PG8_SA(0, 1), a2 + hstep, voffA);
            PG8_WAIT_V(8); PG8_WAIT_L(0); PG8_BAR; PG8_MMA(0, 0, At, B0); PG8_MMA(0, 1, At, B1); PG8_BAR; PG8_SCHED;
            PG8_LDA(At, 1, 1); PG8_STAGE(PG8_SB(1, 0), b3, voffB); PG8_STAGE(PG8_SB(1, 1), b3 + hstep, voffB); PG8_STAGE(PG8_SA(1, 0), a3, voffA);
            PG8_WAIT_V(8); PG8_WAIT_L(0); PG8_BAR; PG8_MMA(1, 0, At, B0); PG8_MMA(1, 1, At, B1); PG8_BAR; PG8_SCHED;
            } else {
            PG8_LDB(B0, 0, 0); PG8_SCHED; PG8_LDA(At, 0, 0); PG8_STAGE(PG8_SA(1, 1), a1 + hstep, voffA);
            PG8_WAIT_L(8); PG8_BAR; PG8_WAIT_L(0); PG8_MMA(0, 0, At, B0); PG8_BAR; PG8_SCHED;
            PG8_LDB(B1, 0, 1); PG8_STAGE(PG8_SB(0, 0), b2, voffB);
            PG8_BAR; PG8_WAIT_L(0); PG8_MMA(0, 1, At, B1); PG8_BAR;
            PG8_LDA(At, 0, 1); PG8_STAGE(PG8_SA(0, 0), a2, voffA);
            PG8_BAR; PG8_WAIT_L(0); PG8_MMA(1, 0, At, B0); PG8_BAR; PG8_SCHED;
            PG8_STAGE(PG8_SB(0, 1), b2 + hstep, voffB);
            PG8_WAIT_V(6); PG8_BAR; PG8_MMA(1, 1, At, B1); PG8_BAR;
            PG8_LDB(B0, 1, 0); PG8_SCHED; PG8_LDA(At, 1, 0); PG8_STAGE(PG8_SA(0, 1), a2 + hstep, voffA);
            PG8_WAIT_L(8); PG8_BAR; PG8_WAIT_L(0); PG8_MMA(0, 0, At, B0); PG8_BAR; PG8_SCHED;
            PG8_LDB(B1, 1, 1); PG8_STAGE(PG8_SB(1, 0), b3, voffB);
            PG8_BAR; PG8_WAIT_L(0); PG8_MMA(0, 1, At, B1); PG8_BAR;
            PG8_LDA(At, 1, 1); PG8_STAGE(PG8_SA(1, 0), a3, voffA);
            PG8_BAR; PG8_WAIT_L(0); PG8_MMA(1, 0, At, B0); PG8_BAR; PG8_SCHED;
            PG8_STAGE(PG8_SB(1, 1), b3 + hstep, voffB);
            PG8_WAIT_V(6); PG8_BAR; PG8_MMA(1, 1, At, B1); PG8_BAR;
            }
        }
        if constexpr (ALIGN_EPI) { if (wr == 0) PG8_BAR; }
        if constexpr (!Epi::AFTER_DRAIN) { E(acc, cur, wr, wc, fr, fq); S.done(cur); }
        if (!has_next) break;
#pragma unroll
        for (int a = 0; a < 2; ++a)
#pragma unroll
            for (int b = 0; b < 2; ++b)
#pragma unroll
                for (int m = 0; m < 4; ++m)
#pragma unroll
                    for (int n = 0; n < 2; ++n) acc[a][b][m][n] = (f32x4){0.f, 0.f, 0.f, 0.f};
        cur = nxt; cA = nA; cB = nB; ++ui;
        if constexpr (ALIGN_EPI) { if (wr == 1) PG8_BAR; }
    }
    PG8_WAIT_V(0);
    if constexpr (!ALIGN_EPI) { if (wr == 0) PG8_BAR; }
    PG8_BAR;
    if constexpr (Epi::AFTER_DRAIN) { E.fused(acc, cur, wr, wc, fr, fq, lds, wid, lane); S.done(cur); }
#undef PG8_SA
#undef PG8_SB
#undef PG8_STAGE
#undef PG8_LDA
#undef PG8_LDB
#undef PG8_MMA
#undef PG8_WAIT_V
#undef PG8_WAIT_L
#undef PG8_BAR
#undef PG8_SCHED
}
}
namespace pg8 {
template <class Epi, class Sched, int MODE, bool ALIGN_EPI = true>
__device__ __forceinline__ void gemm_grouped(PG8_LAS unsigned char* lds, const Gemm g, const Sched& S, const Epi& E) {
    constexpr bool SP2 = true;
    const int tid = threadIdx.x, wid = __builtin_amdgcn_readfirstlane(tid >> 6), lane = tid & 63, wr = wid >> 2, wc = wid & 3, fr = lane & 15, fq = lane >> 4;
    const int K = g.K, nt = K / BK;
    unsigned voffA[2], voffB[2];
#pragma unroll
    for (int i = 0; i < 2; ++i) { int R, C; stage_rc(tid * 16 + i * 8192, R, C); const int Rb = Epi::PERM ? ((R & ~31) + perm32(R & 31)) : R;
        voffA[i] = (unsigned)(R * K + C) * 2u; voffB[i] = (unsigned)(Rb * K + C) * 2u; }
    const size_t kstep = (size_t)(BK * 2);
    const size_t hstep = (size_t)HALF * K * 2;
    const size_t tstep = 2 * hstep;
    const unsigned ldsw = (unsigned)wid * 1024u;
    const int aoff = lds_byte(wr * 64 + fr, fq * 8), boff = lds_byte(wc * 32 + fr, fq * 8);
#define PG8_SA(b, h) (((b) * 2 + (h)) * HTB)
#define PG8_SB(b, h) ((4 + (b) * 2 + (h)) * HTB)
#define PG8_STAGE(bufoff, gbase, voff) do { _Pragma("unroll") for (int _i = 0; _i < 2; ++_i) \
        __builtin_amdgcn_global_load_lds((const unsigned*)((const char*)(gbase) + (voff)[_i]), (PG8_LAS unsigned*)(lds + (bufoff) + ldsw + _i * 8192), 16, 0, 0); } while (0)
#define PG8_STAGE_A(bufoff, kptr, h, nx) do { if (MODE == 0) { unsigned _v[2]; _v[0] = (nx) ? nvA[h][0] : cvA[h][0]; _v[1] = (nx) ? nvA[h][1] : cvA[h][1]; PG8_STAGE(bufoff, kptr, _v); } else { PG8_STAGE(bufoff, (kptr) + (h) * hstep, voffA); } } while (0)
#define PG8_LDA(dst, b, h) do { _Pragma("unroll") for (int m = 0; m < 4; ++m) _Pragma("unroll") for (int k = 0; k < 2; ++k) dst[m][k] = *(const PG8_LAS bf16x8*)(lds + PG8_SA(b, h) + aoff + m * 2048 + k * 1024); } while (0)
#define PG8_LDB(dst, b, h) do { _Pragma("unroll") for (int n = 0; n < 2; ++n) _Pragma("unroll") for (int k = 0; k < 2; ++k) dst[n][k] = *(const PG8_LAS bf16x8*)(lds + PG8_SB(b, h) + boff + n * 2048 + k * 1024); } while (0)
#define PG8_MMA(ai, bj, At, Bt) do { __builtin_amdgcn_s_setprio(1); _Pragma("unroll") for (int m = 0; m < 4; ++m) _Pragma("unroll") for (int n = 0; n < 2; ++n) _Pragma("unroll") for (int k = 0; k < 2; ++k) \
        acc[ai][bj][m][n] = __builtin_amdgcn_mfma_f32_16x16x32_bf16(Bt[n][k], At[m][k], acc[ai][bj][m][n], 0, 0, 0); __builtin_amdgcn_s_setprio(0); } while (0)
#define PG8_WAIT_V(n) asm volatile("s_waitcnt vmcnt(" #n ")" ::: "memory")
#define PG8_WAIT_L(n) asm volatile("s_waitcnt lgkmcnt(" #n ")" ::: "memory")
#define PG8_BAR __builtin_amdgcn_s_barrier()
#define PG8_SCHED __builtin_amdgcn_sched_barrier(0)
    GUnit cur, nxt; int ui = 0;
    if (!S.next(0, cur)) return;
    unsigned cvA[2][2], nvA[2][2];
    if (MODE == 0) S.rows(cur, voffA, cvA);
    f32x4 acc[2][2][4][2];
#pragma unroll
    for (int a = 0; a < 2; ++a)
#pragma unroll
        for (int b = 0; b < 2; ++b)
#pragma unroll
            for (int m = 0; m < 4; ++m)
#pragma unroll
                for (int n = 0; n < 2; ++n) acc[a][b][m][n] = (f32x4){0.f, 0.f, 0.f, 0.f};
    bf16x8 At[4][2], B0[2][2], B1[2][2];
    const size_t estep = (size_t)g.N * K * 2;
    const char* cA = (const char*)g.A + (MODE == 0 ? (size_t)0 : (size_t)cur.pm * tstep); const char* cB = (const char*)g.Bt + (size_t)cur.e * estep + (size_t)cur.pn * tstep;
    S.a_ready(cur);
    if constexpr (SP2) {
        PG8_STAGE(PG8_SB(0, 0), cB, voffB); PG8_STAGE(PG8_SB(0, 1), cB + hstep, voffB); PG8_STAGE_A(PG8_SA(0, 0), cA, 0, false); PG8_STAGE_A(PG8_SA(0, 1), cA, 1, false);
        if (wr == 1) PG8_BAR;
        PG8_WAIT_V(2); PG8_BAR;
        PG8_STAGE(PG8_SB(1, 0), cB + kstep, voffB); PG8_STAGE_A(PG8_SA(1, 0), cA + kstep, 0, false); PG8_STAGE(PG8_SB(1, 1), cB + hstep + kstep, voffB);
        PG8_WAIT_V(6); PG8_BAR;
    } else {
        PG8_STAGE(PG8_SB(0, 0), cB, voffB); PG8_STAGE(PG8_SA(0, 0), cA, voffA); PG8_STAGE(PG8_SB(0, 1), cB + hstep, voffB); PG8_STAGE(PG8_SA(0, 1), cA + hstep, voffA);
        if (wr == 1) PG8_BAR;
        PG8_WAIT_V(4); PG8_BAR;
        PG8_STAGE(PG8_SB(1, 0), cB + kstep, voffB); PG8_STAGE_A(PG8_SA(1, 0), cA + kstep, 0, false); PG8_STAGE(PG8_SB(1, 1), cB + hstep + kstep, voffB);
        PG8_WAIT_V(6); PG8_BAR;
    }
    for (;;) {
        const bool has_next = S.next(ui + 1, nxt);
        const char* nA = (MODE == 0) ? cA : (has_next ? (const char*)g.A + (size_t)nxt.pm * tstep : cA); const char* nB = has_next ? (const char*)g.Bt + (size_t)nxt.e * estep + (size_t)nxt.pn * tstep : cB;
        if (MODE == 0) { if (has_next) S.rows(nxt, voffA, nvA); else { nvA[0][0] = cvA[0][0]; nvA[0][1] = cvA[0][1]; nvA[1][0] = cvA[1][0]; nvA[1][1] = cvA[1][1]; } }
        for (int t = 0; t < nt; t += 2) {
            const bool last = (t == nt - 2);
            const char* a1 = cA + (size_t)(t + 1) * kstep;
            const char* a2 = last ? nA : cA + (size_t)(t + 2) * kstep; const char* b2 = last ? nB : cB + (size_t)(t + 2) * kstep;
            const char* a3 = a2 + kstep; const char* b3 = b2 + kstep;
            if (last && has_next) S.a_ready(nxt);
            if constexpr (SP2) {
            PG8_LDB(B0, 0, 0); PG8_LDB(B1, 0, 1); PG8_SCHED; PG8_LDA(At, 0, 0); PG8_STAGE_A(PG8_SA(1, 1), a1, 1, false);
            PG8_WAIT_V(8); PG8_WAIT_L(0); PG8_BAR; PG8_MMA(0, 0, At, B0); PG8_MMA(0, 1, At, B1); PG8_BAR; PG8_SCHED;
            PG8_LDA(At, 0, 1); PG8_STAGE(PG8_SB(0, 0), b2, voffB); PG8_STAGE(PG8_SB(0, 1), b2 + hstep, voffB); PG8_STAGE_A(PG8_SA(0, 0), a2, 0, last);
            PG8_WAIT_V(8); PG8_WAIT_L(0); PG8_BAR; PG8_MMA(1, 0, At, B0); PG8_MMA(1, 1, At, B1); PG8_BAR; PG8_SCHED;
            PG8_LDB(B0, 1, 0); PG8_LDB(B1, 1, 1); PG8_SCHED; PG8_LDA(At, 1, 0); PG8_STAGE_A(PG8_SA(0, 1), a2, 1, last);
            PG8_WAIT_V(8); PG8_WAIT_L(0); PG8_BAR; PG8_MMA(0, 0, At, B0); PG8_MMA(0, 1, At, B1); PG8_BAR; PG8_SCHED;
            PG8_LDA(At, 1, 1); PG8_STAGE(PG8_SB(1, 0), b3, voffB); PG8_STAGE(PG8_SB(1, 1), b3 + hstep, voffB); PG8_STAGE_A(PG8_SA(1, 0), a3, 0, last);
            PG8_WAIT_V(8); PG8_WAIT_L(0); PG8_BAR; PG8_MMA(1, 0, At, B0); PG8_MMA(1, 1, At, B1); PG8_BAR; PG8_SCHED;
            } else {
            PG8_LDB(B0, 0, 0); PG8_SCHED; PG8_LDA(At, 0, 0); PG8_STAGE_A(PG8_SA(1, 1), a1, 1, false);
            PG8_WAIT_L(8); PG8_BAR; PG8_WAIT_L(0); PG8_MMA(0, 0, At, B0); PG8_BAR; PG8_SCHED;
            PG8_LDB(B1, 0, 1); PG8_STAGE(PG8_SB(0, 0), b2, voffB);
            PG8_BAR; PG8_WAIT_L(0); PG8_MMA(0, 1, At, B1); PG8_BAR;
            PG8_LDA(At, 0, 1); PG8_STAGE_A(PG8_SA(0, 0), a2, 0, last);
            PG8_BAR; PG8_WAIT_L(0); PG8_MMA(1, 0, At, B0); PG8_BAR; PG8_SCHED;
            PG8_STAGE(PG8_SB(0, 1), b2 + hstep, voffB);
            PG8_WAIT_V(6); PG8_BAR; PG8_MMA(1, 1, At, B1); PG8_BAR;
            PG8_LDB(B0, 1, 0); PG8_SCHED; PG8_LDA(At, 1, 0); PG8_STAGE_A(PG8_SA(0, 1), a2, 1, last);
            PG8_WAIT_L(8); PG8_BAR; PG8_WAIT_L(0); PG8_MMA(0, 0, At, B0); PG8_BAR; PG8_SCHED;
            PG8_LDB(B1, 1, 1); PG8_STAGE(PG8_SB(1, 0), b3, voffB);
            PG8_BAR; PG8_WAIT_L(0); PG8_MMA(0, 1, At, B1); PG8_BAR;
            PG8_LDA(At, 1, 1); PG8_STAGE_A(PG8_SA(1, 0), a3, 0, last);
            PG8_BAR; PG8_WAIT_L(0); PG8_MMA(1, 0, At, B0); PG8_BAR; PG8_SCHED;
            PG8_STAGE(PG8_SB(1, 1), b3 + hstep, voffB);
            PG8_WAIT_V(6); PG8_BAR; PG8_MMA(1, 1, At, B1); PG8_BAR;
            }
        }
        if constexpr (ALIGN_EPI) { if (wr == 0) PG8_BAR; }
        if constexpr (!Epi::AFTER_DRAIN) { E(acc, cur, wr, wc, fr, fq); S.done(cur); }
        if (!has_next) break;
#pragma unroll
        for (int a = 0; a < 2; ++a)
#pragma unroll
            for (int b = 0; b < 2; ++b)
#pragma unroll
                for (int m = 0; m < 4; ++m)
#pragma unroll
                    for (int n = 0; n < 2; ++n) acc[a][b][m][n] = (f32x4){0.f, 0.f, 0.f, 0.f};
        cur = nxt; cA = nA; cB = nB; ++ui;
        if (MODE == 0) { cvA[0][0] = nvA[0][0]; cvA[0][1] = nvA[0][1]; cvA[1][0] = nvA[1][0]; cvA[1][1] = nvA[1][1]; }
        if constexpr (ALIGN_EPI) { if (wr == 1) PG8_BAR; }
    }
    PG8_WAIT_V(0);
    if constexpr (!ALIGN_EPI) { if (wr == 0) PG8_BAR; }
    PG8_BAR;
    if constexpr (Epi::AFTER_DRAIN) { E.fused(acc, cur, wr, wc, fr, fq, lds, wid, lane); S.done(cur); }
#undef PG8_SA
#undef PG8_SB
#undef PG8_STAGE
#undef PG8_STAGE_A
#undef PG8_LDA
#undef PG8_LDB
#undef PG8_MMA
#undef PG8_WAIT_V
#undef PG8_WAIT_L
#undef PG8_BAR
#undef PG8_SCHED
}
}
namespace pg8 {
__device__ __forceinline__ float fast_sigmoid(float x) { return __builtin_amdgcn_rcpf(1.f + __expf(-x)); }
__device__ __forceinline__ float fast_gelu_tanh(float x) { const float t = 1.5957691216057308f * (x + 0.044715f * x * x * x); return x * __builtin_amdgcn_rcpf(1.f + __expf(-t)); }
__device__ __forceinline__ u32x4 pack8(const f32x4 a, const f32x4 b) { u32x4 w; w.x = cvt_pk_bf16(a[0], a[1]); w.y = cvt_pk_bf16(a[2], a[3]); w.z = cvt_pk_bf16(b[0], b[1]); w.w = cvt_pk_bf16(b[2], b[3]); return w; }

struct EpiProj {
    static constexpr bool PERM = true, AFTER_DRAIN = false;
    const float* rs1; const float* bg; const float* qg; const float* kg; const float* cosT; const float* sinT;
    bf16_t *QP, *KP, *VB, *LRX, *LRG, *GA, *GL;
    __device__ __forceinline__ void operator()(const f32x4 (&acc)[2][2][4][2], const Unit& u, int wr, int wc, int fr, int fq) const {
        const int type = u.pn >> 2;
        const int rowt = u.pm * BM + wr * 64 + fr;
        const int b = (u.pm * BM) >> 12;
        if (type <= 1) {
            const bool isq = (type == 0);
            const float* gsrc = isq ? qg : kg;
            f32x4 g[2][2];
#pragma unroll
            for (int bj = 0; bj < 2; ++bj)
#pragma unroll
                for (int n = 0; n < 2; ++n) g[bj][n] = *(const f32x4*)(gsrc + 32 * bj + 8 * fq + 4 * n);
            const int hc = (u.pn & 3) * 4 + wc;
            bf16_t* dstbase = (isq ? QP : KP) + ((size_t)(b * 16 + hc) * 4096) * 64 + 8 * fq;
            const float osc = isq ? (0.125f * 1.4426950408889634f) : 1.f;
#pragma unroll
            for (int ai = 0; ai < 2; ++ai)
#pragma unroll
                for (int m = 0; m < 4; ++m) {
                    const int row = rowt + ai * HALF + m * 16; const int pos = row & 4095; const float rsv = rs1[row];
                    f32x4 v[2][2]; float ss = 0.f;
#pragma unroll
                    for (int bj = 0; bj < 2; ++bj)
#pragma unroll
                        for (int n = 0; n < 2; ++n) { v[bj][n] = acc[ai][bj][m][n] * rsv; const f32x4 q = v[bj][n] * v[bj][n]; ss += (q[0] + q[1]) + (q[2] + q[3]); }
                    ss += __shfl_xor(ss, 16); ss += __shfl_xor(ss, 32);
                    const float rn = rsqrtf(ss * (1.f / 64.f) + 1e-6f);
                    f32x4 o0[2], o1[2];
#pragma unroll
                    for (int n = 0; n < 2; ++n) {
                        const f32x4 c = *(const f32x4*)(cosT + pos * 32 + 8 * fq + 4 * n), s = *(const f32x4*)(sinT + pos * 32 + 8 * fq + 4 * n);
                        const f32x4 y0 = v[0][n] * rn * g[0][n], y1 = v[1][n] * rn * g[1][n];
                        o0[n] = (y0 * c - y1 * s) * osc; o1[n] = (y0 * s + y1 * c) * osc;
                    }
                    bf16_t* dst = dstbase + (size_t)pos * 64;
                    *(u32x4*)dst = pack8(o0[0], o0[1]);
                    *(u32x4*)(dst + 32) = pack8(o1[0], o1[1]);
                }
        } else {
            const int colt = (u.pn & 3) * 256 + wc * 32 + 8 * fq;
#pragma unroll
            for (int ai = 0; ai < 2; ++ai)
#pragma unroll
                for (int m = 0; m < 4; ++m) {
                    const int row = rowt + ai * HALF + m * 16; const int pos = row & 4095; const float rsv = rs1[row];
#pragma unroll
                    for (int bj = 0; bj < 2; ++bj) {
                        const int col = colt + 128 * bj;
                        f32x4 v0 = acc[ai][bj][m][0] * rsv, v1 = acc[ai][bj][m][1] * rsv;
                        bf16_t* dst;
                        if (type == 2) { dst = VB + ((size_t)((b * 8 + (col >> 7)) * 4096 + pos)) * 128 + (col & 127); }
                        else if (type == 3) { dst = LRX + (size_t)row * 1024 + col; }
                        else if (type == 4) {
                            dst = LRG + (size_t)row * 1024 + col;
#pragma unroll
                            for (int j = 0; j < 4; ++j) { v0[j] = fast_gelu_tanh(v0[j]); v1[j] = fast_gelu_tanh(v1[j]); }
                        } else {
                            const float* bp = bg + (type == 6 ? 1024 : 0) + col;
                            const f32x4 b0 = *(const f32x4*)bp, b1 = *(const f32x4*)(bp + 4);
                            dst = (type == 5 ? GA : GL) + (size_t)row * 1024 + col;
#pragma unroll
                            for (int j = 0; j < 4; ++j) { v0[j] = fast_sigmoid(v0[j] + b0[j]); v1[j] = fast_sigmoid(v1[j] + b1[j]); }
                        }
                        *(u32x4*)dst = pack8(v0, v1);
                    }
                }
        }
    }
};
__device__ __forceinline__ void unpack8(const u32x4 w, f32x4& a, f32x4& b) {
    a[0] = __uint_as_float(w.x << 16); a[1] = __uint_as_float(w.x & 0xffff0000u); a[2] = __uint_as_float(w.y << 16); a[3] = __uint_as_float(w.y & 0xffff0000u);
    b[0] = __uint_as_float(w.z << 16); b[1] = __uint_as_float(w.z & 0xffff0000u); b[2] = __uint_as_float(w.w << 16); b[3] = __uint_as_float(w.w & 0xffff0000u);
}
template <int PASS> struct EpiMerge {
    static constexpr bool PERM = true, AFTER_DRAIN = false;
    bf16_t* M; const bf16_t* G;
    __device__ __forceinline__ void operator()(const f32x4 (&acc)[2][2][4][2], const Unit& u, int wr, int wc, int fr, int fq) const {
        const int row0 = u.pm * BM + wr * 64 + fr, col0 = u.pn * BM + wc * 32 + 8 * fq;
#pragma unroll
        for (int ai = 0; ai < 2; ++ai)
#pragma unroll
            for (int m = 0; m < 4; ++m)
#pragma unroll
                for (int bj = 0; bj < 2; ++bj) {
                    const size_t idx = (size_t)(row0 + ai * HALF + m * 16) * 1024 + col0 + bj * HALF;
                    f32x4 g0, g1; unpack8(*(const u32x4*)(G + idx), g0, g1);
                    f32x4 v0 = acc[ai][bj][m][0] * g0, v1 = acc[ai][bj][m][1] * g1;
                    if (PASS == 2) { f32x4 t0, t1; unpack8(*(const u32x4*)(M + idx), t0, t1); v0 += t0; v1 += t1; }
                    *(u32x4*)(M + idx) = pack8(v0, v1);
                }
    }
};
struct EpiResid {
    static constexpr bool PERM = false, AFTER_DRAIN = false;
    const float* X; float* O;
    __device__ __forceinline__ void operator()(const f32x4 (&acc)[2][2][4][2], const Unit& u, int wr, int wc, int fr, int fq) const {
        const int row0 = u.pm * BM + wr * 64 + fr, col0 = u.pn * BM + wc * 32 + 4 * fq;
#pragma unroll
        for (int ai = 0; ai < 2; ++ai)
#pragma unroll
            for (int m = 0; m < 4; ++m)
#pragma unroll
                for (int bj = 0; bj < 2; ++bj)
#pragma unroll
                    for (int n = 0; n < 2; ++n) {
                        const size_t idx = (size_t)(row0 + ai * HALF + m * 16) * 1024 + col0 + bj * HALF + n * 16;
                        *(f32x4*)(O + idx) = *(const f32x4*)(X + idx) + acc[ai][bj][m][n];
                    }
    }
};
}

constexpr int NWAVES = 8;
constexpr int RING_OFF = 0, RING_BYTES = 131072;
constexpr int LDSCTL_OFF = RING_BYTES, MISC_OFF = LDSCTL_OFF + 320;
constexpr int LDS_BYTES = 147456;
constexpr size_t WS_CTL = WS_S7, CTL_ZERO_BYTES = 1 * MiB;
constexpr size_t WS_SEL_E = WS_S7 + 1 * MiB, WS_SEL_W = WS_S7 + 2 * MiB;
constexpr size_t WS_RS1 = WS_S7 + 3 * MiB;
constexpr size_t WS_COS = WS_S7 + 3 * MiB + 512 * 1024, WS_SIN = WS_S7 + 4 * MiB;
constexpr size_t WS_WINT = WS_S7 + 5 * MiB;
constexpr size_t WS_WAT = WS_S7 + 19 * MiB, WS_WLT = WS_S7 + 21 * MiB, WS_WOT = WS_S7 + 23 * MiB;
constexpr size_t WS_LRUW = WS_S7 + 25 * MiB;
constexpr size_t WS_LRUS = WS_S7 + 26 * MiB;
constexpr size_t WS_LIST = WS_S7 + 30 * MiB;
constexpr int CW_BAR = 4096, CW_CNT = 8192;

#define GAS __attribute__((address_space(1)))
#define LAS __attribute__((address_space(3)))
typedef unsigned v4u __attribute__((ext_vector_type(4)));
typedef float f32x4 __attribute__((ext_vector_type(4)));
typedef GAS unsigned gu32;
typedef GAS unsigned long long gu64;
#define RLX_AGENT __ATOMIC_RELAXED, __HIP_MEMORY_SCOPE_AGENT
#define LDS_WAIT() asm volatile("s_waitcnt lgkmcnt(0)" ::: "memory")
#define VM_WAIT() asm volatile("s_waitcnt vmcnt(0)" ::: "memory")
__device__ __forceinline__ unsigned pk2(float lo, float hi) { return (unsigned)f2bf(lo) | ((unsigned)f2bf(hi) << 16); }
namespace pg8 {
struct GroupedOrder {
    const PG8_LAS int* tb;
    const int* listT;
    int G, c, nct;
    __device__ __forceinline__ bool next(int i, GUnit& u) const {
        const int L = i * G + c; const int Tn = __builtin_amdgcn_readfirstlane(tb[16]);
        if (L >= Tn * nct) return false;
        const int rt = L / nct; u.pn = L % nct; u.pm = rt;
        int e = 0;
#pragma unroll
        for (int k = 1; k < 16; ++k) e += (rt >= __builtin_amdgcn_readfirstlane(tb[k])) ? 1 : 0;
        u.e = e; u.pos0 = (rt - __builtin_amdgcn_readfirstlane(tb[e])) * 256; u.cnt = __builtin_amdgcn_readfirstlane(tb[32 + e]);
        return true;
    }
    __device__ __forceinline__ void rows(const GUnit& u, const unsigned (&voffA)[2], unsigned (&out)[2][2]) const {
#pragma unroll
        for (int h = 0; h < 2; ++h)
#pragma unroll
            for (int i = 0; i < 2; ++i) {
                const int R = (int)(voffA[i] >> 11) + 128 * h, pos = u.pos0 + R;
                const int tok = (pos < u.cnt) ? (listT[u.e * 16384 + pos] >> 1) : 0;
                out[h][i] = (unsigned)tok * 2048u + (voffA[i] & 2047u);
            }
    }
    __device__ __forceinline__ void a_ready(const GUnit&) const {}
    __device__ __forceinline__ void done(const GUnit&) const {}
};
struct EpiUp {
    static constexpr bool PERM = true, AFTER_DRAIN = false;
    bf16_t* HID; const float* listW;
    __device__ __forceinline__ void operator()(const f32x4 (&acc)[2][2][4][2], const GUnit& u, int wr, int wc, int fr, int fq) const {
        const int f0 = u.pn * 128 + wc * 32 + 8 * fq;
#pragma unroll
        for (int ai = 0; ai < 2; ++ai)
#pragma unroll
            for (int m = 0; m < 4; ++m) {
                const int r = ai * HALF + wr * 64 + m * 16 + fr, pos = u.pos0 + r;
                const float w = (pos < u.cnt) ? listW[u.e * 16384 + pos] : 0.f;
                f32x4 h0, h1;
#pragma unroll
                for (int j = 0; j < 4; ++j) {
                    const float g0 = acc[ai][0][m][0][j], g1 = acc[ai][0][m][1][j];
                    h0[j] = g0 * __builtin_amdgcn_rcpf(1.f + __expf(-g0)) * acc[ai][1][m][0][j] * w;
                    h1[j] = g1 * __builtin_amdgcn_rcpf(1.f + __expf(-g1)) * acc[ai][1][m][1][j] * w;
                }
                *(u32x4*)(HID + (size_t)(u.pm * BM + r) * 512 + f0) = pack8(h0, h1);
            }
    }
};
struct EpiDown {
    static constexpr bool PERM = true, AFTER_DRAIN = false;
    bf16_t* Y0; size_t ystride; const int* listT;
    __device__ __forceinline__ void operator()(const f32x4 (&acc)[2][2][4][2], const GUnit& u, int wr, int wc, int fr, int fq) const {
        const int col0 = u.pn * BM + wc * 32 + 8 * fq;
#pragma unroll
        for (int ai = 0; ai < 2; ++ai)
#pragma unroll
            for (int m = 0; m < 4; ++m) {
                const int r = ai * HALF + wr * 64 + m * 16 + fr, pos = u.pos0 + r;
                if (pos < u.cnt) {
                    const int ent = listT[u.e * 16384 + pos];
                    bf16_t* Y = Y0 + (size_t)(ent & 1) * ystride + (size_t)(ent >> 1) * 1024 + col0;
                    *(u32x4*)Y = pack8(acc[ai][0][m][0], acc[ai][0][m][1]);
                    *(u32x4*)(Y + HALF) = pack8(acc[ai][1][m][0], acc[ai][1][m][1]);
                }
            }
    }
};
}
namespace att {
using bf16x8 = __attribute__((ext_vector_type(8))) short;
using s16x4  = __attribute__((ext_vector_type(4))) short;
using f32x16 = __attribute__((ext_vector_type(16))) float;
using u32x4  = __attribute__((ext_vector_type(4))) unsigned;
constexpr int NW = 8, QBLK = 32, KVBLK = 64;
constexpr int SHM_K = KVBLK * 64 * 2, SHM_V = KVBLK * 128 * 2;
constexpr int NSLOT = 3;
constexpr int LDS_V = 0, LDS_K = NSLOT * SHM_V, LDS_WS = LDS_K + NSLOT * SHM_K, LDS_OST = 0  , LDS_END = LDS_WS + NW * 256;
static_assert(NW * 8192 <= LDS_WS, "O stage fits under the rings");
static_assert(LDS_END <= 131072, "attention LDS");
#define ATT_KSWZ(row, c16) ((c16) * 1024 + (row) * 16)
#define ATT_SBAR() __builtin_amdgcn_sched_barrier(0)
__device__ __forceinline__ int crow(int r, int hi) { return (r & 3) + 8 * (r >> 2) + 4 * hi; }
__device__ __forceinline__ unsigned cvtpk(float lo, float hi) { unsigned r; asm volatile("v_cvt_pk_bf16_f32 %0, %1, %2" : "=v"(r) : "v"(lo), "v"(hi)); return r; }

__device__ __forceinline__ void partialSM(f32x16& p0) {
#pragma unroll
  for (int r = 0; r < 16; ++r) p0[r] = __builtin_amdgcn_exp2f(p0[r]);
}
__device__ __forceinline__ void finishSM(f32x16& p0, f32x16& p1, float& l_reg, bf16x8& pa0, bf16x8& pa1, bf16x8& pa2, bf16x8& pa3) {
#pragma unroll
  for (int r = 0; r < 16; ++r) p1[r] = __builtin_amdgcn_exp2f(p1[r]);
  float ps = 0.f;
#pragma unroll
  for (int r = 0; r < 16; ++r) ps += p0[r];
#pragma unroll
  for (int r = 0; r < 16; ++r) ps += p1[r];
  l_reg += ps;
#define ATT_PK4(P, BASE, OUT) do { unsigned a0 = cvtpk(P[BASE + 0], P[BASE + 1]), a1 = cvtpk(P[BASE + 2], P[BASE + 3]);   \
    unsigned b0 = cvtpk(P[BASE + 4], P[BASE + 5]), b1 = cvtpk(P[BASE + 6], P[BASE + 7]);                              \
    auto r0 = __builtin_amdgcn_permlane32_swap(a0, b0, false, false); auto r1 = __builtin_amdgcn_permlane32_swap(a1, b1, false, false); \
    u32x4 w = {r0[0], r1[0], r0[1], r1[1]}; OUT = *reinterpret_cast<bf16x8*>(&w); } while (0)
  ATT_PK4(p0, 0, pa0); ATT_PK4(p0, 8, pa1); ATT_PK4(p1, 0, pa2); ATT_PK4(p1, 8, pa3);
#undef ATT_PK4
}
__device__ __forceinline__ void qkt(f32x16& p0, f32x16& p1, const char* Ks, const bf16x8* qr, int r32, int hi) {
  p0 = f32x16{}; p1 = f32x16{};
#pragma unroll
  for (int d0 = 0; d0 < 4; ++d0) { const int c16 = d0 * 2 + hi;
    const bf16x8 b0 = *reinterpret_cast<const bf16x8*>(Ks + ATT_KSWZ(r32, c16));
    const bf16x8 b1 = *reinterpret_cast<const bf16x8*>(Ks + ATT_KSWZ(32 + r32, c16));
    p0 = __builtin_amdgcn_mfma_f32_32x32x16_bf16(b0, qr[d0], p0, 0, 0, 0);
    p1 = __builtin_amdgcn_mfma_f32_32x32x16_bf16(b1, qr[d0], p1, 0, 0, 0); }
}
__device__ __forceinline__ int v_st(int k, int c) { const int kk = (k & ~0xC) | ((k & 4) << 1) | ((k & 8) >> 1); return ((kk >> 3) * 4 + (c >> 5)) * 512 + ((kk & 7) * 32 + (c & 31)) * 2; }
__device__ __forceinline__ int v_rd_base(int lane) { return ((lane & 3) << 3) | (((lane >> 2) & 3) << 6) | (((lane >> 4) & 1) << 5) | (((lane >> 5) & 1) << 8); }
constexpr int v_rd_off(int d0, int ks, int half) { return d0 * 512 + ks * 4096 + half * 2048; }
template <int OFF> __device__ __forceinline__ s16x4 tr_read(int vb) {
  s16x4 r; asm volatile("ds_read_b64_tr_b16 %0, %1 offset:%2" : "=&v"(r) : "v"(vb), "i"(OFF) : "memory"); return r;
}
template <int D0> __device__ __forceinline__ void pv_one(f32x16& od, int vb, bf16x8 pa0, bf16x8 pa1, bf16x8 pa2, bf16x8 pa3) {
  const s16x4 l0 = tr_read<v_rd_off(D0, 0, 0)>(vb), h0 = tr_read<v_rd_off(D0, 0, 1)>(vb), l1 = tr_read<v_rd_off(D0, 1, 0)>(vb), h1 = tr_read<v_rd_off(D0, 1, 1)>(vb);
  const s16x4 l2 = tr_read<v_rd_off(D0, 2, 0)>(vb), h2 = tr_read<v_rd_off(D0, 2, 1)>(vb), l3 = tr_read<v_rd_off(D0, 3, 0)>(vb), h3 = tr_read<v_rd_off(D0, 3, 1)>(vb);
  asm volatile("s_waitcnt lgkmcnt(0)" ::: "memory"); ATT_SBAR();
#define ATT_PK(L, H) (bf16x8){L[0], L[1], L[2], L[3], H[0], H[1], H[2], H[3]}
  od = __builtin_amdgcn_mfma_f32_32x32x16_bf16(pa0, ATT_PK(l0, h0), od, 0, 0, 0);
  od = __builtin_amdgcn_mfma_f32_32x32x16_bf16(pa1, ATT_PK(l1, h1), od, 0, 0, 0);
  od = __builtin_amdgcn_mfma_f32_32x32x16_bf16(pa2, ATT_PK(l2, h2), od, 0, 0, 0);
  od = __builtin_amdgcn_mfma_f32_32x32x16_bf16(pa3, ATT_PK(l3, h3), od, 0, 0, 0);
#undef ATT_PK
}
__device__ __forceinline__ void pv_d0(f32x16* o, int vb, bf16x8 pa0, bf16x8 pa1, bf16x8 pa2, bf16x8 pa3) {
  pv_one<0>(o[0], vb, pa0, pa1, pa2, pa3); pv_one<1>(o[1], vb, pa0, pa1, pa2, pa3); pv_one<2>(o[2], vb, pa0, pa1, pa2, pa3); pv_one<3>(o[3], vb, pa0, pa1, pa2, pa3);
}

__device__ __forceinline__ void glds16(const void* gsrc, unsigned lds_dst) { unsigned keep;
  asm volatile("s_mov_b32 %0, m0\n\ts_mov_b32 m0, %2\n\ts_nop 0\n\tglobal_load_lds_dwordx4 %1, off\n\ts_mov_b32 m0, %0" : "=&s"(keep) : "v"(gsrc), "s"(lds_dst) : "memory"); }
#define ATT_WAIT_BAR(N) asm volatile("s_waitcnt vmcnt(" #N ") lgkmcnt(0)\n\ts_barrier" ::: "memory")
__device__ __forceinline__ void attn_unit(const bf16_t* __restrict__ Qb, const bf16_t* __restrict__ Kh, const bf16_t* __restrict__ Vh, bf16_t* __restrict__ Ob, char* lds) {
  const int tid = threadIdx.x, lane = tid & 63, r32 = lane & 31, hi = lane >> 5; const int wid = __builtin_amdgcn_readfirstlane(tid >> 6);
  char* V_lds = lds + LDS_V; char* K_lds = lds + LDS_K;
  float* wsf = (float*)(lds + LDS_WS) + wid * 64;
  float l_reg = 0.f; f32x16 o[4] = {}; bf16x8 qr[4];
  const unsigned lds0 = (unsigned)(uintptr_t)lds;
  const bf16_t* ksrc = Kh + (size_t)lane * 64 + wid * 8;
  const unsigned kdst = lds0 + LDS_K + wid * 1024;
  const bf16_t* vsrc[2]; unsigned vdst[2];
#pragma unroll
  for (int i = 0; i < 2; ++i) { const int q = 2 * wid + i, kk = (q >> 1) * 8 + ((lane >> 2) & 7), k = (kk & ~0xC) | ((kk & 4) << 1) | ((kk & 8) >> 1), c = (2 * (q & 1) + (lane >> 5)) * 32 + (lane & 3) * 8;
    vsrc[i] = Vh + (size_t)k * 128 + c; vdst[i] = lds0 + LDS_V + q * 1024; }
#define ATT_DMA_K(t, slot) glds16(ksrc + (size_t)(t) * (KVBLK * 64), (unsigned)__builtin_amdgcn_readfirstlane(kdst + (slot) * SHM_K))
#define ATT_DMA_V(t, slot) do { glds16(vsrc[0] + (size_t)(t) * (KVBLK * 128), (unsigned)__builtin_amdgcn_readfirstlane(vdst[0] + (slot) * SHM_V)); \
                                glds16(vsrc[1] + (size_t)(t) * (KVBLK * 128), (unsigned)__builtin_amdgcn_readfirstlane(vdst[1] + (slot) * SHM_V)); } while (0)
  asm volatile("s_waitcnt lgkmcnt(0)\n\ts_barrier" ::: "memory");
  ATT_DMA_K(0, 0);
  ATT_DMA_K(1, 1); ATT_DMA_V(0, 0);
  const bf16_t* Qw = Qb + (size_t)(wid * QBLK + r32) * 64 + hi * 8;
#pragma unroll
  for (int d0 = 0; d0 < 4; ++d0) qr[d0] = *reinterpret_cast<const bf16x8*>(Qw + d0 * 16);
  const int vb0 = (int)(uintptr_t)V_lds + v_rd_base(lane);
  f32x16 pA0, pA1, pB0, pB1; bf16x8 pa0, pa1, pa2, pa3; constexpr int NT = 4096 / KVBLK;
  ATT_WAIT_BAR(3);
  ATT_DMA_K(2, 2); ATT_DMA_V(1, 1);
  qkt(pA0, pA1, K_lds, qr, r32, hi); partialSM(pA0);
  ATT_WAIT_BAR(3);
  int sk = 1, sv = 0;
#define ATT_ROT() do { sk = (sk == NSLOT - 1) ? 0 : sk + 1; sv = (sv == NSLOT - 1) ? 0 : sv + 1; } while (0)
#define ATT_STEP(PC0, PC1, PP0, PP1, j, ISSUE) do { \
    if (ISSUE) { const int sn_k = (sk == 0) ? NSLOT - 1 : sk - 1, sn_v = (sv == NSLOT - 1) ? 0 : sv + 1; const int sn_v2 = (sn_v == NSLOT - 1) ? 0 : sn_v + 1; \
      ATT_DMA_K((j) + 2, sn_k); ATT_DMA_V((j) + 1, sn_v2); } \
    ATT_SBAR(); qkt(PC0, PC1, K_lds + sk * SHM_K, qr, r32, hi); \
    finishSM(PP0, PP1, l_reg, pa0, pa1, pa2, pa3); ATT_SBAR(); \
    pv_d0(o, vb0 + sv * SHM_V, pa0, pa1, pa2, pa3); partialSM(PC0); } while (0)
  int j = 1;
  for (; j + 3 < NT; j += 2) {
    ATT_STEP(pB0, pB1, pA0, pA1, j, true);     ATT_WAIT_BAR(3); ATT_ROT();
    ATT_STEP(pA0, pA1, pB0, pB1, j + 1, true); ATT_WAIT_BAR(3); ATT_ROT();
  }
  ATT_STEP(pB0, pB1, pA0, pA1, j, true);       ATT_WAIT_BAR(3); ATT_ROT();
  { const int sn_v = (sv == NSLOT - 1) ? 0 : sv + 1; const int sn_v2 = (sn_v == NSLOT - 1) ? 0 : sn_v + 1; ATT_DMA_V(NT - 1, sn_v2); }
  ATT_STEP(pA0, pA1, pB0, pB1, j + 1, false);  ATT_WAIT_BAR(2); ATT_ROT();
  ATT_STEP(pB0, pB1, pA0, pA1, j + 2, false);  ATT_WAIT_BAR(0); ATT_ROT();
  finishSM(pB0, pB1, l_reg, pa0, pa1, pa2, pa3); ATT_SBAR();
  pv_d0(o, vb0 + sv * SHM_V, pa0, pa1, pa2, pa3);
  { auto rr = __builtin_amdgcn_permlane32_swap(__float_as_uint(l_reg), __float_as_uint(l_reg), false, false); l_reg = __uint_as_float(rr[0]) + __uint_as_float(rr[1]); }
  if (hi == 0) wsf[r32] = l_reg; asm volatile("s_waitcnt lgkmcnt(0)" ::: "memory");
  float rli[16];
#pragma unroll
  for (int r = 0; r < 16; ++r) rli[r] = __builtin_amdgcn_rcpf(wsf[crow(r, hi)]);
  asm volatile("s_waitcnt lgkmcnt(0)\n\ts_barrier" ::: "memory");
  bf16_t* stg = (bf16_t*)(lds + LDS_OST) + wid * 4096;
#pragma unroll
  for (int r = 0; r < 16; ++r) { const int orow = crow(r, hi);
#pragma unroll
    for (int d0 = 0; d0 < 4; ++d0) stg[orow * 128 + d0 * 32 + r32] = f2bf(o[d0][r] * rli[r]); }
  asm volatile("s_waitcnt lgkmcnt(0)" ::: "memory");
  bf16_t* Ow = Ob + (size_t)(wid * QBLK) * 1024;
#pragma unroll
  for (int i = 0; i < 8; ++i) { const int row = i * 4 + (lane >> 4), ch = lane & 15; const u32x4 v = *(const u32x4*)(stg + row * 128 + ch * 8); *(u32x4*)(Ow + (size_t)row * 1024 + ch * 8) = v; }
#undef ATT_DMA_K
#undef ATT_DMA_V
#undef ATT_ROT
#undef ATT_STEP
}
}
namespace lru {
using bf16x8 = __attribute__((ext_vector_type(8))) short;
using f32x16 = __attribute__((ext_vector_type(16))) float;
using u32x4  = __attribute__((ext_vector_type(4))) unsigned;
typedef float f32x4_t __attribute__((ext_vector_type(4)));
constexpr int T = 64, NCH = 4096 / T;
constexpr int LDS_XR = 0, LDS_H = 16384, LDS_CAR = LDS_H + 2 * T * 128 * 4, LDS_CW = LDS_CAR + 2 * 16 * 128 * 4, LDS_END = LDS_CW + 640 * 4;
#define LRU_XSWZ(row, c16) ((row) * 256 + ((((c16) ^ (row)) & 15) << 4))
__device__ __forceinline__ int crow(int r, int hi) { return (r & 3) + 8 * (r >> 2) + 4 * hi; }
__device__ __forceinline__ float fsig(float x) { return __builtin_amdgcn_rcpf(1.f + __expf(-x)); }

template <int DIR, bool APPLY>
__device__ __forceinline__ void scan(f32x16 (&a)[2], f32x16 (&u)[2], float cin, int hi, float& Ptot, float& Hend) {
  float P[2][4], H[2][4], Pp[2][4], Hp[2][4];
#pragma unroll
  for (int rt = 0; rt < 2; ++rt)
#pragma unroll
    for (int q = 0; q < 4; ++q) {
      float p = 1.f, h = 0.f;
#pragma unroll
      for (int ii = 0; ii < 4; ++ii) { const int r = 4 * q + (DIR ? 3 - ii : ii); h = a[rt][r] * h + u[rt][r]; p *= a[rt][r]; }
      P[rt][q] = p; H[rt][q] = h;
      Pp[rt][q] = __shfl_xor(p, 32); Hp[rt][q] = __shfl_xor(h, 32);
    }
  float c = cin, pt = 1.f; float myc[2][4];
  const bool first = (hi == (DIR ? 1 : 0));
#pragma unroll
  for (int gg = 0; gg < 8; ++gg) {
    const int rt = DIR ? 1 - (gg >> 2) : (gg >> 2), q = DIR ? 3 - (gg & 3) : (gg & 3);
    const float Pf = first ? P[rt][q] : Pp[rt][q], Hf = first ? H[rt][q] : Hp[rt][q];
    const float Ps = first ? Pp[rt][q] : P[rt][q], Hs = first ? Hp[rt][q] : H[rt][q];
    const float c0 = c; c = Pf * c + Hf; const float c1 = c; c = Ps * c + Hs; pt *= Pf * Ps;
    myc[rt][q] = first ? c0 : c1;
  }
  Ptot = pt; Hend = c;
  if (APPLY) {
#pragma unroll
    for (int rt = 0; rt < 2; ++rt)
#pragma unroll
      for (int q = 0; q < 4; ++q) {
        float h = myc[rt][q];
#pragma unroll
        for (int ii = 0; ii < 4; ++ii) { const int r = 4 * q + (DIR ? 3 - ii : ii); h = a[rt][r] * h + u[rt][r]; u[rt][r] = h; }
      }
  }
}

struct Params {
  const bf16_t* LRX; const bf16_t* LRG; const bf16_t* Wt; const float* conv_w; const float* conv_b;
  const float* ba; const float* bi; const float* lam; float* SUM; bf16_t* YL;
};

template <int PASS>
__device__ __forceinline__ void lru_phase(const Params& p, char* lds, int vcu, int G) {
  const int tid = threadIdx.x, wid = tid >> 6, lane = tid & 63, r32 = lane & 31, hi = lane >> 5;
  const int dir = wid >> 2, cq = wid & 3;
  const int blk = vcu & 7, idx = vcu >> 3, nper = (NB * NCH) / (G >> 3);
  const int e = cq * 32 + r32, ch = blk * 128 + e;
  const int un0 = idx * nper, b = un0 / NCH, chunk0 = un0 % NCH;
  const size_t rowb = (size_t)b * 4096;
  bf16x8 wb[2][8];
#pragma unroll
  for (int g = 0; g < 2; ++g)
#pragma unroll
    for (int ks = 0; ks < 8; ++ks) wb[g][ks] = *reinterpret_cast<const bf16x8*>(p.Wt + ((size_t)((dir * 2 + g) * 8 + blk) * 128 + e) * 128 + ks * 16 + hi * 8);
  const float bav = p.ba[dir * 1024 + ch], biv = p.bi[dir * 1024 + ch];
  const float c8 = -8.f * log1pf(__expf(-p.lam[dir * 1024 + ch]));
  const int c8i = tid & 15, cc = blk * 128 + c8i * 8, trow = tid >> 4;
  float* CWL = (float*)(lds + LDS_CW);
  float* CAR = (float*)(lds + LDS_CAR);
  __syncthreads();
  for (int q = tid; q < 640; q += 512) CWL[q] = (q < 512) ? p.conv_w[(q >> 7) * 1024 + blk * 128 + (q & 127)] : p.conv_b[blk * 128 + (q & 127)];
  if (PASS == 2 && tid < 256) {
    const int d2 = tid >> 7, e2 = tid & 127; float c = 0.f;
    const float* sp = p.SUM + ((size_t)(b * NCH * 2 + d2) * 1024 + blk * 128 + e2) * 2;
    if (d2 == 0) {
#pragma unroll 8
      for (int j = 0; j < chunk0 + nper; ++j) { const float a_ = sp[(size_t)j * 4096], h_ = sp[(size_t)j * 4096 + 1]; if (j >= chunk0) CAR[(j - chunk0) * 128 + e2] = c; c = a_ * c + h_; }
    } else {
#pragma unroll 8
      for (int j = NCH - 1; j >= chunk0; --j) { const float a_ = sp[(size_t)j * 4096], h_ = sp[(size_t)j * 4096 + 1]; if (j < chunk0 + nper) CAR[(nper + j - chunk0) * 128 + e2] = c; c = a_ * c + h_; }
    }
  }
  bf16x8 xq[2][4];
#define LRU_LOADROWS(t0_) do { _Pragma("unroll") for (int pp = 0; pp < 2; ++pp) _Pragma("unroll") for (int j = 0; j < 4; ++j) { \
      const int ta = (t0_) + trow + 32 * pp - 1 + j; \
      xq[pp][j] = (ta >= 0 && ta < 4096) ? *reinterpret_cast<const bf16x8*>(p.LRX + (rowb + ta) * 1024 + cc) : bf16x8{0, 0, 0, 0, 0, 0, 0, 0}; } } while (0)
  LRU_LOADROWS(chunk0 * T);
  for (int i = 0; i < nper; ++i) {
    const int chunk = chunk0 + i, t0 = chunk * T;
    __syncthreads();
#pragma unroll
    for (int pp = 0; pp < 2; ++pp) {
      f32x4_t a0 = *(const f32x4_t*)(CWL + 512 + c8i * 8), a1 = *(const f32x4_t*)(CWL + 512 + c8i * 8 + 4);
#pragma unroll
      for (int j = 0; j < 4; ++j) {
        f32x4_t x0, x1;
#pragma unroll
        for (int k = 0; k < 4; ++k) { x0[k] = bf2f((bf16_t)xq[pp][j][k]); x1[k] = bf2f((bf16_t)xq[pp][j][4 + k]); }
        a0 += *(const f32x4_t*)(CWL + j * 128 + c8i * 8) * x0; a1 += *(const f32x4_t*)(CWL + j * 128 + c8i * 8 + 4) * x1;
      }
      u32x4 w; w.x = pk2(a0[0], a0[1]); w.y = pk2(a0[2], a0[3]); w.z = pk2(a1[0], a1[1]); w.w = pk2(a1[2], a1[3]);
      *(u32x4*)(lds + LDS_XR + LRU_XSWZ(trow + 32 * pp, c8i)) = w;
    }
    if (i + 1 < nper) LRU_LOADROWS(t0 + T);
    __syncthreads();
    f32x16 aA[2], aI[2];
    aA[0] = f32x16{}; aA[1] = f32x16{}; aI[0] = f32x16{}; aI[1] = f32x16{};
#pragma unroll
    for (int ks = 0; ks < 8; ++ks) {
      const int c16 = ks * 2 + hi;
      const bf16x8 x0 = *reinterpret_cast<const bf16x8*>(lds + LDS_XR + LRU_XSWZ(r32, c16));
      const bf16x8 x1 = *reinterpret_cast<const bf16x8*>(lds + LDS_XR + LRU_XSWZ(32 + r32, c16));
      aA[0] = __builtin_amdgcn_mfma_f32_32x32x16_bf16(x0, wb[0][ks], aA[0], 0, 0, 0);
      aA[1] = __builtin_amdgcn_mfma_f32_32x32x16_bf16(x1, wb[0][ks], aA[1], 0, 0, 0);
      aI[0] = __builtin_amdgcn_mfma_f32_32x32x16_bf16(x0, wb[1][ks], aI[0], 0, 0, 0);
      aI[1] = __builtin_amdgcn_mfma_f32_32x32x16_bf16(x1, wb[1][ks], aI[1], 0, 0, 0);
    }
#pragma unroll
    for (int rt = 0; rt < 2; ++rt)
#pragma unroll
      for (int r = 0; r < 16; ++r) {
        const int t = 32 * rt + crow(r, hi);
        const float xv = bf2f(*(const bf16_t*)(lds + LDS_XR + LRU_XSWZ(t, e >> 3) + (e & 7) * 2));
        const float rg = fsig(aA[rt][r] + bav), ig = fsig(aI[rt][r] + biv);
        const float a = __expf(c8 * rg);
        aA[rt][r] = a; aI[rt][r] = __builtin_amdgcn_sqrtf(1.f - a * a) * ig * xv;
      }
    float Ptot, Hend;
    if (PASS == 1) {
      if (dir == 0) scan<0, false>(aA, aI, 0.f, hi, Ptot, Hend); else scan<1, false>(aA, aI, 0.f, hi, Ptot, Hend);
      if (hi == 0) { float* s = p.SUM + ((size_t)((b * NCH + chunk) * 2 + dir) * 1024 + ch) * 2; s[0] = Ptot; s[1] = Hend; }
    } else {
      const float cin = CAR[(dir * nper + i) * 128 + e];
      if (dir == 0) scan<0, true>(aA, aI, cin, hi, Ptot, Hend); else scan<1, true>(aA, aI, cin, hi, Ptot, Hend);
      float* Hs = (float*)(lds + LDS_H) + dir * (T * 128);
#pragma unroll
      for (int rt = 0; rt < 2; ++rt)
#pragma unroll
        for (int r = 0; r < 16; ++r) Hs[(32 * rt + crow(r, hi)) * 128 + e] = aI[rt][r];
      __syncthreads();
#pragma unroll
      for (int pp = 0; pp < 2; ++pp) {
        const int t = trow + 32 * pp;
        const float* hf = (const float*)(lds + LDS_H) + t * 128 + c8i * 8; const float* hb = hf + T * 128;
        const f32x4_t f0 = *(const f32x4_t*)hf, f1 = *(const f32x4_t*)(hf + 4), b0 = *(const f32x4_t*)hb, b1 = *(const f32x4_t*)(hb + 4);
        const size_t gi = (rowb + t0 + t) * 1024 + cc;
        const bf16x8 gv = *reinterpret_cast<const bf16x8*>(p.LRG + gi);
        u32x4 w;
        w.x = pk2((f0[0] + b0[0]) * bf2f((bf16_t)gv[0]), (f0[1] + b0[1]) * bf2f((bf16_t)gv[1]));
        w.y = pk2((f0[2] + b0[2]) * bf2f((bf16_t)gv[2]), (f0[3] + b0[3]) * bf2f((bf16_t)gv[3]));
        w.z = pk2((f1[0] + b1[0]) * bf2f((bf16_t)gv[4]), (f1[1] + b1[1]) * bf2f((bf16_t)gv[5]));
        w.w = pk2((f1[2] + b1[2]) * bf2f((bf16_t)gv[6]), (f1[3] + b1[3]) * bf2f((bf16_t)gv[7]));
        *(u32x4*)(p.YL + gi) = w;
      }
    }
  }
#undef LRU_LOADROWS
}
}
#define XB_TMO      128
#define XB_XCNT(j)  (256  + 64 * (j))
#define XB_XSUB(j)  (1280 + 64 * (j))
#define XB_XGEN(j)  (2304 + 64 * (j))
#define XB_TOP      3328
#define XB_TOPGEN   3392
#define XCD_BAR_WORDS 3456
#define XB_SPIN_CAP (1u << 18)

__device__ __forceinline__ unsigned xb_ld(unsigned* p)              { return __hip_atomic_load(p, __ATOMIC_RELAXED, __HIP_MEMORY_SCOPE_AGENT); }
__device__ __forceinline__ unsigned xb_add(unsigned* p, unsigned v) { return __hip_atomic_fetch_add(p, v, __ATOMIC_RELAXED, __HIP_MEMORY_SCOPE_AGENT); }
__device__ __forceinline__ unsigned xb_xcc_id() { return (unsigned)__builtin_amdgcn_s_getreg((3 << 11) | 20) & 0xFu; }
#define XB_SPIN(cond, bar) do { unsigned _sp = 0; while (cond) { __builtin_amdgcn_s_sleep(1); \
    if ((++_sp & 255u) == 0u) { if (xb_ld(&(bar)[XB_TMO])) break; if (_sp > XB_SPIN_CAP) { atomicAdd(&(bar)[XB_TMO], 1u); break; } } } } while (0)

struct XcdBarrier {
    unsigned* bar; unsigned x;
    volatile LAS unsigned* st;
};

__device__ __forceinline__ XcdBarrier xcd_barrier_post(unsigned* bar, volatile LAS unsigned* st) {
    XcdBarrier b; b.bar = bar; b.x = xb_xcc_id(); b.st = st;
    if (threadIdx.x == 0) (void)xb_add(&bar[XB_XCNT(b.x)], 1u);
    return b;
}
__device__ __forceinline__ void xcd_barrier_complete(unsigned* bar, unsigned x, unsigned& nloc, unsigned& nx) {
    const unsigned G = gridDim.x * gridDim.y * gridDim.z;
    unsigned sum, cnt, mine, sp = 0u;
    for (;;) {
        sum = 0u; cnt = 0u; mine = 0u;
#pragma unroll
        for (unsigned j = 0; j < 16; ++j) { const unsigned c = xb_ld(&bar[XB_XCNT(j)]); sum += c; cnt += (c > 0u) ? 1u : 0u; mine = (j == x) ? c : mine; }
        if (sum == G) break;
        __builtin_amdgcn_s_sleep(1);
        if ((++sp & 255u) == 0u) { if (xb_ld(&bar[XB_TMO])) break; if (sp > XB_SPIN_CAP) { atomicAdd(&bar[XB_TMO], 1u); break; } }
    }
    nloc = mine > 0u ? mine : 1u; nx = cnt > 0u ? cnt : 1u;
}

__device__ __forceinline__ void xcd_barrier(const XcdBarrier& b) {
    asm volatile("s_waitcnt vmcnt(0)" ::: "memory");
    __syncthreads();
    if (threadIdx.x == 0) {
        unsigned* bar = b.bar;
        __builtin_amdgcn_s_waitcnt(0);
        unsigned nloc = b.st[0], nx = b.st[1];
        if (nloc == 0u) { xcd_barrier_complete(bar, b.x, nloc, nx); b.st[0] = nloc; b.st[1] = nx; }
        const unsigned old = xb_add(&bar[XB_XSUB(b.x)], 1u);
        const unsigned gen = old / nloc;
        if (old + 1u == (gen + 1u) * nloc) {
            __builtin_amdgcn_fence(__ATOMIC_RELEASE, "agent");
            asm volatile("s_waitcnt vmcnt(0)" ::: "memory");
            const unsigned og = xb_add(&bar[XB_TOP], 1u);
            const unsigned tg = og / nx;
            if (og + 1u == (tg + 1u) * nx) xb_add(&bar[XB_TOPGEN], 1u);
            else XB_SPIN(xb_ld(&bar[XB_TOPGEN]) == tg, bar);
            __builtin_amdgcn_fence(__ATOMIC_ACQUIRE, "agent");
            xb_add(&bar[XB_XGEN(b.x)], 1u);
            asm volatile("s_waitcnt vmcnt(0)" ::: "memory");
        } else {
            XB_SPIN(xb_ld(&bar[XB_XGEN(b.x)]) == gen, bar);
            __builtin_amdgcn_fence(__ATOMIC_ACQUIRE, "agent");
            asm volatile("s_waitcnt vmcnt(0)" ::: "memory");
        }
    }
    __syncthreads();
}
struct MkArgs { const float* in[29]; float* out; unsigned char* ws; int ph_lo, ph_hi; };
struct Frame {
    LAS unsigned char* lds;
    volatile LAS unsigned* MISC;
    gu32* ctl;
    int tid, lane, wave;
    int vcu, G;
};

__device__ __forceinline__ void p0_transpose_item(const float* W, int K, int N, bf16_t* WT, LAS float* scr, int item, int lane, const float* kscale, int mode) {
    const int nblk = N / 32, kb = item / nblk, nb = item % nblk, k0 = 64 * kb, n0 = 32 * nb;
#pragma unroll 8
    for (int i = 0; i < 32; ++i) { const int kk = 2 * i + (lane >> 5); float w = W[(size_t)(k0 + kk) * N + n0 + (lane & 31)]; if (kscale) w *= kscale[k0 + kk]; scr[kk * 33 + (lane & 31)] = w; }
    LDS_WAIT(); asm volatile("" ::: "memory");
    const int r0 = (mode == 1 && n0 < 2048) ? ((n0 & ~255) + 128 * ((n0 >> 5) & 1) + 32 * ((n0 >> 6) & 3)) : (mode >= 2) ? (256 * (n0 >> 7) + 128 * (mode - 2) + (n0 & 127)) : n0;
    const int c = lane & 7;
#pragma unroll
    for (int j = 0; j < 4; ++j) { const int n = (lane >> 3) + 8 * j; const LAS float* s = scr + (8 * c) * 33 + n;
        v4u o; o.x = pk2(s[0 * 33], s[1 * 33]); o.y = pk2(s[2 * 33], s[3 * 33]); o.z = pk2(s[4 * 33], s[5 * 33]); o.w = pk2(s[6 * 33], s[7 * 33]);
        *(GAS v4u*)(WT + (size_t)(r0 + n) * K + k0 + 8 * c) = o; }
    LDS_WAIT(); asm volatile("" ::: "memory");
}
__device__ __forceinline__ void p0_row(const float* xrow, bf16_t* orow, float* rs, int lane) {
    const GAS f32x4* xr = (const GAS f32x4*)xrow + lane;
    f32x4 v[4]; float s = 0.f;
#pragma unroll
    for (int j = 0; j < 4; ++j) { v[j] = xr[64 * j]; s += (v[j].x * v[j].x + v[j].y * v[j].y) + (v[j].z * v[j].z + v[j].w * v[j].w); }
    s = wave_sum(s);
    if (lane == 0) *rs = rsqrtf(s * (1.f / 1024.f) + 1e-6f);
    GAS unsigned long long* o8 = (GAS unsigned long long*)orow + lane;
#pragma unroll
    for (int j = 0; j < 4; ++j) o8[64 * j] = (unsigned long long)pk2(v[j].x, v[j].y) | ((unsigned long long)pk2(v[j].z, v[j].w) << 32);
}

__global__ void __launch_bounds__(NWAVES * 64, 2) persist(MkArgs args) {
    extern __shared__ __attribute__((aligned(16))) unsigned char lds[];
    Frame F;
    F.lds = (LAS unsigned char*)lds;
    F.MISC = (volatile LAS unsigned*)(F.lds + MISC_OFF);
    F.tid = threadIdx.x; F.lane = F.tid & 63; F.wave = __builtin_amdgcn_readfirstlane(F.tid >> 6);
    F.G = gridDim.x; { const int bx = blockIdx.x; F.vcu = (F.G % 8 == 0) ? (bx % 8) * (F.G / 8) + bx / 8 : bx; }
    unsigned char* ws = args.ws;
    F.ctl = (gu32*)(ws + WS_CTL);
    for (int u = F.tid; u < (LDS_BYTES - LDSCTL_OFF) / 4; u += NWAVES * 64) ((LAS unsigned*)(F.lds + LDSCTL_OFF))[u] = 0u;
    __syncthreads();
    const int lo = args.ph_lo, hi = args.ph_hi;
    XcdBarrier bar; bar.bar = (unsigned*)(F.ctl + CW_BAR); bar.x = 0; bar.st = nullptr;
    if (hi - lo > 1) bar = xcd_barrier_post((unsigned*)(F.ctl + CW_BAR), F.MISC + 8);
#define IN(k) (lo <= (k) && (k) < hi)
#define BOTH(k) (IN(k) && IN((k) + 1))
#define GRID_BAR() xcd_barrier(bar)

    const float* x = args.in[0];
    bf16_t* XB = (bf16_t*)args.out;
    float* RS1 = (float*)(ws + WS_RS1); float* COST = (float*)(ws + WS_COS); float* SINT = (float*)(ws + WS_SIN);
    bf16_t* WINT = (bf16_t*)(ws + WS_WINT); bf16_t* WAT = (bf16_t*)(ws + WS_WAT); bf16_t* WLT = (bf16_t*)(ws + WS_WLT); bf16_t* WOT = (bf16_t*)(ws + WS_WOT);
    bf16_t* LRUW = (bf16_t*)(ws + WS_LRUW); float* LRUS = (float*)(ws + WS_LRUS);
    bf16_t* QP = (bf16_t*)(ws + WS_S0); bf16_t* KP = (bf16_t*)(ws + WS_S1); bf16_t* VB = (bf16_t*)(ws + WS_S2);
    bf16_t* LRX = (bf16_t*)(ws + WS_S3); bf16_t* LRG = (bf16_t*)(ws + WS_S4); bf16_t* GA = (bf16_t*)(ws + WS_S5); bf16_t* GL = (bf16_t*)(ws + WS_S6);

    if (IN(0)) REPEAT(0) {
        LAS float* scr = (LAS float*)(F.lds + RING_OFF + F.wave * 16384);
        const int gw = F.vcu * NWAVES + F.wave, NGW = F.G * NWAVES;
        constexpr int I_IN = (1024 / 64) * (PROJ / 32), I_SQ = (1024 / 64) * (1024 / 32);
        constexpr int I_LRU = 32 * 8;
        constexpr int NITEMS = I_IN + 3 * I_SQ + I_LRU;
        for (int it = gw; it < NITEMS; it += NGW) {
            int r = it;
            if (r < I_IN) { p0_transpose_item(args.in[2], 1024, PROJ, WINT, scr, r, F.lane, args.in[1], 1); continue; } r -= I_IN;
            if (r < I_SQ) { p0_transpose_item(args.in[11], 1024, 1024, WAT, scr, r, F.lane, nullptr, 0); continue; } r -= I_SQ;
            if (r < I_SQ) { p0_transpose_item(args.in[19], 1024, 1024, WLT, scr, r, F.lane, nullptr, 0); continue; } r -= I_SQ;
            if (r < I_SQ) { p0_transpose_item(args.in[20], 1024, 1024, WOT, scr, r, F.lane, nullptr, 0); continue; } r -= I_SQ;
            { const int mat = r >> 3, gate = mat >> 4, dirblk = mat & 15, dir = dirblk >> 3, blk = dirblk & 7;
              p0_transpose_item((gate ? args.in[16] : args.in[14]) + (size_t)dirblk * 16384, 128, 128, LRUW + (size_t)((dir * 2 + gate) * 8 + blk) * 16384, scr, r & 7, F.lane, nullptr, 0); }
        }
        for (int m = gw; m < NTOK; m += NGW) p0_row(x + (size_t)m * 1024, XB + (size_t)m * 1024, RS1 + m, F.lane);
        {
            for (int e = blockIdx.x * (NWAVES * 64) + F.tid; e < 4096 * 32; e += F.G * NWAVES * 64) {
                const int pos = e >> 5, i = e & 31;
                const float inv_freq = expf(-9.210340371976184f * (float)i * (1.f / 32.f));
                float sn, cs; sincosf((float)pos * inv_freq, &sn, &cs);
                COST[e] = cs; SINT[e] = sn;
            }
        }
    }
    if (BOTH(0)) GRID_BAR();
    if (IN(1)) {
        pg8::Gemm g{XB, WINT, NTOK, PROJ, 1024}; pg8::StaticOrder S; S.init(NTOK, PROJ, F.G, (int)blockIdx.x, PROBE_PHASE == 1 ? 2 : 1);
        pg8::EpiProj E{RS1, args.in[3], args.in[4], args.in[5], COST, SINT, QP, KP, VB, LRX, LRG, GA, GL};
        pg8::gemm_phase<pg8::EpiProj, pg8::StaticOrder, true, true>(F.lds + RING_OFF, g, S, E);
    }
    if (BOTH(1)) GRID_BAR();
    bf16_t* O1N = (bf16_t*)args.out; bf16_t* O2N = O1N + (size_t)NTOK * 1024;
    if (IN(2)) {
        const int per = 1024 / F.G;
        REPEAT(2) for (int i = 0; i < per; ++i) {
            const int unit = F.vcu * per + i;
            const int bhc = unit >> 4, qb = unit & 15, b = bhc >> 4, hc = bhc & 15, h = hc >> 1, c = hc & 1;
            att::attn_unit(QP + ((size_t)bhc * 4096 + qb * 256) * 64, KP + (size_t)bhc * 4096 * 64, VB + ((size_t)(b * 8 + h) * 4096) * 128,
                           (c ? O2N : O1N) + ((size_t)b * 4096 + qb * 256) * 1024 + h * 128, (char*)lds + RING_OFF);
        }
        REPEAT(10) { const lru::Params lp{LRX, LRG, LRUW, args.in[12], args.in[13], args.in[15], args.in[17], args.in[18], LRUS, nullptr};
          lru::lru_phase<1>(lp, (char*)lds + RING_OFF, F.vcu, F.G); }
        if (BOTH(2)) GRID_BAR();
    }
    bf16_t* ON = (bf16_t*)(ws + WS_S0); bf16_t* YL = (bf16_t*)(ws + WS_S1);
    if (IN(3)) REPEAT(3) {
        {
            const float s1 = wave_sum(args.in[6][F.lane] * args.in[7][F.lane]), s2 = wave_sum(args.in[8][F.lane] * args.in[9][F.lane]);
            const float lam = expf(s1) - expf(s2) + 0.2f;
            const float g0 = args.in[10][F.lane] * 0.8f, g1 = args.in[10][64 + F.lane] * 0.8f;
            const int gw = F.vcu * NWAVES + F.wave, NGW = F.G * NWAVES;
            for (int it = gw; it < NTOK * 8; it += NGW) {
                const size_t base = (size_t)it * 128;
                const float a0 = bf2f(O1N[base + F.lane]) - lam * bf2f(O2N[base + F.lane]);
                const float a1 = bf2f(O1N[base + 64 + F.lane]) - lam * bf2f(O2N[base + 64 + F.lane]);
                const float ss = wave_sum(a0 * a0 + a1 * a1);
                const float rs = rsqrtf(ss * (1.f / 128.f) + 1e-6f);
                ON[base + F.lane] = f2bf(a0 * rs * g0); ON[base + 64 + F.lane] = f2bf(a1 * rs * g1);
            }
        }
        { const lru::Params lp{LRX, LRG, LRUW, args.in[12], args.in[13], args.in[15], args.in[17], args.in[18], LRUS, YL};
          lru::lru_phase<2>(lp, (char*)lds + RING_OFF, F.vcu, F.G); }
    }
    if (BOTH(3)) GRID_BAR();
    bf16_t* MERGED = (bf16_t*)(ws + WS_S2);
    if (IN(4)) {
        { pg8::Gemm g{ON, WAT, NTOK, 1024, 1024}; pg8::StaticOrder S; S.init(NTOK, 1024, F.G, (int)blockIdx.x, PROBE_PHASE == 4 ? 2 : 1);
          pg8::EpiMerge<1> E{MERGED, GA};
          pg8::gemm_phase<pg8::EpiMerge<1>, pg8::StaticOrder, false, true>(F.lds + RING_OFF, g, S, E); }
        { pg8::Gemm g{YL, WLT, NTOK, 1024, 1024}; pg8::StaticOrder S; S.init(NTOK, 1024, F.G, (int)blockIdx.x, PROBE_PHASE == 4 ? 2 : 1);
          pg8::EpiMerge<2> E{MERGED, GL};
          pg8::gemm_phase<pg8::EpiMerge<2>, pg8::StaticOrder, false, true>(F.lds + RING_OFF, g, S, E); }
    }
    if (BOTH(4)) GRID_BAR();
    if (IN(5)) {
        pg8::Gemm g{MERGED, WOT, NTOK, 1024, 1024}; pg8::StaticOrder S; S.init(NTOK, 1024, F.G, (int)blockIdx.x, PROBE_PHASE == 5 ? 2 : 1);
        pg8::EpiResid E{x, args.out};
        pg8::gemm_phase<pg8::EpiResid, pg8::StaticOrder, false, true>(F.lds + RING_OFF, g, S, E);
    }
    if (BOTH(5)) GRID_BAR();
    bf16_t* H2 = (bf16_t*)(ws + WS_S0); bf16_t* HID = (bf16_t*)(ws + WS_S3);
    bf16_t* WGU = (bf16_t*)(ws + WS_S5); bf16_t* WDN = (bf16_t*)(ws + WS_S6 + 2 * MiB);
    bf16_t* Y0 = (bf16_t*)(ws + WS_S1); bf16_t* Y1 = (bf16_t*)(ws + WS_S2);
    int* LISTT = (int*)(ws + WS_LIST); float* LISTW = (float*)(ws + WS_LIST + 1 * MiB);
    gu32* GCNT = F.ctl + CW_CNT;
    LAS int* TB = (LAS int*)(F.lds + LDSCTL_OFF + 1024);
    if (IN(6)) {
        const float* x1 = args.out;
        const int tpc = NTOK / F.G, tpw = tpc / NWAVES;
        LAS int* LE = (LAS int*)(F.lds + RING_OFF + 12288); LAS float* LW = (LAS float*)(F.lds + RING_OFF + 12288 + 1024);
        LAS int* LRK = (LAS int*)(F.lds + RING_OFF + 12288 + 2048); LAS int* LCNT = (LAS int*)(F.lds + RING_OFF + 12288 + 3072); LAS int* LBASE = LCNT + 16;
        LAS float* WR = (LAS float*)(F.lds + RING_OFF + 16384);
        __syncthreads();
        if (F.tid < 32) LCNT[F.tid] = 0;
        const float* gain2 = args.in[21]; const float* wg = args.in[22]; const float* bg = args.in[23]; const float* wer = args.in[24]; const float* ber = args.in[25];
        for (int i = F.tid; i < 1024 * 5; i += NWAVES * 64) {
            const int d = i / 5, q = i % 5;
            const f32x4 w4 = (q == 0) ? *(const f32x4*)&wg[d * 4] : *(const f32x4*)&wer[d * 16 + (q - 1) * 4];
            *(LAS f32x4*)&WR[d * 20 + q * 4] = w4;
        }
        __syncthreads();
        for (int k = 0; k < tpw; ++k) {
            const int tl = F.wave * tpw + k; const size_t tok = (size_t)F.vcu * tpc + tl;
            const float* xr = x1 + tok * 1024 + F.lane; const float* gp = gain2 + F.lane; bf16_t* hp = H2 + tok * 1024 + F.lane;
            float v[16]; float ss = 0.f;
#pragma unroll
            for (int j = 0; j < 16; ++j) { v[j] = xr[j * 64]; ss += v[j] * v[j]; }
            ss = wave_sum(ss);
            const float rs = rsqrtf(ss * (1.f / 1024.f) + 1e-6f);
            float lg[20];
#pragma unroll
            for (int q = 0; q < 20; ++q) lg[q] = 0.f;
            const LAS float* wl = WR + F.lane * 20;
#pragma unroll
            for (int j = 0; j < 16; ++j) {
                const float hv = v[j] * rs * gp[j * 64];
                hp[j * 64] = f2bf(hv);
#pragma unroll
                for (int q = 0; q < 5; ++q) { const f32x4 w4 = *(const LAS f32x4*)&wl[j * 64 * 20 + q * 4]; lg[q * 4 + 0] += hv * w4.x; lg[q * 4 + 1] += hv * w4.y; lg[q * 4 + 2] += hv * w4.z; lg[q * 4 + 3] += hv * w4.w; }
            }
#pragma unroll
            for (int q = 0; q < 20; ++q) lg[q] = wave_sum(lg[q]);
            const float gl0 = lg[0] + bg[0], gl1 = lg[1] + bg[1], gl2 = lg[2] + bg[2], gl3 = lg[3] + bg[3];
            int gs = 0; float gm = gl0;
            if (gl1 > gm) { gm = gl1; gs = 1; } if (gl2 > gm) { gm = gl2; gs = 2; } if (gl3 > gm) { gm = gl3; gs = 3; }
            const float gw = 1.f / (expf(gl0 - gm) + expf(gl1 - gm) + expf(gl2 - gm) + expf(gl3 - gm));
            float el[4];
#pragma unroll
            for (int j = 0; j < 4; ++j) { const float s0 = lg[4 + j], s1 = lg[8 + j], s2 = lg[12 + j], s3 = lg[16 + j]; el[j] = (gs == 0 ? s0 : gs == 1 ? s1 : gs == 2 ? s2 : s3) + ber[gs * 4 + j]; }
            int i0 = 0; float v0 = el[0];
            if (el[1] > v0) { v0 = el[1]; i0 = 1; } if (el[2] > v0) { v0 = el[2]; i0 = 2; } if (el[3] > v0) { v0 = el[3]; i0 = 3; }
            int i1 = (i0 == 0) ? 1 : 0; float v1 = -3.0e38f;
#pragma unroll
            for (int j = 0; j < 4; ++j) { if (j != i0 && el[j] > v1) { v1 = el[j]; i1 = j; } }
            const float ex = expf(v1 - v0);
            if (F.lane == 0) { LE[tl * 2] = gs * 4 + i0; LE[tl * 2 + 1] = gs * 4 + i1; LW[tl * 2] = gw / (1.f + ex); LW[tl * 2 + 1] = gw * ex / (1.f + ex); }
        }
        __syncthreads();
        const int npair = tpc * 2;
        int me = 0;
        if (F.tid < npair) { me = LE[F.tid]; LRK[F.tid] = __hip_atomic_fetch_add(&LCNT[me], 1, __ATOMIC_RELAXED, __HIP_MEMORY_SCOPE_WORKGROUP); }
        __syncthreads();
        if (F.tid < 16) LBASE[F.tid] = (int)__hip_atomic_fetch_add(GCNT + F.tid, (unsigned)LCNT[F.tid], RLX_AGENT);
        __syncthreads();
        if (F.tid < npair) { const int pos = LBASE[me] + LRK[F.tid]; LISTT[me * 16384 + pos] = (F.vcu * tpc + (F.tid >> 1)) * 2 + (F.tid & 1); LISTW[me * 16384 + pos] = LW[F.tid]; }
        __syncthreads();
        REPEAT(11) {
            LAS float* scr = (LAS float*)(F.lds + RING_OFF + F.wave * 16384);
            const int gw_ = F.vcu * NWAVES + F.wave, NGW = F.G * NWAVES;
            constexpr int I_GU = (1024 / 64) * (512 / 32), I_DN = (512 / 64) * (1024 / 32);
            for (int it = gw_; it < 16 * (2 * I_GU + I_DN); it += NGW) {
                const int e = it / (2 * I_GU + I_DN); int r = it % (2 * I_GU + I_DN);
                if (r < 2 * I_GU) {
                    const int isup = r >= I_GU; if (isup) r -= I_GU;
                    p0_transpose_item((isup ? args.in[27] : args.in[26]) + (size_t)e * 1024 * 512, 1024, 512, WGU + (size_t)e * 1024 * 1024, scr, r, F.lane, nullptr, 2 + isup);
                } else {
                    p0_transpose_item(args.in[28] + (size_t)e * 512 * 1024, 512, 1024, WDN + (size_t)e * 1024 * 512, scr, r - 2 * I_GU, F.lane, nullptr, 0);
                }
            }
        }
        if (BOTH(6)) GRID_BAR();
    }
    if (IN(7) || IN(8)) {
        __syncthreads();
        if (F.tid < 16) TB[32 + F.tid] = (int)__hip_atomic_load(GCNT + F.tid, RLX_AGENT);
        __syncthreads();
        if (F.tid == 0) { int accn = 0; for (int e = 0; e < 16; ++e) { TB[e] = accn; accn += (TB[32 + e] + 255) >> 8; } TB[16] = accn; }
        __syncthreads();
    }
    if (IN(7)) REPEAT(7) {
        pg8::Gemm g{H2, WGU, 0, 1024, 1024}; pg8::GroupedOrder S{TB, LISTT, F.G, F.vcu, 4};
        pg8::EpiUp E{HID, LISTW};
        pg8::gemm_grouped<pg8::EpiUp, pg8::GroupedOrder, 0, true>(F.lds + RING_OFF, g, S, E);
    }
    if (BOTH(7)) GRID_BAR();
    if (IN(8)) REPEAT(8) {
        pg8::Gemm g{HID, WDN, 0, 1024, 512}; pg8::GroupedOrder S{TB, LISTT, F.G, F.vcu, 4};
        pg8::EpiDown E{Y0, (size_t)(Y1 - Y0), LISTT};
        pg8::gemm_grouped<pg8::EpiDown, pg8::GroupedOrder, 1, true>(F.lds + RING_OFF, g, S, E);
    }
    if (BOTH(8)) GRID_BAR();
    if (IN(9)) {
        typedef unsigned u32x2_t __attribute__((ext_vector_type(2)));
        f32x4* o4 = (f32x4*)args.out; const u32x2_t* a2 = (const u32x2_t*)Y0; const u32x2_t* b2 = (const u32x2_t*)Y1;
        for (size_t i = (size_t)blockIdx.x * (NWAVES * 64) + F.tid; i < (size_t)NTOK * 256; i += (size_t)F.G * NWAVES * 64) {
            f32x4 v = o4[i]; const u32x2_t a = a2[i], b = b2[i];
            v[0] += __uint_as_float(a.x << 16) + __uint_as_float(b.x << 16); v[1] += __uint_as_float(a.x & 0xffff0000u) + __uint_as_float(b.x & 0xffff0000u);
            v[2] += __uint_as_float(a.y << 16) + __uint_as_float(b.y << 16); v[3] += __uint_as_float(a.y & 0xffff0000u) + __uint_as_float(b.y & 0xffff0000u);
            o4[i] = v;
        }
    }
#undef IN
#undef BOTH
}
extern "C" void kernel_launch(void* const* d_in, const int* in_sizes, int n_in, void* d_out, int out_size, void* d_ws, size_t ws_size, hipStream_t stream) {
  static int once = 0;
  if (!once) {
    once = 1;
    if (ws_size < 8 * SLOT || n_in != 29) fprintf(stderr, "kernel_launch: unexpected ws %zu n_in %d\n", ws_size, n_in);
    (void)hipFuncSetAttribute((const void*)persist, hipFuncAttributeMaxDynamicSharedMemorySize, LDS_BYTES);
  }
  char* ws = (char*)d_ws;
  (void)hipMemsetAsync(ws + WS_CTL, 0, CTL_ZERO_BYTES, stream);
  MkArgs a{};
  for (int i = 0; i < 29; ++i) a.in[i] = (const float*)d_in[i];
  a.out = (float*)d_out; a.ws = (unsigned char*)d_ws;
  const int GRID = 256;
  a.ph_lo = 0; a.ph_hi = 10; hipLaunchKernelGGL(persist, dim3(GRID), dim3(NWAVES * 64), LDS_BYTES, stream, a);
}
```

```cpp
#include <hip/hip_runtime.h>
#include <cstdint>
#include <cstdio>

typedef unsigned short bf16_t;
__device__ __forceinline__ float bf2f(bf16_t v) { return __uint_as_float(((unsigned)v) << 16); }
__device__ __forceinline__ bf16_t f2bf(float f) { unsigned u = __float_as_uint(f); return (bf16_t)((u + 0x7fffu + ((u >> 16) & 1u)) >> 16); }
__device__ __forceinline__ float toF(float v) { return v; }
__device__ __forceinline__ float toF(bf16_t v) { return bf2f(v); }

constexpr int NTOK = 16384, DM = 1024, SEQ = 4096, NB = 4, PROJ = 7168;
constexpr size_t MiB = 1u << 20;
constexpr size_t SLOT = 32 * MiB;
constexpr size_t WS_S0 = 0, WS_S1 = SLOT, WS_S2 = 2 * SLOT, WS_S3 = 3 * SLOT, WS_S4 = 4 * SLOT, WS_S5 = 5 * SLOT, WS_S6 = 6 * SLOT, WS_S7 = 7 * SLOT;

__device__ __forceinline__ float wave_sum(float v) {
#pragma unroll
  for (int o = 1; o < 64; o <<= 1) v += __shfl_xor(v, o);
  return v;
}
__device__ __forceinline__ float sigmoidf_(float x) { return 1.f / (1.f + __expf(-x)); }
__device__ __forceinline__ float gelu_tanh(float x) {
  const float k0 = 0.7978845608028654f, k1 = 0.044715f;
  float t = k0 * (x + k1 * x * x * x);
  return 0.5f * x * (1.f + tanhf(t));
}

#ifndef PROBE_PHASE
#define PROBE_PHASE -1
#endif
#define REPEAT(k) for (int _rep = 0; _rep < ((PROBE_PHASE == (k)) ? 2 : 1); ++_rep)
namespace pg8 {
#define PG8_LAS __attribute__((address_space(3)))
typedef unsigned short bf16_t;
typedef short bf16x8 __attribute__((ext_vector_type(8)));
typedef float f32x4 __attribute__((ext_vector_type(4)));
typedef unsigned u32x4 __attribute__((ext_vector_type(4)));
constexpr int BM = 256, BK = 64, HALF = 128, HTB = HALF * BK * 2  , STAGE_BYTES = 8 * HTB, NXCD = 8, WGM = 8;

__host__ __device__ __forceinline__ int lds_byte(int r, int c) { const int st = (r >> 4) * 2 + (c >> 5), rr = r & 15, cc = c & 31, ob = rr * 64 + cc * 2; return st * 1024 + (ob ^ (((ob >> 9) & 1) << 5)); }
__host__ __device__ __forceinline__ void stage_rc(int b, int& R, int& C) { const int st = b / 1024, sb = b % 1024, swz = sb ^ (((sb >> 9) & 1) << 5); R = (st >> 1) * 16 + swz / 64; C = (st & 1) * 32 + (swz % 64) / 2; }
__host__ __device__ __forceinline__ int perm32(int rho) { const int n = rho >> 4, i = rho & 15; return 8 * (i >> 2) + 4 * n + (i & 3); }

struct Unit { int pm, pn; };
struct GUnit { int pm, pn, e, pos0, cnt; };
struct Gemm { const bf16_t* A; const bf16_t* Bt; int M, N, K; };

struct StaticOrder {
    int nM, nN, nwg, G, c, rep;
    __host__ __device__ void init(int M, int N, int G_, int c_, int rep_ = 1) { nM = M / BM; nN = N / BM; nwg = nM * nN; G = G_; c = c_; rep = rep_; }
    __host__ __device__ bool next(int i, Unit& u) const {
        const long L = (long)i * G + c; if (L >= (long)nwg * rep) return false;
        int wgid = (int)(L % nwg); { const int q = nwg / NXCD, r = nwg % NXCD, xcd = wgid % NXCD, off = wgid / NXCD; wgid = (xcd < r ? xcd * (q + 1) : r * (q + 1) + (xcd - r) * q) + off; }
        const int nig = WGM * nN, gid = wgid / nig, fm = gid * WGM, gsz = (nM - fm) < WGM ? (nM - fm) : WGM;
        u.pm = fm + ((wgid % nig) % gsz); u.pn = (wgid % nig) / gsz; return true;
    }
    __device__ __forceinline__ void a_ready(const Unit&) const {}
    __device__ __forceinline__ void done(const Unit&) const {}
};

__device__ __forceinline__ unsigned cvt_pk_bf16(float lo, float hi) { unsigned r; asm volatile("v_cvt_pk_bf16_f32 %0, %1, %2" : "=v"(r) : "v"(lo), "v"(hi)); return r; }
typedef float f32x2 __attribute__((ext_vector_type(2)));
template <class Epi, class Sched, bool ALIGN_EPI = false, bool SP2 = false>
__device__ __forceinline__ void gemm_phase(PG8_LAS unsigned char* lds, const Gemm g, const Sched& S, const Epi& E) {
    const int tid = threadIdx.x, wid = __builtin_amdgcn_readfirstlane(tid >> 6), lane = tid & 63, wr = wid >> 2, wc = wid & 3, fr = lane & 15, fq = lane >> 4;
    const int K = g.K, nt = K / BK;
    unsigned voffA[2], voffB[2];
#pragma unroll
    for (int i = 0; i < 2; ++i) { int R, C; stage_rc(tid * 16 + i * 8192, R, C); const int Rb = Epi::PERM ? ((R & ~31) + perm32(R & 31)) : R;
        voffA[i] = (unsigned)(R * K + C) * 2u; voffB[i] = (unsigned)(Rb * K + C) * 2u; }
    const size_t kstep = (size_t)(BK * 2);
    const size_t hstep = (size_t)HALF * K * 2;
    const size_t tstep = 2 * hstep;
    const unsigned ldsw = (unsigned)wid * 1024u;
    const int aoff = lds_byte(wr * 64 + fr, fq * 8), boff = lds_byte(wc * 32 + fr, fq * 8);
#define PG8_SA(b, h) (((b) * 2 + (h)) * HTB)
#define PG8_SB(b, h) ((4 + (b) * 2 + (h)) * HTB)
#define PG8_STAGE(bufoff, gbase, voff) do { _Pragma("unroll") for (int _i = 0; _i < 2; ++_i) \
        __builtin_amdgcn_global_load_lds((const unsigned*)((const char*)(gbase) + (voff)[_i]), (PG8_LAS unsigned*)(lds + (bufoff) + ldsw + _i * 8192), 16, 0, 0); } while (0)
#define PG8_LDA(dst, b, h) do { _Pragma("unroll") for (int m = 0; m < 4; ++m) _Pragma("unroll") for (int k = 0; k < 2; ++k) dst[m][k] = *(const PG8_LAS bf16x8*)(lds + PG8_SA(b, h) + aoff + m * 2048 + k * 1024); } while (0)
#define PG8_LDB(dst, b, h) do { _Pragma("unroll") for (int n = 0; n < 2; ++n) _Pragma("unroll") for (int k = 0; k < 2; ++k) dst[n][k] = *(const PG8_LAS bf16x8*)(lds + PG8_SB(b, h) + boff + n * 2048 + k * 1024); } while (0)
#define PG8_MMA(ai, bj, At, Bt) do { __builtin_amdgcn_s_setprio(1); _Pragma("unroll") for (int m = 0; m < 4; ++m) _Pragma("unroll") for (int n = 0; n < 2; ++n) _Pragma("unroll") for (int k = 0; k < 2; ++k) \
        acc[ai][bj][m][n] = __builtin_amdgcn_mfma_f32_16x16x32_bf16(Bt[n][k], At[m][k], acc[ai][bj][m][n], 0, 0, 0); __builtin_amdgcn_s_setprio(0); } while (0)
#define PG8_WAIT_V(n) asm volatile("s_waitcnt vmcnt(" #n ")" ::: "memory")
#define PG8_WAIT_L(n) asm volatile("s_waitcnt lgkmcnt(" #n ")" ::: "memory")
#define PG8_BAR __builtin_amdgcn_s_barrier()
#define PG8_SCHED __builtin_amdgcn_sched_barrier(0)
    Unit cur, nxt; int ui = 0;
    if (!S.next(0, cur)) return;
    f32x4 acc[2][2][4][2];
#pragma unroll
    for (int a = 0; a < 2; ++a)
#pragma unroll
        for (int b = 0; b < 2; ++b)
#pragma unroll
            for (int m = 0; m < 4; ++m)
#pragma unroll
                for (int n = 0; n < 2; ++n) acc[a][b][m][n] = (f32x4){0.f, 0.f, 0.f, 0.f};
    bf16x8 At[4][2], B0[2][2], B1[2][2];
    const char* cA = (const char*)g.A + (size_t)cur.pm * tstep; const char* cB = (const char*)g.Bt + (size_t)cur.pn * tstep;
    S.a_ready(cur);
    if constexpr (SP2) {
        PG8_STAGE(PG8_SB(0, 0), cB, voffB); PG8_STAGE(PG8_SB(0, 1), cB + hstep, voffB); PG8_STAGE(PG8_SA(0, 0), cA, voffA); PG8_STAGE(PG8_SA(0, 1), cA + hstep, voffA);
        if (wr == 1) PG8_BAR;
        PG8_WAIT_V(2); PG8_BAR;
        PG8_STAGE(PG8_SB(1, 0), cB + kstep, voffB); PG8_STAGE(PG8_SA(1, 0), cA + kstep, voffA); PG8_STAGE(PG8_SB(1, 1), cB + hstep + kstep, voffB);
        PG8_WAIT_V(6); PG8_BAR;
    } else {
        PG8_STAGE(PG8_SB(0, 0), cB, voffB); PG8_STAGE(PG8_SA(0, 0), cA, voffA); PG8_STAGE(PG8_SB(0, 1), cB + hstep, voffB); PG8_STAGE(PG8_SA(0, 1), cA + hstep, voffA);
        if (wr == 1) PG8_BAR;
        PG8_WAIT_V(4); PG8_BAR;
        PG8_STAGE(PG8_SB(1, 0), cB + kstep, voffB); PG8_STAGE(PG8_SA(1, 0), cA + kstep, voffA); PG8_STAGE(PG8_SB(1, 1), cB + hstep + kstep, voffB);
        PG8_WAIT_V(6); PG8_BAR;
    }
    for (;;) {
        const bool has_next = S.next(ui + 1, nxt);
        const char* nA = has_next ? (const char*)g.A + (size_t)nxt.pm * tstep : cA; const char* nB = has_next ? (const char*)g.Bt + (size_t)nxt.pn * tstep : cB;
        for (int t = 0; t < nt; t += 2) {
            const bool last = (t == nt - 2);
            const char* a1 = cA + (size_t)(t + 1) * kstep;
            const char* a2 = last ? nA : cA + (size_t)(t + 2) * kstep; const char* b2 = last ? nB : cB + (size_t)(t + 2) * kstep;
            const char* a3 = a2 + kstep; const char* b3 = b2 + kstep;
            if (last && has_next) S.a_ready(nxt);
            if constexpr (SP2) {
            PG8_LDB(B0, 0, 0); PG8_LDB(B1, 0, 1); PG8_SCHED; PG8_LDA(At, 0, 0); PG8_STAGE(PG8_SA(1, 1), a1 + hstep, voffA);
            PG8_WAIT_V(8); PG8_WAIT_L(0); PG8_BAR; PG8_MMA(0, 0, At, B0); PG8_MMA(0, 1, At, B1); PG8_BAR; PG8_SCHED;
            PG8_LDA(At, 0, 1); PG8_STAGE(PG8_SB(0, 0), b2, voffB); PG8_STAGE(PG8_SB(0, 1), b2 + hstep, voffB); PG8_STAGE(PG8_SA(0, 0), a2, voffA);
            PG8_WAIT_V(8); PG8_WAIT_L(0); PG8_BAR; PG8_MMA(1, 0, At, B0); PG8_MMA(1, 1, At, B1); PG8_BAR; PG8_SCHED;
            PG8_LDB(B0, 1, 0); PG8_LDB(B1, 1, 1); PG8_SCHED; PG8_LDA(At, 1, 0); PG8_STAGE(PG8_SA(0, 1), a2 + hstep, voffA);
            PG8_WAIT_V(8); PG8_WAIT_L(0); PG8_BAR; PG8_MMA(0, 0, At, B0); PG8_MMA(0, 1, At, B1); PG8_BAR; PG8_SCHED;
            PG8_LDA(At, 1, 1); PG8_STAGE(PG8_SB(1, 0), b3, voffB); PG8_STAGE(PG8_SB(1, 1), b3 + hstep, voffB); PG8_STAGE(PG8_SA(1, 0), a3, voffA);
            PG8_WAIT_V(8); PG8_WAIT_L(0); PG8_BAR; PG8_MMA(1, 0, At, B0); PG8_MMA(1, 1, At, B1); PG8_BAR; PG8_SCHED;
            } else {
            PG8_LDB(B0, 0, 0); PG8_SCHED; PG8_LDA(At, 0, 0); PG8_STAGE(PG8_SA(1, 1), a1 + hstep, voffA);
            PG8_WAIT_L(8); PG8_BAR; PG8_WAIT_L(0); PG8_MMA(0, 0, At, B0); PG8_BAR; PG8_SCHED;
            PG8_LDB(B1, 0, 1); PG8_STAGE(PG8_SB(0, 0), b2, voffB);
            PG8_BAR; PG8_WAIT_L(0); PG8_MMA(0, 1, At, B1); PG8_BAR;
            PG8_LDA(At, 0, 1); PG8_STAGE(PG8_SA(0, 0), a2, voffA);
            PG8_BAR; PG8_WAIT_L(0); PG8_MMA(1, 0, At, B0); PG8_BAR; PG8_SCHED;
            PG8_STAGE(PG8_SB(0, 1), b2 + hstep, voffB);
            PG8_WAIT_V(6); PG8_BAR; PG8_MMA(1, 1, At, B1); PG8_BAR;
            PG8_LDB(B0, 1, 0); PG8_SCHED; PG8_LDA(At, 1, 0); PG8_STAGE(PG8_SA(0, 1), a2 + hstep, voffA);
            PG8_WAIT_L(8); PG8_BAR; PG8_WAIT_L(0); PG8_MMA(0, 0, At, B0); PG8_BAR; PG8_SCHED;
            PG8_LDB(B1, 1, 1); PG8_STAGE(PG8_SB(1, 0), b3, voffB);
            PG8_BAR; PG8_WAIT_L(0); PG8_MMA(0, 1, At, B1); PG8_BAR;
            PG8_LDA(At, 1, 1); PG8_STAGE(PG8_SA(1, 0), a3, voffA);
            PG8_BAR; PG8_WAIT_L(0); PG8_MMA(1, 0, At, B0); PG8_BAR; PG8_SCHED;
            PG8_STAGE(PG8_SB(1, 1), b3 + hstep, voffB);
            PG8_WAIT_V(6); PG8_BAR; PG8_MMA(1, 1, At, B1); PG8_BAR;
            }
        }
        if constexpr (ALIGN_EPI) { if (wr == 0) PG8_BAR; }
        if constexpr (!Epi::AFTER_DRAIN) { E(acc, cur, wr, wc, fr, fq); S.done(cur); }
        if (!has_next) break;
#pragma unroll
        for (int a = 0; a < 2; ++a)
#pragma unroll
            for (int b = 0; b < 2; ++b)
#pragma unroll
                for (int m = 0; m < 4; ++m)
#pragma unroll
                    for (int n = 0; n < 2; ++n) acc[a][b][m][n] = (f32x4){0.f, 0.f, 0.f, 0.f};
        cur = nxt; cA = nA; cB = nB; ++ui;
        if constexpr (ALIGN_EPI) { if (wr == 1) PG8_BAR; }
    }
    PG8_WAIT_V(0);
    if constexpr (!ALIGN_EPI) { if (wr == 0) PG8_BAR; }
    PG8_BAR;
    if constexpr (Epi::AFTER_DRAIN) { E.fused(acc, cur, wr, wc, fr, fq, lds, wid, lane); S.done(cur); }
#undef PG8_SA
#undef PG8_SB
#undef PG8_STAGE
#undef PG8_LDA
#undef PG8_LDB
#undef PG8_MMA
#undef PG8_WAIT_V
#undef PG8_WAIT_L
#undef PG8_BAR
#undef PG8_SCHED
}
}
namespace pg8 {
template <class Epi, class Sched, int MODE, bool ALIGN_EPI = true>
__device__ __forceinline__ void gemm_grouped(PG8_LAS unsigned char* lds, const Gemm g, const Sched& S, const Epi& E) {
    constexpr bool SP2 = true;
    const int tid = threadIdx.x, wid = __builtin_amdgcn_readfirstlane(tid >> 6), lane = tid & 63, wr = wid >> 2, wc = wid & 3, fr = lane & 15, fq = lane >> 4;
    const int K = g.K, nt = K / BK;
    unsigned voffA[2], voffB[2];
#pragma unroll
    for (int i = 0; i < 2; ++i) { int R, C; stage_rc(tid * 16 + i * 8192, R, C); const int Rb = Epi::PERM ? ((R & ~31) + perm32(R & 31)) : R;
        voffA[i] = (unsigned)(R * K + C) * 2u; voffB[i] = (unsigned)(Rb * K + C) * 2u; }
    const size_t kstep = (size_t)(BK * 2);
    const size_t hstep = (size_t)HALF * K * 2;
    const size_t tstep = 2 * hstep;
    const unsigned ldsw = (unsigned)wid * 1024u;
    const int aoff = lds_byte(wr * 64 + fr, fq * 8), boff = lds_byte(wc * 32 + fr, fq * 8);
#define PG8_SA(b, h) (((b) * 2 + (h)) * HTB)
#define PG8_SB(b, h) ((4 + (b) * 2 + (h)) * HTB)
#define PG8_STAGE(bufoff, gbase, voff) do { _Pragma("unroll") for (int _i = 0; _i < 2; ++_i) \
        __builtin_amdgcn_global_load_lds((const unsigned*)((const char*)(gbase) + (voff)[_i]), (PG8_LAS unsigned*)(lds + (bufoff) + ldsw + _i * 8192), 16, 0, 0); } while (0)
#define PG8_STAGE_A(bufoff, kptr, h, nx) do { if (MODE == 0) { unsigned _v[2]; _v[0] = (nx) ? nvA[h][0] : cvA[h][0]; _v[1] = (nx) ? nvA[h][1] : cvA[h][1]; PG8_STAGE(bufoff, kptr, _v); } else { PG8_STAGE(bufoff, (kptr) + (h) * hstep, voffA); } } while (0)
#define PG8_LDA(dst, b, h) do { _Pragma("unroll") for (int m = 0; m < 4; ++m) _Pragma("unroll") for (int k = 0; k < 2; ++k) dst[m][k] = *(const PG8_LAS bf16x8*)(lds + PG8_SA(b, h) + aoff + m * 2048 + k * 1024); } while (0)
#define PG8_LDB(dst, b, h) do { _Pragma("unroll") for (int n = 0; n < 2; ++n) _Pragma("unroll") for (int k = 0; k < 2; ++k) dst[n][k] = *(const PG8_LAS bf16x8*)(lds + PG8_SB(b, h) + boff + n * 2048 + k * 1024); } while (0)
#define PG8_MMA(ai, bj, At, Bt) do { __builtin_amdgcn_s_setprio(1); _Pragma("unroll") for (int m = 0; m < 4; ++m) _Pragma("unroll") for (int n = 0; n < 2; ++n) _Pragma("unroll") for (int k = 0; k < 2; ++k) \
        acc[ai][bj][m][n] = __builtin_amdgcn_mfma_f32_16x16x32_bf16(Bt[n][k], At[m][k], acc[ai][bj][m][n], 0, 0, 0); __builtin_amdgcn_s_setprio(0); } while (0)
#define PG8_WAIT_V(n) asm volatile("s_waitcnt vmcnt(" #n ")" ::: "memory")
#define PG8_WAIT_L(n) asm volatile("s_waitcnt lgkmcnt(" #n ")" ::: "memory")
#define PG8_BAR __builtin_amdgcn_s_barrier()
#define PG8_SCHED __builtin_amdgcn_sched_barrier(0)
    GUnit cur, nxt; int ui = 0;
    if (!S.next(0, cur)) return;
    unsigned cvA[2][2], nvA[2][2];
    if (MODE == 0) S.rows(cur, voffA, cvA);
    f32x4 acc[2][2][4][2];
#pragma unroll
    for (int a = 0; a < 2; ++a)
#pragma unroll
        for (int b = 0; b < 2; ++b)
#pragma unroll
            for (int m = 0; m < 4; ++m)
#pragma unroll
                for (int n = 0; n < 2; ++n) acc[a][b][m][n] = (f32x4){0.f, 0.f, 0.f, 0.f};
    bf16x8 At[4][2], B0[2][2], B1[2][2];
    const size_t estep = (size_t)g.N * K * 2;
    const char* cA = (const char*)g.A + (MODE == 0 ? (size_t)0 : (size_t)cur.pm * tstep); const char* cB = (const char*)g.Bt + (size_t)cur.e * estep + (size_t)cur.pn * tstep;
    S.a_ready(cur);
    if constexpr (SP2) {
        PG8_STAGE(PG8_SB(0, 0), cB, voffB); PG8_STAGE(PG8_SB(0, 1), cB + hstep, voffB); PG8_STAGE_A(PG8_SA(0, 0), cA, 0, false); PG8_STAGE_A(PG8_SA(0, 1), cA, 1, false);
        if (wr == 1) PG8_BAR;
        PG8_WAIT_V(2); PG8_BAR;
        PG8_STAGE(PG8_SB(1, 0), cB + kstep, voffB); PG8_STAGE_A(PG8_SA(1, 0), cA + kstep, 0, false); PG8_STAGE(PG8_SB(1, 1), cB + hstep + kstep, voffB);
        PG8_WAIT_V(6); PG8_BAR;
    } else {
        PG8_STAGE(PG8_SB(0, 0), cB, voffB); PG8_STAGE(PG8_SA(0, 0), cA, voffA); PG8_STAGE(PG8_SB(0, 1), cB + hstep, voffB); PG8_STAGE(PG8_SA(0, 1), cA + hstep, voffA);
        if (wr == 1) PG8_BAR;
        PG8_WAIT_V(4); PG8_BAR;
        PG8_STAGE(PG8_SB(1, 0), cB + kstep, voffB); PG8_STAGE_A(PG8_SA(1, 0), cA + kstep, 0, false); PG8_STAGE(PG8_SB(1, 1), cB + hstep + kstep, voffB);
        PG8_WAIT_V(6); PG8_BAR;
    }
    for (;;) {
        const bool has_next = S.next(ui + 1, nxt);
        const char* nA = (MODE == 0) ? cA : (has_next ? (const char*)g.A + (size_t)nxt.pm * tstep : cA); const char* nB = has_next ? (const char*)g.Bt + (size_t)nxt.e * estep + (size_t)nxt.pn * tstep : cB;
        if (MODE == 0) { if (has_next) S.rows(nxt, voffA, nvA); else { nvA[0][0] = cvA[0][0]; nvA[0][1] = cvA[0][1]; nvA[1][0] = cvA[1][0]; nvA[1][1] = cvA[1][1]; } }
        for (int t = 0; t < nt; t += 2) {
            const bool last = (t == nt - 2);
            const char* a1 = cA + (size_t)(t + 1) * kstep;
            const char* a2 = last ? nA : cA + (size_t)(t + 2) * kstep; const char* b2 = last ? nB : cB + (size_t)(t + 2) * kstep;
            const char* a3 = a2 + kstep; const char* b3 = b2 + kstep;
            if (last && has_next) S.a_ready(nxt);
            if constexpr (SP2) {
            PG8_LDB(B0, 0, 0); PG8_LDB(B1, 0, 1); PG8_SCHED; PG8_LDA(At, 0, 0); PG8_STAGE_A(PG8_SA(1, 1), a1, 1, false);
            PG8_WAIT_V(8); PG8_WAIT_L(0); PG8_BAR; PG8_MMA(0, 0, At, B0); PG8_MMA(0, 1, At, B1); PG8_BAR; PG8_SCHED;
            PG8_LDA(At, 0, 1); PG8_STAGE(PG8_SB(0, 0), b2, voffB); PG8_STAGE(PG8_SB(0, 1), b2 + hstep, voffB); PG8_STAGE_A(PG8_SA(0, 0), a2, 0, last);
            PG8_WAIT_V(8); PG8_WAIT_L(0); PG8_BAR; PG8_MMA(1, 0, At, B0); PG8_MMA(1, 1, At, B1); PG8_BAR; PG8_SCHED;
            PG8_LDB(B0, 1, 0); PG8_LDB(B1, 1, 1); PG8_SCHED; PG8_LDA(At, 1, 0); PG8_STAGE_A(PG8_SA(0, 1), a2, 1, last);
            PG8_WAIT_V(8); PG8_WAIT_L(0); PG8_BAR; PG8_MMA(0, 0, At, B0); PG8_MMA(0, 1, At, B1); PG8_BAR; PG8_SCHED;
            PG8_LDA(At, 1, 1); PG8_STAGE(PG8_SB(1, 0), b3, voffB); PG8_STAGE(PG8_SB(1, 1), b3 + hstep, voffB); PG8_STAGE_A(PG8_SA(1, 0), a3, 0, last);
            PG8_WAIT_V(8); PG8_WAIT_L(0); PG8_BAR; PG8_MMA(1, 0, At, B0); PG8_MMA(1, 1, At, B1); PG8_BAR; PG8_SCHED;
            } else {
            PG8_LDB(B0, 0, 0); PG8_SCHED; PG8_LDA(At, 0, 0); PG8_STAGE_A(PG8_SA(1, 1), a1, 1, false);
            PG8_WAIT_L(8); PG8_BAR; PG8_WAIT_L(0); PG8_MMA(0, 0, At, B0); PG8_BAR; PG8_SCHED;
            PG8_LDB(B1, 0, 1); PG8_STAGE(PG8_SB(0, 0), b2, voffB);
            PG8_BAR; PG8_WAIT_L(0); PG8_MMA(0, 1, At, B1); PG8_BAR;
            PG8_LDA(At, 0, 1); PG8_STAGE_A(PG8_SA(0, 0), a2, 0, last);
            PG8_BAR; PG8_WAIT_L(0); PG8_MMA(1, 0, At, B0); PG8_BAR; PG8_SCHED;
            PG8_STAGE(PG8_SB(0, 1), b2 + hstep, voffB);
            PG8_WAIT_V(6); PG8_BAR; PG8_MMA(1, 1, At, B1); PG8_BAR;
            PG8_LDB(B0, 1, 0); PG8_SCHED; PG8_LDA(At, 1, 0); PG8_STAGE_A(PG8_SA(0, 1), a2, 1, last);
            PG8_WAIT_L(8); PG8_BAR; PG8_WAIT_L(0); PG8_MMA(0, 0, At, B0); PG8_BAR; PG8_SCHED;
            PG8_LDB(B1, 1, 1); PG8_STAGE(PG8_SB(1, 0), b3, voffB);
            PG8_BAR; PG8_WAIT_L(0); PG8_MMA(0, 1, At, B1); PG8_BAR;
            PG8_LDA(At, 1, 1); PG8_STAGE_A(PG8_SA(1, 0), a3, 0, last);
            PG8_BAR; PG8_WAIT_L(0); PG8_MMA(1, 0, At, B0); PG8_BAR; PG8_SCHED;
            PG8_STAGE(PG8_SB(1, 1), b3 + hstep, voffB);
            PG8_WAIT_V(6); PG8_BAR; PG8_MMA(1, 1, At, B1); PG8_BAR;
            }
        }
        if constexpr (ALIGN_EPI) { if (wr == 0) PG8_BAR; }
        if constexpr (!Epi::AFTER_DRAIN) { E(acc, cur, wr, wc, fr, fq); S.done(cur); }
        if (!has_next) break;
#pragma unroll
        for (int a = 0; a < 2; ++a)
#pragma unroll
            for (int b = 0; b < 2; ++b)
#pragma unroll
                for (int m = 0; m < 4; ++m)
#pragma unroll
                    for (int n = 0; n < 2; ++n) acc[a][b][m][n] = (f32x4){0.f, 0.f, 0.f, 0.f};
        cur = nxt; cA = nA; cB = nB; ++ui;
        if (MODE == 0) { cvA[0][0] = nvA[0][0]; cvA[0][1] = nvA[0][1]; cvA[1][0] = nvA[1][0]; cvA[1][1] = nvA[1][1]; }
        if constexpr (ALIGN_EPI) { if (wr == 1) PG8_BAR; }
    }
    PG8_WAIT_V(0);
    if constexpr (!ALIGN_EPI) { if (wr == 0) PG8_BAR; }
    PG8_BAR;
    if constexpr (Epi::AFTER_DRAIN) { E.fused(acc, cur, wr, wc, fr, fq, lds, wid, lane); S.done(cur); }
#undef PG8_SA
#undef PG8_SB
#undef PG8_STAGE
#undef PG8_STAGE_A
#undef PG8_LDA
#undef PG8_LDB
#undef PG8_MMA
#undef PG8_WAIT_V
#undef PG8_WAIT_L
#undef PG8_BAR
#undef PG8_SCHED
}
}
namespace pg8 {
__device__ __forceinline__ float fast_sigmoid(float x) { return __builtin_amdgcn_rcpf(1.f + __expf(-x)); }
__device__ __forceinline__ float fast_gelu_tanh(float x) { const float t = 1.5957691216057308f * (x + 0.044715f * x * x * x); return x * __builtin_amdgcn_rcpf(1.f + __expf(-t)); }
__device__ __forceinline__ u32x4 pack8(const f32x4 a, const f32x4 b) { u32x4 w; w.x = cvt_pk_bf16(a[0], a[1]); w.y = cvt_pk_bf16(a[2], a[3]); w.z = cvt_pk_bf16(b[0], b[1]); w.w = cvt_pk_bf16(b[2], b[3]); return w; }

struct EpiProj {
    static constexpr bool PERM = true, AFTER_DRAIN = false;
    const float* rs1; const float* bg; const float* qg; const float* kg; const float* cosT; const float* sinT;
    bf16_t *QP, *KP, *VB, *LRX, *LRG, *GA, *GL;
    __device__ __forceinline__ void operator()(const f32x4 (&acc)[2][2][4][2], const Unit& u, int wr, int wc, int fr, int fq) const {
        const int type = u.pn >> 2;
        const int rowt = u.pm * BM + wr * 64 + fr;
        const int b = (u.pm * BM) >> 12;
        if (type <= 1) {
            const bool isq = (type == 0);
            const float* gsrc = isq ? qg : kg;
            f32x4 g[2][2];
#pragma unroll
            for (int bj = 0; bj < 2; ++bj)
#pragma unroll
                for (int n = 0; n < 2; ++n) g[bj][n] = *(const f32x4*)(gsrc + 32 * bj + 8 * fq + 4 * n);
            const int hc = (u.pn & 3) * 4 + wc;
            bf16_t* dstbase = (isq ? QP : KP) + ((size_t)(b * 16 + hc) * 4096) * 64 + 8 * fq;
            const float osc = isq ? (0.125f * 1.4426950408889634f) : 1.f;
#pragma unroll
            for (int ai = 0; ai < 2; ++ai)
#pragma unroll
                for (int m = 0; m < 4; ++m) {
                    const int row = rowt + ai * HALF + m * 16; const int pos = row & 4095; const float rsv = rs1[row];
                    f32x4 v[2][2]; float ss = 0.f;
#pragma unroll
                    for (int bj = 0; bj < 2; ++bj)
#pragma unroll
                        for (int n = 0; n < 2; ++n) { v[bj][n] = acc[ai][bj][m][n] * rsv; const f32x4 q = v[bj][n] * v[bj][n]; ss += (q[0] + q[1]) + (q[2] + q[3]); }
                    ss += __shfl_xor(ss, 16); ss += __shfl_xor(ss, 32);
                    const float rn = rsqrtf(ss * (1.f / 64.f) + 1e-6f);
                    f32x4 o0[2], o1[2];
#pragma unroll
                    for (int n = 0; n < 2; ++n) {
                        const f32x4 c = *(const f32x4*)(cosT + pos * 32 + 8 * fq + 4 * n), s = *(const f32x4*)(sinT + pos * 32 + 8 * fq + 4 * n);
                        const f32x4 y0 = v[0][n] * rn * g[0][n], y1 = v[1][n] * rn * g[1][n];
                        o0[n] = (y0 * c - y1 * s) * osc; o1[n] = (y0 * s + y1 * c) * osc;
                    }
                    bf16_t* dst = dstbase + (size_t)pos * 64;
                    *(u32x4*)dst = pack8(o0[0], o0[1]);
                    *(u32x4*)(dst + 32) = pack8(o1[0], o1[1]);
                }
        } else {
            const int colt = (u.pn & 3) * 256 + wc * 32 + 8 * fq;
#pragma unroll
            for (int ai = 0; ai < 2; ++ai)
#pragma unroll
                for (int m = 0; m < 4; ++m) {
                    const int row = rowt + ai * HALF + m * 16; const int pos = row & 4095; const float rsv = rs1[row];
#pragma unroll
                    for (int bj = 0; bj < 2; ++bj) {
                        const int col = colt + 128 * bj;
                        f32x4 v0 = acc[ai][bj][m][0] * rsv, v1 = acc[ai][bj][m][1] * rsv;
                        bf16_t* dst;
                        if (type == 2) { dst = VB + ((size_t)((b * 8 + (col >> 7)) * 4096 + pos)) * 128 + (col & 127); }
                        else if (type == 3) { dst = LRX + (size_t)row * 1024 + col; }
                        else if (type == 4) {
                            dst = LRG + (size_t)row * 1024 + col;
#pragma unroll
                            for (int j = 0; j < 4; ++j) { v0[j] = fast_gelu_tanh(v0[j]); v1[j] = fast_gelu_tanh(v1[j]); }
                        } else {
                            const float* bp = bg + (type == 6 ? 1024 : 0) + col;
                            const f32x4 b0 = *(const f32x4*)bp, b1 = *(const f32x4*)(bp + 4);
                            dst = (type == 5 ? GA : GL) + (size_t)row * 1024 + col;
#pragma unroll
                            for (int j = 0; j < 4; ++j) { v0[j] = fast_sigmoid(v0[j] + b0[j]); v1[j] = fast_sigmoid(v1[j] + b1[j]); }
                        }
                        *(u32x4*)dst = pack8(v0, v1);
                    }
                }
        }
    }
};
__device__ __forceinline__ void unpack8(const u32x4 w, f32x4& a, f32x4& b) {
    a[0] = __uint_as_float(w.x << 16); a[1] = __uint_as_float(w.x & 0xffff0000u); a[2] = __uint_as_float(w.y << 16); a[3] = __uint_as_float(w.y & 0xffff0000u);
    b[0] = __uint_as_float(w.z << 16); b[1] = __uint_as_float(w.z & 0xffff0000u); b[2] = __uint_as_float(w.w << 16); b[3] = __uint_as_float(w.w & 0xffff0000u);
}
template <int PASS> struct EpiMerge {
    static constexpr bool PERM = true, AFTER_DRAIN = false;
    bf16_t* M; const bf16_t* G;
    __device__ __forceinline__ void operator()(const f32x4 (&acc)[2][2][4][2], const Unit& u, int wr, int wc, int fr, int fq) const {
        const int row0 = u.pm * BM + wr * 64 + fr, col0 = u.pn * BM + wc * 32 + 8 * fq;
#pragma unroll
        for (int ai = 0; ai < 2; ++ai)
#pragma unroll
            for (int m = 0; m < 4; ++m)
#pragma unroll
                for (int bj = 0; bj < 2; ++bj) {
                    const size_t idx = (size_t)(row0 + ai * HALF + m * 16) * 1024 + col0 + bj * HALF;
                    f32x4 g0, g1; unpack8(*(const u32x4*)(G + idx), g0, g1);
                    f32x4 v0 = acc[ai][bj][m][0] * g0, v1 = acc[ai][bj][m][1] * g1;
                    if (PASS == 2) { f32x4 t0, t1; unpack8(*(const u32x4*)(M + idx), t0, t1); v0 += t0; v1 += t1; }
                    *(u32x4*)(M + idx) = pack8(v0, v1);
                }
    }
};
struct EpiResid {
    static constexpr bool PERM = false, AFTER_DRAIN = false;
    const float* X; float* O;
    __device__ __forceinline__ void operator()(const f32x4 (&acc)[2][2][4][2], const Unit& u, int wr, int wc, int fr, int fq) const {
        const int row0 = u.pm * BM + wr * 64 + fr, col0 = u.pn * BM + wc * 32 + 4 * fq;
#pragma unroll
        for (int ai = 0; ai < 2; ++ai)
#pragma unroll
            for (int m = 0; m < 4; ++m)
#pragma unroll
                for (int bj = 0; bj < 2; ++bj)
#pragma unroll
                    for (int n = 0; n < 2; ++n) {
                        const size_t idx = (size_t)(row0 + ai * HALF + m * 16) * 1024 + col0 + bj * HALF + n * 16;
                        *(f32x4*)(O + idx) = *(const f32x4*)(X + idx) + acc[ai][bj][m][n];
                    }
    }
};
}

constexpr int NWAVES = 8;
constexpr int RING_OFF = 0, RING_BYTES = 131072;
constexpr int LDSCTL_OFF = RING_BYTES, MISC_OFF = LDSCTL_OFF + 320;
constexpr int LDS_BYTES = 147456;
constexpr size_t WS_CTL = WS_S7, CTL_ZERO_BYTES = 1 * MiB;
constexpr size_t WS_SEL_E = WS_S7 + 1 * MiB, WS_SEL_W = WS_S7 + 2 * MiB;
constexpr size_t WS_RS1 = WS_S7 + 3 * MiB;
constexpr size_t WS_COS = WS_S7 + 3 * MiB + 512 * 1024, WS_SIN = WS_S7 + 4 * MiB;
constexpr size_t WS_WINT = WS_S7 + 5 * MiB;
constexpr size_t WS_WAT = WS_S7 + 19 * MiB, WS_WLT = WS_S7 + 21 * MiB, WS_WOT = WS_S7 + 23 * MiB;
constexpr size_t WS_LRUW = WS_S7 + 25 * MiB;
constexpr size_t WS_LRUS = WS_S7 + 26 * MiB;
constexpr size_t WS_LIST = WS_S7 + 30 * MiB;
constexpr int CW_BAR = 4096, CW_CNT = 8192;

#define GAS __attribute__((address_space(1)))
#define LAS __attribute__((address_space(3)))
typedef unsigned v4u __attribute__((ext_vector_type(4)));
typedef float f32x4 __attribute__((ext_vector_type(4)));
typedef GAS unsigned gu32;
typedef GAS unsigned long long gu64;
#define RLX_AGENT __ATOMIC_RELAXED, __HIP_MEMORY_SCOPE_AGENT
#define LDS_WAIT() asm volatile("s_waitcnt lgkmcnt(0)" ::: "memory")
#define VM_WAIT() asm volatile("s_waitcnt vmcnt(0)" ::: "memory")
__device__ __forceinline__ unsigned pk2(float lo, float hi) { return (unsigned)f2bf(lo) | ((unsigned)f2bf(hi) << 16); }
namespace pg8 {
struct GroupedOrder {
    const PG8_LAS int* tb;
    const int* listT;
    int G, c, nct;
    __device__ __forceinline__ bool next(int i, GUnit& u) const {
        const int L = i * G + c; const int Tn = __builtin_amdgcn_readfirstlane(tb[16]);
        if (L >= Tn * nct) return false;
        const int rt = L / nct; u.pn = L % nct; u.pm = rt;
        int e = 0;
#pragma unroll
        for (int k = 1; k < 16; ++k) e += (rt >= __builtin_amdgcn_readfirstlane(tb[k])) ? 1 : 0;
        u.e = e; u.pos0 = (rt - __builtin_amdgcn_readfirstlane(tb[e])) * 256; u.cnt = __builtin_amdgcn_readfirstlane(tb[32 + e]);
        return true;
    }
    __device__ __forceinline__ void rows(const GUnit& u, const unsigned (&voffA)[2], unsigned (&out)[2][2]) const {
#pragma unroll
        for (int h = 0; h < 2; ++h)
#pragma unroll
            for (int i = 0; i < 2; ++i) {
                const int R = (int)(voffA[i] >> 11) + 128 * h, pos = u.pos0 + R;
                const int tok = (pos < u.cnt) ? (listT[u.e * 16384 + pos] >> 1) : 0;
                out[h][i] = (unsigned)tok * 2048u + (voffA[i] & 2047u);
            }
    }
    __device__ __forceinline__ void a_ready(const GUnit&) const {}
    __device__ __forceinline__ void done(const GUnit&) const {}
};
struct EpiUp {
    static constexpr bool PERM = true, AFTER_DRAIN = false;
    bf16_t* HID; const float* listW;
    __device__ __forceinline__ void operator()(const f32x4 (&acc)[2][2][4][2], const GUnit& u, int wr, int wc, int fr, int fq) const {
        const int f0 = u.pn * 128 + wc * 32 + 8 * fq;
#pragma unroll
        for (int ai = 0; ai < 2; ++ai)
#pragma unroll
            for (int m = 0; m < 4; ++m) {
                const int r = ai * HALF + wr * 64 + m * 16 + fr, pos = u.pos0 + r;
                const float w = (pos < u.cnt) ? listW[u.e * 16384 + pos] : 0.f;
                f32x4 h0, h1;
#pragma unroll
                for (int j = 0; j < 4; ++j) {
                    const float g0 = acc[ai][0][m][0][j], g1 = acc[ai][0][m][1][j];
                    h0[j] = g0 * __builtin_amdgcn_rcpf(1.f + __expf(-g0)) * acc[ai][1][m][0][j] * w;
                    h1[j] = g1 * __builtin_amdgcn_rcpf(1.f + __expf(-g1)) * acc[ai][1][m][1][j] * w;
                }
                *(u32x4*)(HID + (size_t)(u.pm * BM + r) * 512 + f0) = pack8(h0, h1);
            }
    }
};
struct EpiDown {
    static constexpr bool PERM = true, AFTER_DRAIN = false;
    bf16_t* Y0; size_t ystride; const int* listT;
    __device__ __forceinline__ void operator()(const f32x4 (&acc)[2][2][4][2], const GUnit& u, int wr, int wc, int fr, int fq) const {
        const int col0 = u.pn * BM + wc * 32 + 8 * fq;
#pragma unroll
        for (int ai = 0; ai < 2; ++ai)
#pragma unroll
            for (int m = 0; m < 4; ++m) {
                const int r = ai * HALF + wr * 64 + m * 16 + fr, pos = u.pos0 + r;
                if (pos < u.cnt) {
                    const int ent = listT[u.e * 16384 + pos];
                    bf16_t* Y = Y0 + (size_t)(ent & 1) * ystride + (size_t)(ent >> 1) * 1024 + col0;
                    *(u32x4*)Y = pack8(acc[ai][0][m][0], acc[ai][0][m][1]);
                    *(u32x4*)(Y + HALF) = pack8(acc[ai][1][m][0], acc[ai][1][m][1]);
                }
            }
    }
};
}
namespace att {
using bf16x8 = __attribute__((ext_vector_type(8))) short;
using s16x4  = __attribute__((ext_vector_type(4))) short;
using f32x16 = __attribute__((ext_vector_type(16))) float;
using u32x4  = __attribute__((ext_vector_type(4))) unsigned;
constexpr int NW = 8, QBLK = 32, KVBLK = 64;
constexpr int SHM_K = KVBLK * 64 * 2, SHM_V = KVBLK * 128 * 2;
constexpr int NSLOT = 3;
constexpr int LDS_V = 0, LDS_K = NSLOT * SHM_V, LDS_WS = LDS_K + NSLOT * SHM_K, LDS_OST = 0  , LDS_END = LDS_WS + NW * 256;
static_assert(NW * 8192 <= LDS_WS, "O stage fits under the rings");
static_assert(LDS_END <= 131072, "attention LDS");
#define ATT_KSWZ(row, c16) ((c16) * 1024 + (row) * 16)
#define ATT_SBAR() __builtin_amdgcn_sched_barrier(0)
__device__ __forceinline__ int crow(int r, int hi) { return (r & 3) + 8 * (r >> 2) + 4 * hi; }
__device__ __forceinline__ unsigned cvtpk(float lo, float hi) { unsigned r; asm volatile("v_cvt_pk_bf16_f32 %0, %1, %2" : "=v"(r) : "v"(lo), "v"(hi)); return r; }

__device__ __forceinline__ void partialSM(f32x16& p0) {
#pragma unroll
  for (int r = 0; r < 16; ++r) p0[r] = __builtin_amdgcn_exp2f(p0[r]);
}
__device__ __forceinline__ void finishSM(f32x16& p0, f32x16& p1, float& l_reg, bf16x8& pa0, bf16x8& pa1, bf16x8& pa2, bf16x8& pa3) {
#pragma unroll
  for (int r = 0; r < 16; ++r) p1[r] = __builtin_amdgcn_exp2f(p1[r]);
  float ps = 0.f;
#pragma unroll
  for (int r = 0; r < 16; ++r) ps += p0[r];
#pragma unroll
  for (int r = 0; r < 16; ++r) ps += p1[r];
  l_reg += ps;
#define ATT_PK4(P, BASE, OUT) do { unsigned a0 = cvtpk(P[BASE + 0], P[BASE + 1]), a1 = cvtpk(P[BASE + 2], P[BASE + 3]);   \
    unsigned b0 = cvtpk(P[BASE + 4], P[BASE + 5]), b1 = cvtpk(P[BASE + 6], P[BASE + 7]);                              \
    auto r0 = __builtin_amdgcn_permlane32_swap(a0, b0, false, false); auto r1 = __builtin_amdgcn_permlane32_swap(a1, b1, false, false); \
    u32x4 w = {r0[0], r1[0], r0[1], r1[1]}; OUT = *reinterpret_cast<bf16x8*>(&w); } while (0)
  ATT_PK4(p0, 0, pa0); ATT_PK4(p0, 8, pa1); ATT_PK4(p1, 0, pa2); ATT_PK4(p1, 8, pa3);
#undef ATT_PK4
}
__device__ __forceinline__ void qkt(f32x16& p0, f32x16& p1, const char* Ks, const bf16x8* qr, int r32, int hi) {
  p0 = f32x16{}; p1 = f32x16{};
#pragma unroll
  for (int d0 = 0; d0 < 4; ++d0) { const int c16 = d0 * 2 + hi;
    const bf16x8 b0 = *reinterpret_cast<const bf16x8*>(Ks + ATT_KSWZ(r32, c16));
    const bf16x8 b1 = *reinterpret_cast<const bf16x8*>(Ks + ATT_KSWZ(32 + r32, c16));
    p0 = __builtin_amdgcn_mfma_f32_32x32x16_bf16(b0, qr[d0], p0, 0, 0, 0);
    p1 = __builtin_amdgcn_mfma_f32_32x32x16_bf16(b1, qr[d0], p1, 0, 0, 0); }
}
__device__ __forceinline__ int v_st(int k, int c) { const int kk = (k & ~0xC) | ((k & 4) << 1) | ((k & 8) >> 1); return ((kk >> 3) * 4 + (c >> 5)) * 512 + ((kk & 7) * 32 + (c & 31)) * 2; }
__device__ __forceinline__ int v_rd_base(int lane) { return ((lane & 3) << 3) | (((lane >> 2) & 3) << 6) | (((lane >> 4) & 1) << 5) | (((lane >> 5) & 1) << 8); }
constexpr int v_rd_off(int d0, int ks, int half) { return d0 * 512 + ks * 4096 + half * 2048; }
template <int OFF> __device__ __forceinline__ s16x4 tr_read(int vb) {
  s16x4 r; asm volatile("ds_read_b64_tr_b16 %0, %1 offset:%2" : "=&v"(r) : "v"(vb), "i"(OFF) : "memory"); return r;
}
template <int D0> __device__ __forceinline__ void pv_one(f32x16& od, int vb, bf16x8 pa0, bf16x8 pa1, bf16x8 pa2, bf16x8 pa3) {
  const s16x4 l0 = tr_read<v_rd_off(D0, 0, 0)>(vb), h0 = tr_read<v_rd_off(D0, 0, 1)>(vb), l1 = tr_read<v_rd_off(D0, 1, 0)>(vb), h1 = tr_read<v_rd_off(D0, 1, 1)>(vb);
  const s16x4 l2 = tr_read<v_rd_off(D0, 2, 0)>(vb), h2 = tr_read<v_rd_off(D0, 2, 1)>(vb), l3 = tr_read<v_rd_off(D0, 3, 0)>(vb), h3 = tr_read<v_rd_off(D0, 3, 1)>(vb);
  asm volatile("s_waitcnt lgkmcnt(0)" ::: "memory"); ATT_SBAR();
#define ATT_PK(L, H) (bf16x8){L[0], L[1], L[2], L[3], H[0], H[1], H[2], H[3]}
  od = __builtin_amdgcn_mfma_f32_32x32x16_bf16(pa0, ATT_PK(l0, h0), od, 0, 0, 0);
  od = __builtin_amdgcn_mfma_f32_32x32x16_bf16(pa1, ATT_PK(l1, h1), od, 0, 0, 0);
  od = __builtin_amdgcn_mfma_f32_32x32x16_bf16(pa2, ATT_PK(l2, h2), od, 0, 0, 0);
  od = __builtin_amdgcn_mfma_f32_32x32x16_bf16(pa3, ATT_PK(l3, h3), od, 0, 0, 0);
#undef ATT_PK
}
__device__ __forceinline__ void pv_d0(f32x16* o, int vb, bf16x8 pa0, bf16x8 pa1, bf16x8 pa2, bf16x8 pa3) {
  pv_one<0>(o[0], vb, pa0, pa1, pa2, pa3); pv_one<1>(o[1], vb, pa0, pa1, pa2, pa3); pv_one<2>(o[2], vb, pa0, pa1, pa2, pa3); pv_one<3>(o[3], vb, pa0, pa1, pa2, pa3);
}

__device__ __forceinline__ void glds16(const void* gsrc, unsigned lds_dst) { unsigned keep;
  asm volatile("s_mov_b32 %0, m0\n\ts_mov_b32 m0, %2\n\ts_nop 0\n\tglobal_load_lds_dwordx4 %1, off\n\ts_mov_b32 m0, %0" : "=&s"(keep) : "v"(gsrc), "s"(lds_dst) : "memory"); }
#define ATT_WAIT_BAR(N) asm volatile("s_waitcnt vmcnt(" #N ") lgkmcnt(0)\n\ts_barrier" ::: "memory")
__device__ __forceinline__ void attn_unit(const bf16_t* __restrict__ Qb, const bf16_t* __restrict__ Kh, const bf16_t* __restrict__ Vh, bf16_t* __restrict__ Ob, char* lds) {
  const int tid = threadIdx.x, lane = tid & 63, r32 = lane & 31, hi = lane >> 5; const int wid = __builtin_amdgcn_readfirstlane(tid >> 6);
  char* V_lds = lds + LDS_V; char* K_lds = lds + LDS_K;
  float* wsf = (float*)(lds + LDS_WS) + wid * 64;
  float l_reg = 0.f; f32x16 o[4] = {}; bf16x8 qr[4];
  const unsigned lds0 = (unsigned)(uintptr_t)lds;
  const bf16_t* ksrc = Kh + (size_t)lane * 64 + wid * 8;
  const unsigned kdst = lds0 + LDS_K + wid * 1024;
  const bf16_t* vsrc[2]; unsigned vdst[2];
#pragma unroll
  for (int i = 0; i < 2; ++i) { const int q = 2 * wid + i, kk = (q >> 1) * 8 + ((lane >> 2) & 7), k = (kk & ~0xC) | ((kk & 4) << 1) | ((kk & 8) >> 1), c = (2 * (q & 1) + (lane >> 5)) * 32 + (lane & 3) * 8;
    vsrc[i] = Vh + (size_t)k * 128 + c; vdst[i] = lds0 + LDS_V + q * 1024; }
#define ATT_DMA_K(t, slot) glds16(ksrc + (size_t)(t) * (KVBLK * 64), (unsigned)__builtin_amdgcn_readfirstlane(kdst + (slot) * SHM_K))
#define ATT_DMA_V(t, slot) do { glds16(vsrc[0] + (size_t)(t) * (KVBLK * 128), (unsigned)__builtin_amdgcn_readfirstlane(vdst[0] + (slot) * SHM_V)); \
                                glds16(vsrc[1] + (size_t)(t) * (KVBLK * 128), (unsigned)__builtin_amdgcn_readfirstlane(vdst[1] + (slot) * SHM_V)); } while (0)
  asm volatile("s_waitcnt lgkmcnt(0)\n\ts_barrier" ::: "memory");
  ATT_DMA_K(0, 0);
  ATT_DMA_K(1, 1); ATT_DMA_V(0, 0);
  const bf16_t* Qw = Qb + (size_t)(wid * QBLK + r32) * 64 + hi * 8;
#pragma unroll
  for (int d0 = 0; d0 < 4; ++d0) qr[d0] = *reinterpret_cast<const bf16x8*>(Qw + d0 * 16);
  const int vb0 = (int)(uintptr_t)V_lds + v_rd_base(lane);
  f32x16 pA0, pA1, pB0, pB1; bf16x8 pa0, pa1, pa2, pa3; constexpr int NT = 4096 / KVBLK;
  ATT_WAIT_BAR(3);
  ATT_DMA_K(2, 2); ATT_DMA_V(1, 1);
  qkt(pA0, pA1, K_lds, qr, r32, hi); partialSM(pA0);
  ATT_WAIT_BAR(3);
  int sk = 1, sv = 0;
#define ATT_ROT() do { sk = (sk == NSLOT - 1) ? 0 : sk + 1; sv = (sv == NSLOT - 1) ? 0 : sv + 1; } while (0)
#define ATT_STEP(PC0, PC1, PP0, PP1, j, ISSUE) do { \
    if (ISSUE) { const int sn_k = (sk == 0) ? NSLOT - 1 : sk - 1, sn_v = (sv == NSLOT - 1) ? 0 : sv + 1; const int sn_v2 = (sn_v == NSLOT - 1) ? 0 : sn_v + 1; \
      ATT_DMA_K((j) + 2, sn_k); ATT_DMA_V((j) + 1, sn_v2); } \
    ATT_SBAR(); qkt(PC0, PC1, K_lds + sk * SHM_K, qr, r32, hi); \
    finishSM(PP0, PP1, l_reg, pa0, pa1, pa2, pa3); ATT_SBAR(); \
    pv_d0(o, vb0 + sv * SHM_V, pa0, pa1, pa2, pa3); partialSM(PC0); } while (0)
  int j = 1;
  for (; j + 3 < NT; j += 2) {
    ATT_STEP(pB0, pB1, pA0, pA1, j, true);     ATT_WAIT_BAR(3); ATT_ROT();
    ATT_STEP(pA0, pA1, pB0, pB1, j + 1, true); ATT_WAIT_BAR(3); ATT_ROT();
  }
  ATT_STEP(pB0, pB1, pA0, pA1, j, true);       ATT_WAIT_BAR(3); ATT_ROT();
  { const int sn_v = (sv == NSLOT - 1) ? 0 : sv + 1; const int sn_v2 = (sn_v == NSLOT - 1) ? 0 : sn_v + 1; ATT_DMA_V(NT - 1, sn_v2); }
  ATT_STEP(pA0, pA1, pB0, pB1, j + 1, false);  ATT_WAIT_BAR(2); ATT_ROT();
  ATT_STEP(pB0, pB1, pA0, pA1, j + 2, false);  ATT_WAIT_BAR(0); ATT_ROT();
  finishSM(pB0, pB1, l_reg, pa0, pa1, pa2, pa3); ATT_SBAR();
  pv_d0(o, vb0 + sv * SHM_V, pa0, pa1, pa2, pa3);
  { auto rr = __builtin_amdgcn_permlane32_swap(__float_as_uint(l_reg), __float_as_uint(l_reg), false, false); l_reg = __uint_as_float(rr[0]) + __uint_as_float(rr[1]); }
  if (hi == 0) wsf[r32] = l_reg; asm volatile("s_waitcnt lgkmcnt(0)" ::: "memory");
  float rli[16];
#pragma unroll
  for (int r = 0; r < 16; ++r) rli[r] = __builtin_amdgcn_rcpf(wsf[crow(r, hi)]);
  asm volatile("s_waitcnt lgkmcnt(0)\n\ts_barrier" ::: "memory");
  bf16_t* stg = (bf16_t*)(lds + LDS_OST) + wid * 4096;
#pragma unroll
  for (int r = 0; r < 16; ++r) { const int orow = crow(r, hi);
#pragma unroll
    for (int d0 = 0; d0 < 4; ++d0) stg[orow * 128 + d0 * 32 + r32] = f2bf(o[d0][r] * rli[r]); }
  asm volatile("s_waitcnt lgkmcnt(0)" ::: "memory");
  bf16_t* Ow = Ob + (size_t)(wid * QBLK) * 1024;
#pragma unroll
  for (int i = 0; i < 8; ++i) { const int row = i * 4 + (lane >> 4), ch = lane & 15; const u32x4 v = *(const u32x4*)(stg + row * 128 + ch * 8); *(u32x4*)(Ow + (size_t)row * 1024 + ch * 8) = v; }
#undef ATT_DMA_K
#undef ATT_DMA_V
#undef ATT_ROT
#undef ATT_STEP
}
}
namespace lru {
using bf16x8 = __attribute__((ext_vector_type(8))) short;
using f32x16 = __attribute__((ext_vector_type(16))) float;
using u32x4  = __attribute__((ext_vector_type(4))) unsigned;
typedef float f32x4_t __attribute__((ext_vector_type(4)));
constexpr int T = 64, NCH = 4096 / T;
constexpr int LDS_XR = 0, LDS_H = 16384, LDS_CAR = LDS_H + 2 * T * 128 * 4, LDS_CW = LDS_CAR + 2 * 16 * 128 * 4, LDS_END = LDS_CW + 640 * 4;
#define LRU_XSWZ(row, c16) ((row) * 256 + ((((c16) ^ (row)) & 15) << 4))
__device__ __forceinline__ int crow(int r, int hi) { return (r & 3) + 8 * (r >> 2) + 4 * hi; }
__device__ __forceinline__ float fsig(float x) { return __builtin_amdgcn_rcpf(1.f + __expf(-x)); }

template <int DIR, bool APPLY>
__device__ __forceinline__ void scan(f32x16 (&a)[2], f32x16 (&u)[2], float cin, int hi, float& Ptot, float& Hend) {
  float P[2][4], H[2][4], Pp[2][4], Hp[2][4];
#pragma unroll
  for (int rt = 0; rt < 2; ++rt)
#pragma unroll
    for (int q = 0; q < 4; ++q) {
      float p = 1.f, h = 0.f;
#pragma unroll
      for (int ii = 0; ii < 4; ++ii) { const int r = 4 * q + (DIR ? 3 - ii : ii); h = a[rt][r] * h + u[rt][r]; p *= a[rt][r]; }
      P[rt][q] = p; H[rt][q] = h;
      Pp[rt][q] = __shfl_xor(p, 32); Hp[rt][q] = __shfl_xor(h, 32);
    }
  float c = cin, pt = 1.f; float myc[2][4];
  const bool first = (hi == (DIR ? 1 : 0));
#pragma unroll
  for (int gg = 0; gg < 8; ++gg) {
    const int rt = DIR ? 1 - (gg >> 2) : (gg >> 2), q = DIR ? 3 - (gg & 3) : (gg & 3);
    const float Pf = first ? P[rt][q] : Pp[rt][q], Hf = first ? H[rt][q] : Hp[rt][q];
    const float Ps = first ? Pp[rt][q] : P[rt][q], Hs = first ? Hp[rt][q] : H[rt][q];
    const float c0 = c; c = Pf * c + Hf; const float c1 = c; c = Ps * c + Hs; pt *= Pf * Ps;
    myc[rt][q] = first ? c0 : c1;
  }
  Ptot = pt; Hend = c;
  if (APPLY) {
#pragma unroll
    for (int rt = 0; rt < 2; ++rt)
#pragma unroll
      for (int q = 0; q < 4; ++q) {
        float h = myc[rt][q];
#pragma unroll
        for (int ii = 0; ii < 4; ++ii) { const int r = 4 * q + (DIR ? 3 - ii : ii); h = a[rt][r] * h + u[rt][r]; u[rt][r] = h; }
      }
  }
}

struct Params {
  const bf16_t* LRX; const bf16_t* LRG; const bf16_t* Wt; const float* conv_w; const float* conv_b;
  const float* ba; const float* bi; const float* lam; float* SUM; bf16_t* YL;
};

template <int PASS>
__device__ __forceinline__ void lru_phase(const Params& p, char* lds, int vcu, int G) {
  const int tid = threadIdx.x, wid = tid >> 6, lane = tid & 63, r32 = lane & 31, hi = lane >> 5;
  const int dir = wid >> 2, cq = wid & 3;
  const int blk = vcu & 7, idx = vcu >> 3, nper = (NB * NCH) / (G >> 3);
  const int e = cq * 32 + r32, ch = blk * 128 + e;
  const int un0 = idx * nper, b = un0 / NCH, chunk0 = un0 % NCH;
  const size_t rowb = (size_t)b * 4096;
  bf16x8 wb[2][8];
#pragma unroll
  for (int g = 0; g < 2; ++g)
#pragma unroll
    for (int ks = 0; ks < 8; ++ks) wb[g][ks] = *reinterpret_cast<const bf16x8*>(p.Wt + ((size_t)((dir * 2 + g) * 8 + blk) * 128 + e) * 128 + ks * 16 + hi * 8);
  const float bav = p.ba[dir * 1024 + ch], biv = p.bi[dir * 1024 + ch];
  const float c8 = -8.f * log1pf(__expf(-p.lam[dir * 1024 + ch]));
  const int c8i = tid & 15, cc = blk * 128 + c8i * 8, trow = tid >> 4;
  float* CWL = (float*)(lds + LDS_CW);
  float* CAR = (float*)(lds + LDS_CAR);
  __syncthreads();
  for (int q = tid; q < 640; q += 512) CWL[q] = (q < 512) ? p.conv_w[(q >> 7) * 1024 + blk * 128 + (q & 127)] : p.conv_b[blk * 128 + (q & 127)];
  if (PASS == 2 && tid < 256) {
    const int d2 = tid >> 7, e2 = tid & 127; float c = 0.f;
    const float* sp = p.SUM + ((size_t)(b * NCH * 2 + d2) * 1024 + blk * 128 + e2) * 2;
    if (d2 == 0) {
#pragma unroll 8
      for (int j = 0; j < chunk0 + nper; ++j) { const float a_ = sp[(size_t)j * 4096], h_ = sp[(size_t)j * 4096 + 1]; if (j >= chunk0) CAR[(j - chunk0) * 128 + e2] = c; c = a_ * c + h_; }
    } else {
#pragma unroll 8
      for (int j = NCH - 1; j >= chunk0; --j) { const float a_ = sp[(size_t)j * 4096], h_ = sp[(size_t)j * 4096 + 1]; if (j < chunk0 + nper) CAR[(nper + j - chunk0) * 128 + e2] = c; c = a_ * c + h_; }
    }
  }
  bf16x8 xq[2][4];
#define LRU_LOADROWS(t0_) do { _Pragma("unroll") for (int pp = 0; pp < 2; ++pp) _Pragma("unroll") for (int j = 0; j < 4; ++j) { \
      const int ta = (t0_) + trow + 32 * pp - 1 + j; \
      xq[pp][j] = (ta >= 0 && ta < 4096) ? *reinterpret_cast<const bf16x8*>(p.LRX + (rowb + ta) * 1024 + cc) : bf16x8{0, 0, 0, 0, 0, 0, 0, 0}; } } while (0)
  LRU_LOADROWS(chunk0 * T);
  for (int i = 0; i < nper; ++i) {
    const int chunk = chunk0 + i, t0 = chunk * T;
    __syncthreads();
#pragma unroll
    for (int pp = 0; pp < 2; ++pp) {
      f32x4_t a0 = *(const f32x4_t*)(CWL + 512 + c8i * 8), a1 = *(const f32x4_t*)(CWL + 512 + c8i * 8 + 4);
#pragma unroll
      for (int j = 0; j < 4; ++j) {
        f32x4_t x0, x1;
#pragma unroll
        for (int k = 0; k < 4; ++k) { x0[k] = bf2f((bf16_t)xq[pp][j][k]); x1[k] = bf2f((bf16_t)xq[pp][j][4 + k]); }
        a0 += *(const f32x4_t*)(CWL + j * 128 + c8i * 8) * x0; a1 += *(const f32x4_t*)(CWL + j * 128 + c8i * 8 + 4) * x1;
      }
      u32x4 w; w.x = pk2(a0[0], a0[1]); w.y = pk2(a0[2], a0[3]); w.z = pk2(a1[0], a1[1]); w.w = pk2(a1[2], a1[3]);
      *(u32x4*)(lds + LDS_XR + LRU_XSWZ(trow + 32 * pp, c8i)) = w;
    }
    if (i + 1 < nper) LRU_LOADROWS(t0 + T);
    __syncthreads();
    f32x16 aA[2], aI[2];
    aA[0] = f32x16{}; aA[1] = f32x16{}; aI[0] = f32x16{}; aI[1] = f32x16{};
#pragma unroll
    for (int ks = 0; ks < 8; ++ks) {
      const int c16 = ks * 2 + hi;
      const bf16x8 x0 = *reinterpret_cast<const bf16x8*>(lds + LDS_XR + LRU_XSWZ(r32, c16));
      const bf16x8 x1 = *reinterpret_cast<const bf16x8*>(lds + LDS_XR + LRU_XSWZ(32 + r32, c16));
      aA[0] = __builtin_amdgcn_mfma_f32_32x32x16_bf16(x0, wb[0][ks], aA[0], 0, 0, 0);
      aA[1] = __builtin_amdgcn_mfma_f32_32x32x16_bf16(x1, wb[0][ks], aA[1], 0, 0, 0);
      aI[0] = __builtin_amdgcn_mfma_f32_32x32x16_bf16(x0, wb[1][ks], aI[0], 0, 0, 0);
      aI[1] = __builtin_amdgcn_mfma_f32_32x32x16_bf16(x1, wb[1][ks], aI[1], 0, 0, 0);
    }
#pragma unroll
    for (int rt = 0; rt < 2; ++rt)
#pragma unroll
      for (int r = 0; r < 16; ++r) {
        const int t = 32 * rt + crow(r, hi);
        const float xv = bf2f(*(const bf16_t*)(lds + LDS_XR + LRU_XSWZ(t, e >> 3) + (e & 7) * 2));
        const float rg = fsig(aA[rt][r] + bav), ig = fsig(aI[rt][r] + biv);
        const float a = __expf(c8 * rg);
        aA[rt][r] = a; aI[rt][r] = __builtin_amdgcn_sqrtf(1.f - a * a) * ig * xv;
      }
    float Ptot, Hend;
    if (PASS == 1) {
      if (dir == 0) scan<0, false>(aA, aI, 0.f, hi, Ptot, Hend); else scan<1, false>(aA, aI, 0.f, hi, Ptot, Hend);
      if (hi == 0) { float* s = p.SUM + ((size_t)((b * NCH + chunk) * 2 + dir) * 1024 + ch) * 2; s[0] = Ptot; s[1] = Hend; }
    } else {
      const float cin = CAR[(dir * nper + i) * 128 + e];
      if (dir == 0) scan<0, true>(aA, aI, cin, hi, Ptot, Hend); else scan<1, true>(aA, aI, cin, hi, Ptot, Hend);
      float* Hs = (float*)(lds + LDS_H) + dir * (T * 128);
#pragma unroll
      for (int rt = 0; rt < 2; ++rt)
#pragma unroll
        for (int r = 0; r < 16; ++r) Hs[(32 * rt + crow(r, hi)) * 128 + e] = aI[rt][r];
      __syncthreads();
#pragma unroll
      for (int pp = 0; pp < 2; ++pp) {
        const int t = trow + 32 * pp;
        const float* hf = (const float*)(lds + LDS_H) + t * 128 + c8i * 8; const float* hb = hf + T * 128;
        const f32x4_t f0 = *(const f32x4_t*)hf, f1 = *(const f32x4_t*)(hf + 4), b0 = *(const f32x4_t*)hb, b1 = *(const f32x4_t*)(hb + 4);
        const size_t gi = (rowb + t0 + t) * 1024 + cc;
        const bf16x8 gv = *reinterpret_cast<const bf16x8*>(p.LRG + gi);
        u32x4 w;
        w.x = pk2((f0[0] + b0[0]) * bf2f((bf16_t)gv[0]), (f0[1] + b0[1]) * bf2f((bf16_t)gv[1]));
        w.y = pk2((f0[2] + b0[2]) * bf2f((bf16_t)gv[2]), (f0[3] + b0[3]) * bf2f((bf16_t)gv[3]));
        w.z = pk2((f1[0] + b1[0]) * bf2f((bf16_t)gv[4]), (f1[1] + b1[1]) * bf2f((bf16_t)gv[5]));
        w.w = pk2((f1[2] + b1[2]) * bf2f((bf16_t)gv[6]), (f1[3] + b1[3]) * bf2f((bf16_t)gv[7]));
        *(u32x4*)(p.YL + gi) = w;
      }
    }
  }
#undef LRU_LOADROWS
}
}
#define XB_TMO      128
#define XB_XCNT(j)  (256  + 64 * (j))
#define XB_XSUB(j)  (1280 + 64 * (j))
#define XB_XGEN(j)  (2304 + 64 * (j))
#define XB_TOP      3328
#define XB_TOPGEN   3392
#define XCD_BAR_WORDS 3456
#define XB_SPIN_CAP (1u << 18)

__device__ __forceinline__ unsigned xb_ld(unsigned* p)              { return __hip_atomic_load(p, __ATOMIC_RELAXED, __HIP_MEMORY_SCOPE_AGENT); }
__device__ __forceinline__ unsigned xb_add(unsigned* p, unsigned v) { return __hip_atomic_fetch_add(p, v, __ATOMIC_RELAXED, __HIP_MEMORY_SCOPE_AGENT); }
__device__ __forceinline__ unsigned xb_xcc_id() { return (unsigned)__builtin_amdgcn_s_getreg((3 << 11) | 20) & 0xFu; }
#define XB_SPIN(cond, bar) do { unsigned _sp = 0; while (cond) { __builtin_amdgcn_s_sleep(1); \
    if ((++_sp & 255u) == 0u) { if (xb_ld(&(bar)[XB_TMO])) break; if (_sp > XB_SPIN_CAP) { atomicAdd(&(bar)[XB_TMO], 1u); break; } } } } while (0)

struct XcdBarrier {
    unsigned* bar; unsigned x;
    volatile LAS unsigned* st;
};

__device__ __forceinline__ XcdBarrier xcd_barrier_post(unsigned* bar, volatile LAS unsigned* st) {
    XcdBarrier b; b.bar = bar; b.x = xb_xcc_id(); b.st = st;
    if (threadIdx.x == 0) (void)xb_add(&bar[XB_XCNT(b.x)], 1u);
    return b;
}
__device__ __forceinline__ void xcd_barrier_complete(unsigned* bar, unsigned x, unsigned& nloc, unsigned& nx) {
    const unsigned G = gridDim.x * gridDim.y * gridDim.z;
    unsigned sum, cnt, mine, sp = 0u;
    for (;;) {
        sum = 0u; cnt = 0u; mine = 0u;
#pragma unroll
        for (unsigned j = 0; j < 16; ++j) { const unsigned c = xb_ld(&bar[XB_XCNT(j)]); sum += c; cnt += (c > 0u) ? 1u : 0u; mine = (j == x) ? c : mine; }
        if (sum == G) break;
        __builtin_amdgcn_s_sleep(1);
        if ((++sp & 255u) == 0u) { if (xb_ld(&bar[XB_TMO])) break; if (sp > XB_SPIN_CAP) { atomicAdd(&bar[XB_TMO], 1u); break; } }
    }
    nloc = mine > 0u ? mine : 1u; nx = cnt > 0u ? cnt : 1u;
}

__device__ __forceinline__ void xcd_barrier(const XcdBarrier& b) {
    asm volatile("s_waitcnt vmcnt(0)" ::: "memory");
    __syncthreads();
    if (threadIdx.x == 0) {
        unsigned* bar = b.bar;
        __builtin_amdgcn_s_waitcnt(0);
        unsigned nloc = b.st[0], nx = b.st[1];
        if (nloc == 0u) { xcd_barrier_complete(bar, b.x, nloc, nx); b.st[0] = nloc; b.st[1] = nx; }
        const unsigned old = xb_add(&bar[XB_XSUB(b.x)], 1u);
        const unsigned gen = old / nloc;
        if (old + 1u == (gen + 1u) * nloc) {
            __builtin_amdgcn_fence(__ATOMIC_RELEASE, "agent");
            asm volatile("s_waitcnt vmcnt(0)" ::: "memory");
            const unsigned og = xb_add(&bar[XB_TOP], 1u);
            const unsigned tg = og / nx;
            if (og + 1u == (tg + 1u) * nx) xb_add(&bar[XB_TOPGEN], 1u);
            else XB_SPIN(xb_ld(&bar[XB_TOPGEN]) == tg, bar);
            __builtin_amdgcn_fence(__ATOMIC_ACQUIRE, "agent");
            xb_add(&bar[XB_XGEN(b.x)], 1u);
            asm volatile("s_waitcnt vmcnt(0)" ::: "memory");
        } else {
            XB_SPIN(xb_ld(&bar[XB_XGEN(b.x)]) == gen, bar);
            __builtin_amdgcn_fence(__ATOMIC_ACQUIRE, "agent");
            asm volatile("s_waitcnt vmcnt(0)" ::: "memory");
        }
    }
    __syncthreads();
}
struct MkArgs { const float* in[29]; float* out; unsigned char* ws; int ph_lo, ph_hi; };
struct Frame {
    LAS unsigned char* lds;
    volatile LAS unsigned* MISC;
    gu32* ctl;
    int tid, lane, wave;
    int vcu, G;
};

__device__ __forceinline__ void p0_transpose_item(const float* W, int K, int N, bf16_t* WT, LAS float* scr, int item, int lane, const float* kscale, int mode) {
    const int nblk = N / 32, kb = item / nblk, nb = item % nblk, k0 = 64 * kb, n0 = 32 * nb;
    f32x4 wv[8];
#pragma unroll
    for (int i = 0; i < 8; ++i) { const int kk = 8 * i + (lane >> 3); wv[i] = *(const GAS f32x4*)(W + (size_t)(k0 + kk) * N + n0 + (lane & 7) * 4); }
#pragma unroll
    for (int i = 0; i < 8; ++i) { const int kk = 8 * i + (lane >> 3); f32x4 w = wv[i]; if (kscale) w = w * kscale[k0 + kk];
        LAS float* d = scr + kk * 33 + (lane & 7) * 4; d[0] = w.x; d[1] = w.y; d[2] = w.z; d[3] = w.w; }
    LDS_WAIT(); asm volatile("" ::: "memory");
    const int r0 = (mode == 1 && n0 < 2048) ? ((n0 & ~255) + 128 * ((n0 >> 5) & 1) + 32 * ((n0 >> 6) & 3)) : (mode >= 2) ? (256 * (n0 >> 7) + 128 * (mode - 2) + (n0 & 127)) : n0;
    const int c = lane & 7;
#pragma unroll
    for (int j = 0; j < 4; ++j) { const int n = (lane >> 3) + 8 * j; const LAS float* s = scr + (8 * c) * 33 + n;
        v4u o; o.x = pk2(s[0 * 33], s[1 * 33]); o.y = pk2(s[2 * 33], s[3 * 33]); o.z = pk2(s[4 * 33], s[5 * 33]); o.w = pk2(s[6 * 33], s[7 * 33]);
        *(GAS v4u*)(WT + (size_t)(r0 + n) * K + k0 + 8 * c) = o; }
    LDS_WAIT(); asm volatile("" ::: "memory");
}
__device__ __forceinline__ void p0_row2(const float* xrow, bf16_t* orow, float* rs, size_t dm, int lane) {
    f32x4 v[2][4]; float s[2] = {0.f, 0.f};
#pragma unroll
    for (int r = 0; r < 2; ++r) { const GAS f32x4* xr = (const GAS f32x4*)(xrow + r * dm * 1024) + lane;
#pragma unroll
        for (int j = 0; j < 4; ++j) v[r][j] = xr[64 * j]; }
#pragma unroll
    for (int r = 0; r < 2; ++r) {
#pragma unroll
        for (int j = 0; j < 4; ++j) s[r] += (v[r][j].x * v[r][j].x + v[r][j].y * v[r][j].y) + (v[r][j].z * v[r][j].z + v[r][j].w * v[r][j].w);
        s[r] = wave_sum(s[r]);
        if (lane == 0) rs[r * dm] = rsqrtf(s[r] * (1.f / 1024.f) + 1e-6f);
        GAS unsigned long long* o8 = (GAS unsigned long long*)(orow + r * dm * 1024) + lane;
#pragma unroll
        for (int j = 0; j < 4; ++j) o8[64 * j] = (unsigned long long)pk2(v[r][j].x, v[r][j].y) | ((unsigned long long)pk2(v[r][j].z, v[r][j].w) << 32);
    }
}

__global__ void __launch_bounds__(NWAVES * 64, 2) persist(MkArgs args) {
    extern __shared__ __attribute__((aligned(16))) unsigned char lds[];
    Frame F;
    F.lds = (LAS unsigned char*)lds;
    F.MISC = (volatile LAS unsigned*)(F.lds + MISC_OFF);
    F.tid = threadIdx.x; F.lane = F.tid & 63; F.wave = __builtin_amdgcn_readfirstlane(F.tid >> 6);
    F.G = gridDim.x; { const int bx = blockIdx.x; F.vcu = (F.G % 8 == 0) ? (bx % 8) * (F.G / 8) + bx / 8 : bx; }
    unsigned char* ws = args.ws;
    F.ctl = (gu32*)(ws + WS_CTL);
    for (int u = F.tid; u < (LDS_BYTES - LDSCTL_OFF) / 4; u += NWAVES * 64) ((LAS unsigned*)(F.lds + LDSCTL_OFF))[u] = 0u;
    __syncthreads();
    const int lo = args.ph_lo, hi = args.ph_hi;
    XcdBarrier bar; bar.bar = (unsigned*)(F.ctl + CW_BAR); bar.x = 0; bar.st = nullptr;
    if (hi - lo > 1) bar = xcd_barrier_post((unsigned*)(F.ctl + CW_BAR), F.MISC + 8);
#define IN(k) (lo <= (k) && (k) < hi)
#define BOTH(k) (IN(k) && IN((k) + 1))
#define GRID_BAR() xcd_barrier(bar)

    const float* x = args.in[0];
    bf16_t* XB = (bf16_t*)args.out;
    float* RS1 = (float*)(ws + WS_RS1); float* COST = (float*)(ws + WS_COS); float* SINT = (float*)(ws + WS_SIN);
    bf16_t* WINT = (bf16_t*)(ws + WS_WINT); bf16_t* WAT = (bf16_t*)(ws + WS_WAT); bf16_t* WLT = (bf16_t*)(ws + WS_WLT); bf16_t* WOT = (bf16_t*)(ws + WS_WOT);
    bf16_t* LRUW = (bf16_t*)(ws + WS_LRUW); float* LRUS = (float*)(ws + WS_LRUS);
    bf16_t* QP = (bf16_t*)(ws + WS_S0); bf16_t* KP = (bf16_t*)(ws + WS_S1); bf16_t* VB = (bf16_t*)(ws + WS_S2);
    bf16_t* LRX = (bf16_t*)(ws + WS_S3); bf16_t* LRG = (bf16_t*)(ws + WS_S4); bf16_t* GA = (bf16_t*)(ws + WS_S5); bf16_t* GL = (bf16_t*)(ws + WS_S6);

    if (IN(0)) REPEAT(0) {
        LAS float* scr = (LAS float*)(F.lds + RING_OFF + F.wave * 16384);
        const int gw = F.vcu * NWAVES + F.wave, NGW = F.G * NWAVES;
        constexpr int I_IN = (1024 / 64) * (PROJ / 32), I_SQ = (1024 / 64) * (1024 / 32);
        constexpr int I_LRU = 32 * 8;
        constexpr int NITEMS = I_IN + 3 * I_SQ + I_LRU;
        for (int it = gw; it < NITEMS; it += NGW) {
            int r = it;
            if (r < I_IN) { p0_transpose_item(args.in[2], 1024, PROJ, WINT, scr, r, F.lane, args.in[1], 1); continue; } r -= I_IN;
            if (r < I_SQ) { p0_transpose_item(args.in[11], 1024, 1024, WAT, scr, r, F.lane, nullptr, 0); continue; } r -= I_SQ;
            if (r < I_SQ) { p0_transpose_item(args.in[19], 1024, 1024, WLT, scr, r, F.lane, nullptr, 0); continue; } r -= I_SQ;
            if (r < I_SQ) { p0_transpose_item(args.in[20], 1024, 1024, WOT, scr, r, F.lane, nullptr, 0); continue; } r -= I_SQ;
            { const int mat = r >> 3, gate = mat >> 4, dirblk = mat & 15, dir = dirblk >> 3, blk = dirblk & 7;
              p0_transpose_item((gate ? args.in[16] : args.in[14]) + (size_t)dirblk * 16384, 128, 128, LRUW + (size_t)((dir * 2 + gate) * 8 + blk) * 16384, scr, r & 7, F.lane, nullptr, 0); }
        }
        for (int m = gw; m < NTOK; m += 2 * NGW) p0_row2(x + (size_t)m * 1024, XB + (size_t)m * 1024, RS1 + m, (size_t)NGW, F.lane);
        {
            for (int e = blockIdx.x * (NWAVES * 64) + F.tid; e < 4096 * 32; e += F.G * NWAVES * 64) {
                const int pos = e >> 5, i = e & 31;
                const float inv_freq = expf(-9.210340371976184f * (float)i * (1.f / 32.f));
                float sn, cs; sincosf((float)pos * inv_freq, &sn, &cs);
                COST[e] = cs; SINT[e] = sn;
            }
        }
    }
    if (BOTH(0)) GRID_BAR();
    if (IN(1)) {
        pg8::Gemm g{XB, WINT, NTOK, PROJ, 1024}; pg8::StaticOrder S; S.init(NTOK, PROJ, F.G, (int)blockIdx.x, PROBE_PHASE == 1 ? 2 : 1);
        pg8::EpiProj E{RS1, args.in[3], args.in[4], args.in[5], COST, SINT, QP, KP, VB, LRX, LRG, GA, GL};
        pg8::gemm_phase<pg8::EpiProj, pg8::StaticOrder, true, true>(F.lds + RING_OFF, g, S, E);
    }
    if (BOTH(1)) GRID_BAR();
    bf16_t* O1N = (bf16_t*)args.out; bf16_t* O2N = O1N + (size_t)NTOK * 1024;
    if (IN(2)) {
        const int per = 1024 / F.G;
        REPEAT(2) for (int i = 0; i < per; ++i) {
            const int unit = F.vcu * per + i;
            const int bhc = unit >> 4, qb = unit & 15, b = bhc >> 4, hc = bhc & 15, h = hc >> 1, c = hc & 1;
            att::attn_unit(QP + ((size_t)bhc * 4096 + qb * 256) * 64, KP + (size_t)bhc * 4096 * 64, VB + ((size_t)(b * 8 + h) * 4096) * 128,
                           (c ? O2N : O1N) + ((size_t)b * 4096 + qb * 256) * 1024 + h * 128, (char*)lds + RING_OFF);
        }
        REPEAT(10) { const lru::Params lp{LRX, LRG, LRUW, args.in[12], args.in[13], args.in[15], args.in[17], args.in[18], LRUS, nullptr};
          lru::lru_phase<1>(lp, (char*)lds + RING_OFF, F.vcu, F.G); }
        if (BOTH(2)) GRID_BAR();
    }
    bf16_t* ON = (bf16_t*)(ws + WS_S0); bf16_t* YL = (bf16_t*)(ws + WS_S1);
    if (IN(3)) REPEAT(3) {
        {
            const float s1 = wave_sum(args.in[6][F.lane] * args.in[7][F.lane]), s2 = wave_sum(args.in[8][F.lane] * args.in[9][F.lane]);
            const float lam = expf(s1) - expf(s2) + 0.2f;
            const float g0 = args.in[10][F.lane] * 0.8f, g1 = args.in[10][64 + F.lane] * 0.8f;
            const int gw = F.vcu * NWAVES + F.wave, NGW = F.G * NWAVES;
            for (int it = gw; it < NTOK * 8; it += NGW) {
                const size_t base = (size_t)it * 128;
                const float a0 = bf2f(O1N[base + F.lane]) - lam * bf2f(O2N[base + F.lane]);
                const float a1 = bf2f(O1N[base + 64 + F.lane]) - lam * bf2f(O2N[base + 64 + F.lane]);
                const float ss = wave_sum(a0 * a0 + a1 * a1);
                const float rs = rsqrtf(ss * (1.f / 128.f) + 1e-6f);
                ON[base + F.lane] = f2bf(a0 * rs * g0); ON[base + 64 + F.lane] = f2bf(a1 * rs * g1);
            }
        }
        { const lru::Params lp{LRX, LRG, LRUW, args.in[12], args.in[13], args.in[15], args.in[17], args.in[18], LRUS, YL};
          lru::lru_phase<2>(lp, (char*)lds + RING_OFF, F.vcu, F.G); }
    }
    if (BOTH(3)) GRID_BAR();
    bf16_t* MERGED = (bf16_t*)(ws + WS_S2);
    if (IN(4)) {
        { pg8::Gemm g{ON, WAT, NTOK, 1024, 1024}; pg8::StaticOrder S; S.init(NTOK, 1024, F.G, (int)blockIdx.x, PROBE_PHASE == 4 ? 2 : 1);
          pg8::EpiMerge<1> E{MERGED, GA};
          pg8::gemm_phase<pg8::EpiMerge<1>, pg8::StaticOrder, false, true>(F.lds + RING_OFF, g, S, E); }
        { pg8::Gemm g{YL, WLT, NTOK, 1024, 1024}; pg8::StaticOrder S; S.init(NTOK, 1024, F.G, (int)blockIdx.x, PROBE_PHASE == 4 ? 2 : 1);
          pg8::EpiMerge<2> E{MERGED, GL};
          pg8::gemm_phase<pg8::EpiMerge<2>, pg8::StaticOrder, false, true>(F.lds + RING_OFF, g, S, E); }
    }
    if (BOTH(4)) GRID_BAR();
    if (IN(5)) {
        pg8::Gemm g{MERGED, WOT, NTOK, 1024, 1024}; pg8::StaticOrder S; S.init(NTOK, 1024, F.G, (int)blockIdx.x, PROBE_PHASE == 5 ? 2 : 1);
        pg8::EpiResid E{x, args.out};
        pg8::gemm_phase<pg8::EpiResid, pg8::StaticOrder, false, true>(F.lds + RING_OFF, g, S, E);
    }
    if (BOTH(5)) GRID_BAR();
    bf16_t* H2 = (bf16_t*)(ws + WS_S0); bf16_t* HID = (bf16_t*)(ws + WS_S3);
    bf16_t* WGU = (bf16_t*)(ws + WS_S5); bf16_t* WDN = (bf16_t*)(ws + WS_S6 + 2 * MiB);
    bf16_t* Y0 = (bf16_t*)(ws + WS_S1); bf16_t* Y1 = (bf16_t*)(ws + WS_S2);
    int* LISTT = (int*)(ws + WS_LIST); float* LISTW = (float*)(ws + WS_LIST + 1 * MiB);
    gu32* GCNT = F.ctl + CW_CNT;
    LAS int* TB = (LAS int*)(F.lds + LDSCTL_OFF + 1024);
    if (IN(6)) {
        const float* x1 = args.out;
        const int tpc = NTOK / F.G, tpw = tpc / NWAVES;
        LAS int* LE = (LAS int*)(F.lds + RING_OFF + 12288); LAS float* LW = (LAS float*)(F.lds + RING_OFF + 12288 + 1024);
        LAS int* LRK = (LAS int*)(F.lds + RING_OFF + 12288 + 2048); LAS int* LCNT = (LAS int*)(F.lds + RING_OFF + 12288 + 3072); LAS int* LBASE = LCNT + 16;
        LAS float* WR = (LAS float*)(F.lds + RING_OFF + 16384);
        __syncthreads();
        if (F.tid < 32) LCNT[F.tid] = 0;
        const float* gain2 = args.in[21]; const float* wg = args.in[22]; const float* bg = args.in[23]; const float* wer = args.in[24]; const float* ber = args.in[25];
        for (int i = F.tid; i < 1024 * 5; i += NWAVES * 64) {
            const int d = i / 5, q = i % 5;
            const f32x4 w4 = (q == 0) ? *(const f32x4*)&wg[d * 4] : *(const f32x4*)&wer[d * 16 + (q - 1) * 4];
            *(LAS f32x4*)&WR[d * 20 + q * 4] = w4;
        }
        __syncthreads();
        for (int k = 0; k < tpw; ++k) {
            const int tl = F.wave * tpw + k; const size_t tok = (size_t)F.vcu * tpc + tl;
            const float* xr = x1 + tok * 1024 + F.lane; const float* gp = gain2 + F.lane; bf16_t* hp = H2 + tok * 1024 + F.lane;
            float v[16]; float ss = 0.f;
#pragma unroll
            for (int j = 0; j < 16; ++j) { v[j] = xr[j * 64]; ss += v[j] * v[j]; }
            ss = wave_sum(ss);
            const float rs = rsqrtf(ss * (1.f / 1024.f) + 1e-6f);
            float lg[20];
#pragma unroll
            for (int q = 0; q < 20; ++q) lg[q] = 0.f;
            const LAS float* wl = WR + F.lane * 20;
#pragma unroll
            for (int j = 0; j < 16; ++j) {
                const float hv = v[j] * rs * gp[j * 64];
                hp[j * 64] = f2bf(hv);
#pragma unroll
                for (int q = 0; q < 5; ++q) { const f32x4 w4 = *(const LAS f32x4*)&wl[j * 64 * 20 + q * 4]; lg[q * 4 + 0] += hv * w4.x; lg[q * 4 + 1] += hv * w4.y; lg[q * 4 + 2] += hv * w4.z; lg[q * 4 + 3] += hv * w4.w; }
            }
#pragma unroll
            for (int q = 0; q < 20; ++q) lg[q] = wave_sum(lg[q]);
            const float gl0 = lg[0] + bg[0], gl1 = lg[1] + bg[1], gl2 = lg[2] + bg[2], gl3 = lg[3] + bg[3];
            int gs = 0; float gm = gl0;
            if (gl1 > gm) { gm = gl1; gs = 1; } if (gl2 > gm) { gm = gl2; gs = 2; } if (gl3 > gm) { gm = gl3; gs = 3; }
            const float gw = 1.f / (expf(gl0 - gm) + expf(gl1 - gm) + expf(gl2 - gm) + expf(gl3 - gm));
            float el[4];
#pragma unroll
            for (int j = 0; j < 4; ++j) { const float s0 = lg[4 + j], s1 = lg[8 + j], s2 = lg[12 + j], s3 = lg[16 + j]; el[j] = (gs == 0 ? s0 : gs == 1 ? s1 : gs == 2 ? s2 : s3) + ber[gs * 4 + j]; }
            int i0 = 0; float v0 = el[0];
            if (el[1] > v0) { v0 = el[1]; i0 = 1; } if (el[2] > v0) { v0 = el[2]; i0 = 2; } if (el[3] > v0) { v0 = el[3]; i0 = 3; }
            int i1 = (i0 == 0) ? 1 : 0; float v1 = -3.0e38f;
#pragma unroll
            for (int j = 0; j < 4; ++j) { if (j != i0 && el[j] > v1) { v1 = el[j]; i1 = j; } }
            const float ex = expf(v1 - v0);
            if (F.lane == 0) { LE[tl * 2] = gs * 4 + i0; LE[tl * 2 + 1] = gs * 4 + i1; LW[tl * 2] = gw / (1.f + ex); LW[tl * 2 + 1] = gw * ex / (1.f + ex); }
        }
        __syncthreads();
        const int npair = tpc * 2;
        int me = 0;
        if (F.tid < npair) { me = LE[F.tid]; LRK[F.tid] = __hip_atomic_fetch_add(&LCNT[me], 1, __ATOMIC_RELAXED, __HIP_MEMORY_SCOPE_WORKGROUP); }
        __syncthreads();
        if (F.tid < 16) LBASE[F.tid] = (int)__hip_atomic_fetch_add(GCNT + F.tid, (unsigned)LCNT[F.tid], RLX_AGENT);
        __syncthreads();
        if (F.tid < npair) { const int pos = LBASE[me] + LRK[F.tid]; LISTT[me * 16384 + pos] = (F.vcu * tpc + (F.tid >> 1)) * 2 + (F.tid & 1); LISTW[me * 16384 + pos] = LW[F.tid]; }
        __syncthreads();
        REPEAT(11) {
            LAS float* scr = (LAS float*)(F.lds + RING_OFF + F.wave * 16384);
            const int gw_ = F.vcu * NWAVES + F.wave, NGW = F.G * NWAVES;
            constexpr int I_GU = (1024 / 64) * (512 / 32), I_DN = (512 / 64) * (1024 / 32);
            for (int it = gw_; it < 16 * (2 * I_GU + I_DN); it += NGW) {
                const int e = it / (2 * I_GU + I_DN); int r = it % (2 * I_GU + I_DN);
                if (r < 2 * I_GU) {
                    const int isup = r >= I_GU; if (isup) r -= I_GU;
                    p0_transpose_item((isup ? args.in[27] : args.in[26]) + (size_t)e * 1024 * 512, 1024, 512, WGU + (size_t)e * 1024 * 1024, scr, r, F.lane, nullptr, 2 + isup);
                } else {
                    p0_transpose_item(args.in[28] + (size_t)e * 512 * 1024, 512, 1024, WDN + (size_t)e * 1024 * 512, scr, r - 2 * I_GU, F.lane, nullptr, 0);
                }
            }
        }
        if (BOTH(6)) GRID_BAR();
    }
    if (IN(7) || IN(8)) {
        __syncthreads();
        if (F.tid < 16) TB[32 + F.tid] = (int)__hip_atomic_load(GCNT + F.tid, RLX_AGENT);
        __syncthreads();
        if (F.tid == 0) { int accn = 0; for (int e = 0; e < 16; ++e) { TB[e] = accn; accn += (TB[32 + e] + 255) >> 8; } TB[16] = accn; }
        __syncthreads();
    }
    if (IN(7)) REPEAT(7) {
        pg8::Gemm g{H2, WGU, 0, 1024, 1024}; pg8::GroupedOrder S{TB, LISTT, F.G, F.vcu, 4};
        pg8::EpiUp E{HID, LISTW};
        pg8::gemm_grouped<pg8::EpiUp, pg8::GroupedOrder, 0, true>(F.lds + RING_OFF, g, S, E);
    }
    if (BOTH(7)) GRID_BAR();
    if (IN(8)) REPEAT(8) {
        pg8::Gemm g{HID, WDN, 0, 1024, 512}; pg8::GroupedOrder S{TB, LISTT, F.G, F.vcu, 4};
        pg8::EpiDown E{Y0, (size_t)(Y1 - Y0), LISTT};
        pg8::gemm_grouped<pg8::EpiDown, pg8::GroupedOrder, 1, true>(F.lds + RING_OFF, g, S, E);
    }
    if (BOTH(8)) GRID_BAR();
    if (IN(9)) {
        typedef unsigned u32x2_t __attribute__((ext_vector_type(2)));
        f32x4* o4 = (f32x4*)args.out; const u32x2_t* a2 = (const u32x2_t*)Y0; const u32x2_t* b2 = (const u32x2_t*)Y1;
        for (size_t i = (size_t)blockIdx.x * (NWAVES * 64) + F.tid; i < (size_t)NTOK * 256; i += (size_t)F.G * NWAVES * 64) {
            f32x4 v = o4[i]; const u32x2_t a = a2[i], b = b2[i];
            v[0] += __uint_as_float(a.x << 16) + __uint_as_float(b.x << 16); v[1] += __uint_as_float(a.x & 0xffff0000u) + __uint_as_float(b.x & 0xffff0000u);
            v[2] += __uint_as_float(a.y << 16) + __uint_as_float(b.y << 16); v[3] += __uint_as_float(a.y & 0xffff0000u) + __uint_as_float(b.y & 0xffff0000u);
            o4[i] = v;
        }
    }
#undef IN
#undef BOTH
}
extern "C" void kernel_launch(void* const* d_in, const int* in_sizes, int n_in, void* d_out, int out_size, void* d_ws, size_t ws_size, hipStream_t stream) {
  static int once = 0;
  if (!once) {
    once = 1;
    if (ws_size < 8 * SLOT || n_in != 29) fprintf(stderr, "kernel_launch: unexpected ws %zu n_in %d\n", ws_size, n_in);
    (void)hipFuncSetAttribute((const void*)persist, hipFuncAttributeMaxDynamicSharedMemorySize, LDS_BYTES);
  }
  char* ws = (char*)d_ws;
  (void)hipMemsetAsync(ws + WS_CTL, 0, CTL_ZERO_BYTES, stream);
  MkArgs a{};
  for (int i = 0; i < 29; ++i) a.in[i] = (const float*)d_in[i];
  a.out = (float*)d_out; a.ws = (unsigned char*)d_ws;
  const int GRID = 256;
  a.ph_lo = 0; a.ph_hi = 10; hipLaunchKernelGGL(persist, dim3(GRID), dim3(NWAVES * 64), LDS_BYTES, stream, a);
}
```
